# Optimizing an MI355X kernel written in HIP

```python
import math
import numpy as np
import jax, jax.numpy as jnp
from jax import lax

D_MODEL = 4096
BATCH = 4
SEQ = 2048
DEPTH = 2

GRID_W = 64
HEAD_DIM = 128
Q_BLOCK = 128
D_MIX = D_MODEL
GROUP_W = D_MIX // 4
NA_HEADS = GROUP_W // HEAD_DIM
NA_WIN_ROWS_MAX = 8
NA_WIN_COLS = 16
AX_HEADS = GROUP_W // HEAD_DIM
AX_KV_HEADS = AX_HEADS // 4
ROPE_DIM_PER_AXIS = HEAD_DIM // 2
ROPE_THETA = 10000.0
SW_HEADS = GROUP_W // HEAD_DIM
SW_KV_HEADS = SW_HEADS // 4
SW_WINDOW = 128
DF_V_DIM = 2 * HEAD_DIM
DF_HEADS = GROUP_W // DF_V_DIM
T5_BUCKETS = 32
T5_MAX_DIST = 128
T5_HEADS = SW_HEADS + DF_HEADS
D_FF = 4 * D_MODEL
EPS = 1e-6
IN_WIDTHS = (
    NA_HEADS * HEAD_DIM, NA_HEADS * HEAD_DIM, NA_HEADS * HEAD_DIM,
    AX_HEADS * HEAD_DIM, AX_KV_HEADS * HEAD_DIM, AX_KV_HEADS * HEAD_DIM,
    SW_HEADS * HEAD_DIM, SW_KV_HEADS * HEAD_DIM, SW_KV_HEADS * HEAD_DIM,
    2 * DF_HEADS * HEAD_DIM, 2 * DF_HEADS * HEAD_DIM, DF_HEADS * DF_V_DIM,
)
D_IN = sum(IN_WIDTHS)

kernel_name = "hybrid_parallel_head_group_encoder"

F32 = jnp.float32


def split_points():
    pts, acc = [], 0
    for w in IN_WIDTHS[:-1]:
        acc += w
        pts.append(acc)
    return pts


def rms_norm(x, g):
    xf = x.astype(F32)
    y = xf * lax.rsqrt(jnp.mean(xf * xf, axis=-1, keepdims=True) + EPS)
    return (y * g.astype(F32)).astype(x.dtype)


def t5_bucket(rel):
    nb = T5_BUCKETS // 2
    max_exact = nb // 2
    base = jnp.where(rel > 0, nb, 0)
    n = jnp.abs(rel)
    n_f = jnp.maximum(n, 1).astype(F32)
    large = max_exact + (jnp.log(n_f / max_exact) / math.log(T5_MAX_DIST / max_exact)
                         * (nb - max_exact)).astype(jnp.int32)
    large = jnp.minimum(large, nb - 1)
    return base + jnp.where(n < max_exact, n, large)


def neighbourhood_attention(q, k, v, rpb):
    B, S, H, Dh = q.shape
    rows = S // GRID_W
    kr = min(NA_WIN_ROWS_MAX, rows)
    kc = NA_WIN_COLS
    nk = kr * kc
    r = np.arange(rows)
    c = np.arange(GRID_W)
    rs = np.clip(r - kr // 2, 0, rows - kr)
    cs = np.clip(c - kc // 2, 0, GRID_W - kc)
    key_r = rs[:, None] + np.arange(kr)
    key_c = cs[:, None] + np.arange(kc)
    idx = (key_r[:, None, :, None] * GRID_W + key_c[None, :, None, :]).reshape(rows, GRID_W, nk)
    dr = np.broadcast_to((key_r - r[:, None])[:, None, :, None], (rows, GRID_W, kr, kc)) + NA_WIN_ROWS_MAX - 1
    dc = np.broadcast_to((key_c - c[:, None])[None, :, None, :], (rows, GRID_W, kr, kc)) + NA_WIN_COLS - 1
    bias = rpb[:, dr, dc].astype(F32).reshape(H, rows, GRID_W, nk).transpose(1, 0, 2, 3)
    q_rows = q.reshape(B, rows, GRID_W, H, Dh).transpose(1, 0, 3, 2, 4)
    scale = Dh ** -0.5

    def row_block(args):
        q_r, idx_r, bias_r = args
        k_g = k[:, idx_r]
        v_g = v[:, idx_r]
        s = jnp.einsum('bhwd,bwnhd->bhwn', q_r, k_g, preferred_element_type=F32) * scale + bias_r
        p = jax.nn.softmax(s, axis=-1)
        return jnp.einsum('bhwn,bwnhd->bwhd', p.astype(v.dtype), v_g)

    o = lax.map(row_block, (q_rows, jnp.asarray(idx, dtype=jnp.int32), bias))
    return o.transpose(1, 0, 2, 3, 4).reshape(B, S, H * Dh)


def axial_rope(S):
    pos = jnp.arange(S, dtype=jnp.int32)
    row = (pos // GRID_W).astype(F32)
    col = (pos % GRID_W).astype(F32)
    n_pairs = ROPE_DIM_PER_AXIS // 2
    inv = ROPE_THETA ** (-jnp.arange(n_pairs, dtype=F32) / n_pairs)
    ang = jnp.concatenate([row[:, None] * inv, col[:, None] * inv], axis=-1)
    return jnp.cos(ang), jnp.sin(ang)


def apply_rope(x, cos, sin):
    xf = x.astype(F32)
    x1, x2 = xf[..., 0::2], xf[..., 1::2]
    c, s = cos[None, :, None, :], sin[None, :, None, :]
    out = jnp.stack([x1 * c - x2 * s, x1 * s + x2 * c], axis=-1).reshape(x.shape)
    return out.astype(x.dtype)


def blocked_gqa(q, k, v):
    B, S, H, Dh = q.shape
    Hkv = k.shape[2]
    G = H // Hkv
    nb = S // Q_BLOCK
    scale = Dh ** -0.5
    qb = q.reshape(B, nb, Q_BLOCK, Hkv, G, Dh).transpose(1, 0, 2, 3, 4, 5)

    def step(qi):
        s = jnp.einsum('bqkgd,bskd->bkgqs', qi, k, preferred_element_type=F32) * scale
        p = jax.nn.softmax(s, axis=-1)
        return jnp.einsum('bkgqs,bskd->bqkgd', p.astype(v.dtype), v)

    o = lax.map(step, qb)
    return o.transpose(1, 0, 2, 3, 4, 5).reshape(B, S, H * Dh)


def sliding_window_gqa(q, k, v, sink, t5_tab):
    B, S, H, Dh = q.shape
    Hkv = k.shape[2]
    G = H // Hkv
    nb = S // Q_BLOCK
    n_side = SW_WINDOW // Q_BLOCK
    span = (2 * n_side + 1) * Q_BLOCK
    pad = n_side * Q_BLOCK
    scale = Dh ** -0.5

    def band(t):
        tp = jnp.pad(t, ((0, 0), (pad, pad), (0, 0), (0, 0)))
        tp = tp.reshape(B, nb + 2 * n_side, Q_BLOCK, Hkv, t.shape[-1])
        return jnp.concatenate([tp[:, j:j + nb] for j in range(2 * n_side + 1)], axis=2)

    kb, vb = band(k), band(v)
    qb = q.reshape(B, nb, Q_BLOCK, Hkv, G, Dh)
    j = jnp.arange(span, dtype=jnp.int32)
    t = jnp.arange(Q_BLOCK, dtype=jnp.int32)
    rel = j[None, :] - pad - t[:, None]
    kpos = jnp.arange(nb, dtype=jnp.int32)[:, None] * Q_BLOCK - pad + j[None, :]
    allowed = (jnp.abs(rel) <= SW_WINDOW)[None] & ((kpos >= 0) & (kpos < S))[:, None, :]
    bias = t5_tab[t5_bucket(rel)].astype(F32).transpose(2, 0, 1).reshape(Hkv, G, 1, Q_BLOCK, span)
    s = jnp.einsum('bnqkgd,bnjkd->bkgnqj', qb, kb, preferred_element_type=F32) * scale + bias
    s = jnp.where(allowed, s, -jnp.inf)
    sink_l = sink.astype(F32).reshape(Hkv, G, 1, 1, 1)
    m = jnp.maximum(jnp.max(s, axis=-1, keepdims=True), sink_l)
    e = jnp.exp(s - m)
    p = e / (jnp.sum(e, axis=-1, keepdims=True) + jnp.exp(sink_l - m))
    o = jnp.einsum('bkgnqj,bnjkd->bnqkgd', p.astype(v.dtype), vb)
    return o.reshape(B, S, H * Dh)


def differential_attention(q1, q2, k1, k2, v, lam, t5_tab):
    B, S, H, Dh = q1.shape
    nb = S // Q_BLOCK
    scale = Dh ** -0.5
    qb = jnp.stack([q1, q2], axis=0).reshape(2, B, nb, Q_BLOCK, H, Dh).transpose(2, 0, 1, 3, 4, 5)
    starts = jnp.arange(nb, dtype=jnp.int32) * Q_BLOCK
    kpos = jnp.arange(S, dtype=jnp.int32)

    def step(args):
        qi, q0 = args
        rel = kpos[None, :] - (q0 + jnp.arange(Q_BLOCK, dtype=jnp.int32))[:, None]
        bias = t5_tab[t5_bucket(rel)].astype(F32).transpose(2, 0, 1)
        s1 = jnp.einsum('bqhd,bshd->bhqs', qi[0], k1, preferred_element_type=F32) * scale + bias
        s2 = jnp.einsum('bqhd,bshd->bhqs', qi[1], k2, preferred_element_type=F32) * scale + bias
        p = jax.nn.softmax(s1, axis=-1) - lam * jax.nn.softmax(s2, axis=-1)
        return jnp.einsum('bhqs,bshe->bqhe', p.astype(v.dtype), v)

    o = lax.map(step, (qb, starts))
    return o.transpose(1, 0, 2, 3, 4).reshape(B, S, H, v.shape[-1])


def setup_inputs(seed: int = 0) -> dict:
    key = jax.random.key(seed)
    ks = jax.random.split(key, 18)

    def nrm(k, shape, scale):
        return jax.random.normal(k, shape, F32) * scale

    def gain(k, shape):
        return 1.0 + 0.05 * jax.random.normal(k, shape, F32)

    return {
        "x": nrm(ks[0], (BATCH, SEQ, D_MODEL), 1.0),
        "ln_attn_pre": gain(ks[1], (DEPTH, D_MODEL)),
        "ln_attn_post": gain(ks[2], (DEPTH, D_MODEL)),
        "ln_mlp_pre": gain(ks[3], (DEPTH, D_MODEL)),
        "ln_mlp_post": gain(ks[4], (DEPTH, D_MODEL)),
        "w_in": nrm(ks[5], (DEPTH, D_MODEL, D_IN), D_MODEL ** -0.5),
        "w_out": nrm(ks[6], (DEPTH, D_MIX, D_MODEL), D_MIX ** -0.5),
        "na_rpb": nrm(ks[7], (DEPTH, NA_HEADS, 2 * NA_WIN_ROWS_MAX - 1, 2 * NA_WIN_COLS - 1), 0.5),
        "ax_q_norm": gain(ks[8], (DEPTH, HEAD_DIM)),
        "ax_k_norm": gain(ks[9], (DEPTH, HEAD_DIM)),
        "sw_sink": nrm(ks[10], (DEPTH, SW_HEADS), 0.5),
        "df_lambda": nrm(ks[11], (DEPTH, 4, HEAD_DIM), 0.1),
        "df_subln": gain(ks[12], (DEPTH, DF_V_DIM)),
        "t5_table": nrm(ks[13], (T5_BUCKETS, T5_HEADS), 0.5),
        "w_mlp_in": nrm(ks[14], (DEPTH, D_MODEL, D_FF), D_MODEL ** -0.5),
        "w_mlp_out": nrm(ks[15], (DEPTH, D_FF, D_MODEL), D_FF ** -0.5),
    }


def reference(x, ln_attn_pre, ln_attn_post, ln_mlp_pre, ln_mlp_post, w_in, w_out, na_rpb,
              ax_q_norm, ax_k_norm, sw_sink, df_lambda, df_subln, t5_table, w_mlp_in, w_mlp_out):
    B, S, _ = x.shape
    cos, sin = axial_rope(S)
    pts = split_points()
    t5_sw = t5_table[:, :SW_HEADS]
    t5_df = t5_table[:, SW_HEADS:]
    for l in range(DEPTH):
        h = rms_norm(x, ln_attn_pre[l])
        proj = jnp.einsum('bsd,de->bse', h, w_in[l])
        aq, ak, av, bq, bk, bv, cq, ck, cv, dq, dk, dv = jnp.split(proj, pts, axis=-1)

        ya = neighbourhood_attention(aq.reshape(B, S, NA_HEADS, HEAD_DIM),
                                     ak.reshape(B, S, NA_HEADS, HEAD_DIM),
                                     av.reshape(B, S, NA_HEADS, HEAD_DIM), na_rpb[l])

        qb_ = apply_rope(rms_norm(bq.reshape(B, S, AX_HEADS, HEAD_DIM), ax_q_norm[l]), cos, sin)
        kb_ = apply_rope(rms_norm(bk.reshape(B, S, AX_KV_HEADS, HEAD_DIM), ax_k_norm[l]), cos, sin)
        yb = blocked_gqa(qb_, kb_, bv.reshape(B, S, AX_KV_HEADS, HEAD_DIM))

        yc = sliding_window_gqa(cq.reshape(B, S, SW_HEADS, HEAD_DIM),
                                ck.reshape(B, S, SW_KV_HEADS, HEAD_DIM),
                                cv.reshape(B, S, SW_KV_HEADS, HEAD_DIM), sw_sink[l], t5_sw)

        lambda_init = 0.8 - 0.6 * math.exp(-0.3 * l)
        lp = df_lambda[l].astype(F32)
        lam = jnp.exp(jnp.sum(lp[0] * lp[1])) - jnp.exp(jnp.sum(lp[2] * lp[3])) + lambda_init
        dq4 = dq.reshape(B, S, 2, DF_HEADS, HEAD_DIM)
        dk4 = dk.reshape(B, S, 2, DF_HEADS, HEAD_DIM)
        od = differential_attention(dq4[:, :, 0], dq4[:, :, 1], dk4[:, :, 0], dk4[:, :, 1],
                                    dv.reshape(B, S, DF_HEADS, DF_V_DIM), lam, t5_df)
        yd = (rms_norm(od, df_subln[l]) * (1.0 - lambda_init)).reshape(B, S, DF_HEADS * DF_V_DIM)

        mix = jnp.concatenate([ya, yb, yc, yd], axis=-1)
        x = x + rms_norm(jnp.einsum('bse,ed->bsd', mix, w_out[l]), ln_attn_post[l])

        h = rms_norm(x, ln_mlp_pre[l])
        u = jnp.square(jax.nn.relu(jnp.einsum('bsd,df->bsf', h, w_mlp_in[l])))
        x = x + rms_norm(jnp.einsum('bsf,fd->bsd', u, w_mlp_out[l]), ln_mlp_post[l])
    return x
```

```cpp
#include <hip/hip_runtime.h>
#include <cstdio>
#include <cstdint>

template <int O> __device__ __forceinline__ float xsw(float v) { return __int_as_float(__builtin_amdgcn_ds_swizzle(__float_as_int(v), (O << 10) | 0x1f)); }
__device__ __forceinline__ float xsum32(float v) { auto rr = __builtin_amdgcn_permlane32_swap(__float_as_uint(v), __float_as_uint(v), false, false); return __uint_as_float(rr[0]) + __uint_as_float(rr[1]); }
__device__ __forceinline__ float xmax32(float v) { auto rr = __builtin_amdgcn_permlane32_swap(__float_as_uint(v), __float_as_uint(v), false, false); return fmaxf(__uint_as_float(rr[0]), __uint_as_float(rr[1])); }
namespace pg8 {
#define PG8_LAS __attribute__((address_space(3)))
typedef unsigned short bf16_t;
typedef short bf16x8 __attribute__((ext_vector_type(8)));
typedef float f32x4 __attribute__((ext_vector_type(4)));
typedef unsigned u32x4 __attribute__((ext_vector_type(4)));
typedef int i32x4 __attribute__((ext_vector_type(4)));
typedef int i32x8 __attribute__((ext_vector_type(8)));
typedef unsigned u32x2 __attribute__((ext_vector_type(2)));
constexpr int BM = 256, BK = 64, HALF = 128, HTB = HALF * BK * 2  , STAGE_BYTES = 8 * HTB, NXCD = 8, WGM = 4;

__host__ __device__ __forceinline__ int lds_byte(int r, int c) { const int st = (r >> 4) * 2 + (c >> 5), rr = r & 15, cc = c & 31, ob = rr * 64 + cc * 2; return st * 1024 + (ob ^ (((ob >> 9) & 1) << 5)); }
__host__ __device__ __forceinline__ void stage_rc(int b, int& R, int& C) { const int st = b / 1024, sb = b % 1024, swz = sb ^ (((sb >> 9) & 1) << 5); R = (st >> 1) * 16 + swz / 64; C = (st & 1) * 32 + (swz % 64) / 2; }
__host__ __device__ __forceinline__ int perm32(int rho) { const int n = rho >> 4, i = rho & 15; return 8 * (i >> 2) + 4 * n + (i & 3); }

struct Unit { int pm, pn; };
struct Gemm { const bf16_t* A; const bf16_t* Bt; int M, N, K; };

struct StaticOrder {
    int nM, nN, nwg, G, c;
    __host__ __device__ void init(int M, int N, int G_, int c_) { nM = M / BM; nN = N / BM; nwg = nM * nN; G = G_; c = c_; }
    __host__ __device__ bool next(int i, Unit& u) const {
        const long L = (long)i * G + c; if (L >= nwg) return false;
        int wgid = (int)L; { const int q = nwg / NXCD, r = nwg % NXCD, xcd = wgid % NXCD, off = wgid / NXCD; wgid = (xcd < r ? xcd * (q + 1) : r * (q + 1) + (xcd - r) * q) + off; }
        const int nig = WGM * nN, gid = wgid / nig, fm = gid * WGM, gsz = (nM - fm) < WGM ? (nM - fm) : WGM;
        u.pm = fm + ((wgid % nig) % gsz); u.pn = (wgid % nig) / gsz; return true;
    }
    __device__ __forceinline__ void a_ready(const Unit&) const {}
    __device__ __forceinline__ void done(const Unit&) const {}
};


__device__ __forceinline__ unsigned cvt_pk_bf16(float lo, float hi) { unsigned r; asm volatile("v_cvt_pk_bf16_f32 %0, %1, %2" : "=v"(r) : "v"(lo), "v"(hi)); return r; }

template <int ACT> struct EpiRowScale {
    static constexpr bool PERM = true, AFTER_DRAIN = false;
    bf16_t* O; int ldc; const float* rs;
    __device__ __forceinline__ void operator()(const f32x4 (&acc)[2][2][4][2], const Unit& u, int wr, int wc, int fr, int fq) const {
        asm volatile("" : "+v"(fr), "+v"(fq));
        const int row0 = u.pm * BM + wr * 64 + fr, col0 = u.pn * BM + wc * 32 + 8 * fq;
#pragma unroll
        for (int ai = 0; ai < 2; ++ai)
#pragma unroll
            for (int m = 0; m < 4; ++m) { const int row = row0 + ai * HALF + m * 16; const float s = rs[row]; bf16_t* rowp = O + (size_t)row * ldc + col0;
#pragma unroll
                for (int bj = 0; bj < 2; ++bj) { f32x4 v0 = acc[ai][bj][m][0] * s, v1 = acc[ai][bj][m][1] * s;
                    if (ACT == 1) {
#pragma unroll
                        for (int j = 0; j < 4; ++j) { const float a = fmaxf(v0[j], 0.f), b = fmaxf(v1[j], 0.f); v0[j] = a * a; v1[j] = b * b; } }
                    u32x4 w; w.x = cvt_pk_bf16(v0[0], v0[1]); w.y = cvt_pk_bf16(v0[2], v0[3]); w.z = cvt_pk_bf16(v1[0], v1[1]); w.w = cvt_pk_bf16(v1[2], v1[3]);
                    *(u32x4*)(rowp + bj * HALF) = w; } }
    }
};
template <bool INT> struct EpiYStats {
    static constexpr bool PERM = true, AFTER_DRAIN = false;
    bf16_t* O; int ldc; float* part; float sc; const float* as; const float* wsc;
    __device__ __forceinline__ void operator()(const f32x4 (&acc)[2][2][4][2], const Unit& u, int wr, int wc, int fr, int fq) const {
        asm volatile("" : "+v"(fr), "+v"(fq));
        const int row0 = u.pm * BM + wr * 64 + fr, col0 = u.pn * BM + wc * 32 + 8 * fq;
#pragma unroll
        for (int ai = 0; ai < 2; ++ai)
#pragma unroll
            for (int m = 0; m < 4; ++m) { const int row = row0 + ai * HALF + m * 16; bf16_t* rowp = O + (size_t)row * ldc + col0; float ss = 0.f; const float s = INT ? as[row] * wsc[0] : sc;
#pragma unroll
                for (int bj = 0; bj < 2; ++bj) { f32x4 v0, v1;
#pragma unroll
                    for (int j = 0; j < 4; ++j) { v0[j] = (INT ? (float)__float_as_int(acc[ai][bj][m][0][j]) : acc[ai][bj][m][0][j]) * s; v1[j] = (INT ? (float)__float_as_int(acc[ai][bj][m][1][j]) : acc[ai][bj][m][1][j]) * s; }
                    ss += (v0[0] * v0[0] + v0[1] * v0[1]) + (v0[2] * v0[2] + v0[3] * v0[3]) + (v1[0] * v1[0] + v1[1] * v1[1]) + (v1[2] * v1[2] + v1[3] * v1[3]);
                    u32x4 w; w.x = cvt_pk_bf16(v0[0], v0[1]); w.y = cvt_pk_bf16(v0[2], v0[3]); w.z = cvt_pk_bf16(v1[0], v1[1]); w.w = cvt_pk_bf16(v1[2], v1[3]);
                    *(u32x4*)(rowp + bj * HALF) = w; }
                ss += xsw<16>(ss); ss = xsum32(ss);
                if (fq == 0) part[(size_t)row * 64 + u.pn * 4 + wc] = ss; }
    }
};


__device__ __forceinline__ unsigned pk4_fp8(float a, float b, float c, float d) { int r = __builtin_amdgcn_cvt_pk_fp8_f32(a, b, 0, false); r = __builtin_amdgcn_cvt_pk_fp8_f32(c, d, r, true); return (unsigned)r; }
template <bool INT> struct EpiRelu2Fp8 {
    static constexpr bool PERM = true, AFTER_DRAIN = false;
    unsigned char* O; int ldc; const float* rs; const float* as; const float* wsc; float us;
    __device__ __forceinline__ void operator()(const f32x4 (&acc)[2][2][4][2], const Unit& u, int wr, int wc, int fr, int fq) const {
        asm volatile("" : "+v"(fr), "+v"(fq));
        const int row0 = u.pm * BM + wr * 64 + fr, col0 = u.pn * BM + wc * 32 + 8 * fq;
        const float winv = INT ? wsc[0] : 1.f;
#pragma unroll
        for (int ai = 0; ai < 2; ++ai)
#pragma unroll
            for (int m = 0; m < 4; ++m) { const int row = row0 + ai * HALF + m * 16; const float s = INT ? rs[row] * (as[row] * winv) : rs[row]; unsigned char* rowp = O + (size_t)row * ldc + col0;
#pragma unroll
                for (int bj = 0; bj < 2; ++bj) { f32x4 v0, v1;
#pragma unroll
                    for (int j = 0; j < 4; ++j) { const float x0 = INT ? (float)__float_as_int(acc[ai][bj][m][0][j]) : acc[ai][bj][m][0][j], x1 = INT ? (float)__float_as_int(acc[ai][bj][m][1][j]) : acc[ai][bj][m][1][j];
                        const float a = fmaxf(x0 * s, 0.f), b = fmaxf(x1 * s, 0.f); v0[j] = fminf(a * a * us, 448.f); v1[j] = fminf(b * b * us, 448.f); }
                    u32x2 w; w.x = pk4_fp8(v0[0], v0[1], v0[2], v0[3]); w.y = pk4_fp8(v1[0], v1[1], v1[2], v1[3]);
                    *(u32x2*)(rowp + bj * HALF) = w; } }
    }
};


struct EpiProjI8 {
    static constexpr bool PERM = true, AFTER_DRAIN = false;
    bf16_t* O; int ldc; const float* rs; const float* as; const float* wsc; PG8_LAS float* T; const float* qn; const float* kn; const float* rope; int seq;
    __device__ __forceinline__ void operator()(const f32x4 (&acc)[2][2][4][2], const Unit& u, int wr, int wc, int fr, int fq) const {
        asm volatile("" : "+v"(fr), "+v"(fq));
        const int row0 = u.pm * BM + wr * 64 + fr, col0 = u.pn * BM + wc * 32 + 8 * fq;
        const float winv = wsc[0];
        const bool bt = (u.pn >= 12 && u.pn <= 16);
        if (bt) {
#pragma unroll
            for (int ai = 0; ai < 2; ++ai)
#pragma unroll
                for (int m = 0; m < 4; ++m) { const int lr = ai * HALF + wr * 64 + m * 16 + fr; const float s = rs[row0 + ai * HALF + m * 16] * (as[row0 + ai * HALF + m * 16] * winv);
#pragma unroll
                    for (int bj = 0; bj < 2; ++bj) { float ss = 0.f;
#pragma unroll
                        for (int j = 0; j < 4; ++j) { const float a = (float)__float_as_int(acc[ai][bj][m][0][j]) * s, b = (float)__float_as_int(acc[ai][bj][m][1][j]) * s; ss += a * a + b * b; }
                        ss += xsw<16>(ss); ss = xsum32(ss);
                        if (fq == 0) T[(lr * 2 + bj) * 4 + wc] = ss; } }
            asm volatile("s_waitcnt lgkmcnt(0)" ::: "memory"); __builtin_amdgcn_s_barrier(); asm volatile("" ::: "memory");
        }
        const float* gn = (u.pn == 16) ? kn : qn; f32x4 g0 = {1.f, 1.f, 1.f, 1.f}, g1 = {1.f, 1.f, 1.f, 1.f};
        if (bt) { g0 = *(const f32x4*)(gn + wc * 32 + 8 * fq); g1 = *(const f32x4*)(gn + wc * 32 + 8 * fq + 4); }
#pragma unroll
        for (int ai = 0; ai < 2; ++ai)
#pragma unroll
            for (int m = 0; m < 4; ++m) { const int row = row0 + ai * HALF + m * 16; const float s = rs[row] * (as[row] * winv); bf16_t* rowp = O + (size_t)row * ldc + col0;
                f32x4 c0 = {1.f, 0.f, 1.f, 0.f}, c1 = {1.f, 0.f, 1.f, 0.f};
                if (bt) { const float* cs = rope + ((size_t)(row & (seq - 1)) * 64 + wc * 16 + fq * 4) * 2; c0 = *(const f32x4*)cs; c1 = *(const f32x4*)(cs + 4); }
#pragma unroll
                for (int bj = 0; bj < 2; ++bj) { f32x4 v0, v1;
#pragma unroll
                    for (int j = 0; j < 4; ++j) { v0[j] = (float)__float_as_int(acc[ai][bj][m][0][j]) * s; v1[j] = (float)__float_as_int(acc[ai][bj][m][1][j]) * s; }
                    if (bt) { const int lr = ai * HALF + wr * 64 + m * 16 + fr; const f32x4 t = *(const PG8_LAS f32x4*)(T + (lr * 2 + bj) * 4);
                        const float r = 1.0f / sqrtf(((t[0] + t[1]) + (t[2] + t[3])) * (1.0f / 128.0f) + 1e-6f);
                        v0 = v0 * r * g0; v1 = v1 * r * g1;
                        f32x4 w0, w1;
                        w0[0] = v0[0] * c0[0] - v0[1] * c0[1]; w0[1] = v0[0] * c0[1] + v0[1] * c0[0]; w0[2] = v0[2] * c0[2] - v0[3] * c0[3]; w0[3] = v0[2] * c0[3] + v0[3] * c0[2];
                        w1[0] = v1[0] * c1[0] - v1[1] * c1[1]; w1[1] = v1[0] * c1[1] + v1[1] * c1[0]; w1[2] = v1[2] * c1[2] - v1[3] * c1[3]; w1[3] = v1[2] * c1[3] + v1[3] * c1[2];
                        v0 = w0; v1 = w1; }
                    u32x4 w; w.x = cvt_pk_bf16(v0[0], v0[1]); w.y = cvt_pk_bf16(v0[2], v0[3]); w.z = cvt_pk_bf16(v1[0], v1[1]); w.w = cvt_pk_bf16(v1[2], v1[3]);
                    *(u32x4*)(rowp + bj * HALF) = w; } }
    }
};
template <class Epi, class Sched, bool ALIGN_EPI = false, bool SP2 = false, int DT = 0>
__device__ __forceinline__ void gemm_phase(PG8_LAS unsigned char* lds, const Gemm g, const Sched& S, const Epi& E, int tid_in) {
    int tid_o = tid_in; asm volatile("" : "+v"(tid_o));
    const int tid = tid_o, wid = __builtin_amdgcn_readfirstlane(tid >> 6), lane = tid & 63, wr = wid >> 2, wc = wid & 3, fr = lane & 15, fq = lane >> 4;
    const int K = g.K, nt = K / BK;
    unsigned voffA[2], voffB[2];
#pragma unroll
    for (int i = 0; i < 2; ++i) { int R, C; stage_rc(tid * 16 + i * 8192, R, C); const int Rb = Epi::PERM ? ((R & ~31) + perm32(R & 31)) : R;
        voffA[i] = (unsigned)(R * K + C) * 2u; voffB[i] = (unsigned)(Rb * K + C) * 2u; }
    const size_t kstep = (size_t)(BK * 2);
    const size_t hstep = (size_t)HALF * K * 2;
    const size_t tstep = 2 * hstep;
    const unsigned ldsw = (unsigned)wid * 1024u;
    const int aoff = lds_byte(wr * 64 + fr, fq * 8), boff = lds_byte(wc * 32 + fr, fq * 8);
    const PG8_LAS unsigned char* abase = lds + aoff; const PG8_LAS unsigned char* bbase = lds + 65536 + boff; asm volatile("" : "+v"(abase), "+v"(bbase));
#define PG8_SA(b, h) (((b) * 2 + (h)) * HTB)
#define PG8_SB(b, h) ((4 + (b) * 2 + (h)) * HTB)
#define PG8_STAGE(bufoff, gbase, voff) do { _Pragma("unroll") for (int _i = 0; _i < 2; ++_i) \
        __builtin_amdgcn_global_load_lds((const unsigned*)((const char*)(gbase) + (voff)[_i]), (PG8_LAS unsigned*)(lds + (bufoff) + ldsw + _i * 8192), 16, 0, 0); } while (0)
#define PG8_LDA(dst, b, h) do { _Pragma("unroll") for (int m = 0; m < 4; ++m) dst[m] = __builtin_shufflevector(*(const PG8_LAS i32x4*)(abase + (PG8_SA(b, h) + m * 2048)), *(const PG8_LAS i32x4*)(abase + (PG8_SA(b, h) + m * 2048 + 1024)), 0, 1, 2, 3, 4, 5, 6, 7); } while (0)
#define PG8_LDB(dst, b, h) do { _Pragma("unroll") for (int n = 0; n < 2; ++n) dst[n] = __builtin_shufflevector(*(const PG8_LAS i32x4*)(bbase + (PG8_SB(b, h) - 65536 + n * 2048)), *(const PG8_LAS i32x4*)(bbase + (PG8_SB(b, h) - 65536 + n * 2048 + 1024)), 0, 1, 2, 3, 4, 5, 6, 7); } while (0)
#define PG8_LO(x) __builtin_bit_cast(bf16x8, __builtin_shufflevector(x, x, 0, 1, 2, 3))
#define PG8_HI(x) __builtin_bit_cast(bf16x8, __builtin_shufflevector(x, x, 4, 5, 6, 7))
#define PG8_LOI(x) __builtin_shufflevector(x, x, 0, 1, 2, 3)
#define PG8_HII(x) __builtin_shufflevector(x, x, 4, 5, 6, 7)
#define PG8_MMA(ai, bj, At, Bt) do { __builtin_amdgcn_s_setprio(1); if constexpr (DT == 1) { _Pragma("unroll") for (int m = 0; m < 4; ++m) _Pragma("unroll") for (int n = 0; n < 2; ++n) \
        asm volatile("v_mfma_scale_f32_16x16x128_f8f6f4 %0, %1, %2, %0, %3, %3 op_sel_hi:[0,0,0]" : "+v"(acc[ai][bj][m][n]) : "v"(Bt[n]), "v"(At[m]), "v"(one_scale)); } \
    else if constexpr (DT == 2) { _Pragma("unroll") for (int m = 0; m < 4; ++m) _Pragma("unroll") for (int n = 0; n < 2; ++n) { \
        i32x4 c_ = __builtin_bit_cast(i32x4, acc[ai][bj][m][n]); c_ = __builtin_amdgcn_mfma_i32_16x16x64_i8(PG8_LOI(Bt[n]), PG8_LOI(At[m]), c_, 0, 0, 0); \
        c_ = __builtin_amdgcn_mfma_i32_16x16x64_i8(PG8_HII(Bt[n]), PG8_HII(At[m]), c_, 0, 0, 0); acc[ai][bj][m][n] = __builtin_bit_cast(f32x4, c_); } } \
    else { _Pragma("unroll") for (int m = 0; m < 4; ++m) _Pragma("unroll") for (int n = 0; n < 2; ++n) { \
        acc[ai][bj][m][n] = __builtin_amdgcn_mfma_f32_16x16x32_bf16(PG8_LO(Bt[n]), PG8_LO(At[m]), acc[ai][bj][m][n], 0, 0, 0); \
        acc[ai][bj][m][n] = __builtin_amdgcn_mfma_f32_16x16x32_bf16(PG8_HI(Bt[n]), PG8_HI(At[m]), acc[ai][bj][m][n], 0, 0, 0); } } __builtin_amdgcn_s_setprio(0); } while (0)
#define PG8_WAIT_V(n) asm volatile("s_waitcnt vmcnt(" #n ")" ::: "memory")
#define PG8_WAIT_L(n) asm volatile("s_waitcnt lgkmcnt(" #n ")" ::: "memory")
#define PG8_BAR __builtin_amdgcn_s_barrier()
#define PG8_SCHED __builtin_amdgcn_sched_barrier(0)
    Unit cur, nxt; int ui = 0;
    if (!S.next(0, cur)) return;
    int one_scale = 0x7F7F7F7F; asm volatile("" : "+v"(one_scale));
    f32x4 acc[2][2][4][2];
#pragma unroll
    for (int a = 0; a < 2; ++a)
#pragma unroll
        for (int b = 0; b < 2; ++b)
#pragma unroll
            for (int m = 0; m < 4; ++m)
#pragma unroll
                for (int n = 0; n < 2; ++n) acc[a][b][m][n] = (f32x4){0.f, 0.f, 0.f, 0.f};
    i32x8 At[4], B0[2], B1[2];
    const char* cA = (const char*)g.A + (size_t)cur.pm * tstep; const char* cB = (const char*)g.Bt + (size_t)cur.pn * tstep;
    S.a_ready(cur);
    if constexpr (SP2) {
        PG8_STAGE(PG8_SB(0, 0), cB, voffB); PG8_STAGE(PG8_SB(0, 1), cB + hstep, voffB); PG8_STAGE(PG8_SA(0, 0), cA, voffA); PG8_STAGE(PG8_SA(0, 1), cA + hstep, voffA);
        if (wr == 1) PG8_BAR;
        PG8_WAIT_V(2); PG8_BAR;
        PG8_STAGE(PG8_SB(1, 0), cB + kstep, voffB); PG8_STAGE(PG8_SA(1, 0), cA + kstep, voffA); PG8_STAGE(PG8_SB(1, 1), cB + hstep + kstep, voffB);
        PG8_WAIT_V(6); PG8_BAR;
    } else {
        PG8_STAGE(PG8_SB(0, 0), cB, voffB); PG8_STAGE(PG8_SA(0, 0), cA, voffA); PG8_STAGE(PG8_SB(0, 1), cB + hstep, voffB); PG8_STAGE(PG8_SA(0, 1), cA + hstep, voffA);
        if (wr == 1) PG8_BAR;
        PG8_WAIT_V(4); PG8_BAR;
        PG8_STAGE(PG8_SB(1, 0), cB + kstep, voffB); PG8_STAGE(PG8_SA(1, 0), cA + kstep, voffA); PG8_STAGE(PG8_SB(1, 1), cB + hstep + kstep, voffB);
        PG8_WAIT_V(6); PG8_BAR;
    }
    for (;;) {
        const bool has_next = S.next(ui + 1, nxt);
        const char* nA = has_next ? (const char*)g.A + (size_t)nxt.pm * tstep : cA; const char* nB = has_next ? (const char*)g.Bt + (size_t)nxt.pn * tstep : cB;
        for (int t = 0; t < nt; t += 2) {
            const bool last = (t == nt - 2);
            const char* a1 = cA + (size_t)(t + 1) * kstep;
            const char* a2 = last ? nA : cA + (size_t)(t + 2) * kstep; const char* b2 = last ? nB : cB + (size_t)(t + 2) * kstep;
            const char* a3 = a2 + kstep; const char* b3 = b2 + kstep;
            if (last && has_next) S.a_ready(nxt);
            if constexpr (SP2) {
            PG8_LDB(B0, 0, 0); PG8_LDB(B1, 0, 1); PG8_SCHED; PG8_LDA(At, 0, 0); PG8_STAGE(PG8_SA(1, 1), a1 + hstep, voffA);
            PG8_WAIT_V(8); PG8_WAIT_L(0); PG8_BAR; PG8_MMA(0, 0, At, B0); PG8_MMA(0, 1, At, B1); PG8_BAR; PG8_SCHED;
            PG8_LDA(At, 0, 1); PG8_STAGE(PG8_SB(0, 0), b2, voffB); PG8_STAGE(PG8_SB(0, 1), b2 + hstep, voffB); PG8_STAGE(PG8_SA(0, 0), a2, voffA);
            PG8_WAIT_V(8); PG8_WAIT_L(0); PG8_BAR; PG8_MMA(1, 0, At, B0); PG8_MMA(1, 1, At, B1); PG8_BAR; PG8_SCHED;
            PG8_LDB(B0, 1, 0); PG8_LDB(B1, 1, 1); PG8_SCHED; PG8_LDA(At, 1, 0); PG8_STAGE(PG8_SA(0, 1), a2 + hstep, voffA);
            PG8_WAIT_V(8); PG8_WAIT_L(0); PG8_BAR; PG8_MMA(0, 0, At, B0); PG8_MMA(0, 1, At, B1); PG8_BAR; PG8_SCHED;
            PG8_LDA(At, 1, 1); PG8_STAGE(PG8_SB(1, 0), b3, voffB); PG8_STAGE(PG8_SB(1, 1), b3 + hstep, voffB); PG8_STAGE(PG8_SA(1, 0), a3, voffA);
            PG8_WAIT_V(8); PG8_WAIT_L(0); PG8_BAR; PG8_MMA(1, 0, At, B0); PG8_MMA(1, 1, At, B1); PG8_BAR; PG8_SCHED;
            } else {
            PG8_LDB(B0, 0, 0); PG8_SCHED; PG8_LDA(At, 0, 0); PG8_STAGE(PG8_SA(1, 1), a1 + hstep, voffA);
            PG8_WAIT_L(8); PG8_BAR; PG8_WAIT_L(0); PG8_MMA(0, 0, At, B0); PG8_BAR; PG8_SCHED;
            PG8_LDB(B1, 0, 1); PG8_STAGE(PG8_SB(0, 0), b2, voffB);
            PG8_BAR; PG8_WAIT_L(0); PG8_MMA(0, 1, At, B1); PG8_BAR;
            PG8_LDA(At, 0, 1); PG8_STAGE(PG8_SA(0, 0), a2, voffA);
            PG8_BAR; PG8_WAIT_L(0); PG8_MMA(1, 0, At, B0); PG8_BAR; PG8_SCHED;
            PG8_STAGE(PG8_SB(0, 1), b2 + hstep, voffB);
            PG8_WAIT_V(6); PG8_BAR; PG8_MMA(1, 1, At, B1); PG8_BAR;
            PG8_LDB(B0, 1, 0); PG8_SCHED; PG8_LDA(At, 1, 0); PG8_STAGE(PG8_SA(0, 1), a2 + hstep, voffA);
            PG8_WAIT_L(8); PG8_BAR; PG8_WAIT_L(0); PG8_MMA(0, 0, At, B0); PG8_BAR; PG8_SCHED;
            PG8_LDB(B1, 1, 1); PG8_STAGE(PG8_SB(1, 0), b3, voffB);
            PG8_BAR; PG8_WAIT_L(0); PG8_MMA(0, 1, At, B1); PG8_BAR;
            PG8_LDA(At, 1, 1); PG8_STAGE(PG8_SA(1, 0), a3, voffA);
            PG8_BAR; PG8_WAIT_L(0); PG8_MMA(1, 0, At, B0); PG8_BAR; PG8_SCHED;
            PG8_STAGE(PG8_SB(1, 1), b3 + hstep, voffB);
            PG8_WAIT_V(6); PG8_BAR; PG8_MMA(1, 1, At, B1); PG8_BAR;
            }
        }
        if constexpr (DT == 1) asm volatile("s_nop 15\n\ts_nop 15" ::: "memory");
        if constexpr (ALIGN_EPI) { if (wr == 0) PG8_BAR; }
        if constexpr (!Epi::AFTER_DRAIN) { E(acc, cur, wr, wc, fr, fq); S.done(cur); }
        if (!has_next) break;
#pragma unroll
        for (int a = 0; a < 2; ++a)
#pragma unroll
            for (int b = 0; b < 2; ++b)
#pragma unroll
                for (int m = 0; m < 4; ++m)
#pragma unroll
                    for (int n = 0; n < 2; ++n) acc[a][b][m][n] = (f32x4){0.f, 0.f, 0.f, 0.f};
        cur = nxt; cA = nA; cB = nB; ++ui;
        if constexpr (ALIGN_EPI) { if (wr == 1) PG8_BAR; }
    }
    PG8_WAIT_V(0);
    if constexpr (!ALIGN_EPI) { if (wr == 0) PG8_BAR; }
    PG8_BAR;
    if constexpr (Epi::AFTER_DRAIN) { E.fused(acc, cur, wr, wc, fr, fq, lds, wid, lane); S.done(cur); }
#undef PG8_SA
#undef PG8_SB
#undef PG8_STAGE
#undef PG8_LO
#undef PG8_LOI
#undef PG8_HII
#undef PG8_HI
#undef PG8_LDA
#undef PG8_LDB
#undef PG8_MMA
#undef PG8_WAIT_V
#undef PG8_WAIT_L
#undef PG8_BAR
#undef PG8_SCHED
}
}

namespace att {
#define ALAS __attribute__((address_space(3)))
typedef unsigned short bf16;
using bf16x8 = __attribute__((ext_vector_type(8))) short;
using s16x4  = __attribute__((ext_vector_type(4))) short;
using f32x16 = __attribute__((ext_vector_type(16))) float;
using u32x4  = __attribute__((ext_vector_type(4))) unsigned;
typedef ALAS char* lptr;
constexpr int   D = 128, NW = 8, QBLK = 32, KVBLK = 64;
constexpr float SCALE = 0.088388347648318440f, INV_SCALE = 11.313708498984761f, LOG2E = 1.4426950408889634f;
constexpr float THR = 8.f;
constexpr float MASKV = -1e30f, MINIT = -1e10f;
constexpr int SHM_V = KVBLK * D * 2, SHM_K = KVBLK * D * 2;
constexpr int OFF_K = 2 * SHM_V, OFF_WS = 2 * SHM_V + 2 * SHM_K, OFF_TAB = OFF_WS + NW * 64 * 4, TAB_BYTES = 8192, OFF_STG = OFF_TAB + TAB_BYTES, ATT_LDS = OFF_STG + NW * 4096;
constexpr int TREL = 384;
enum { MODE_B = 0, MODE_C = 1, MODE_D = 2, MODE_A = 3 };
#define KSWZ(row, colB) ((row) * 256 + ((colB) ^ ((((row) & 7) | ((((row) >> 4) & 1) << 3)) << 4)))
#define SBAR() __builtin_amdgcn_sched_barrier(0)
__device__ __forceinline__ int crow(int r, int hi) { return (r & 3) + 8 * (r >> 2) + 4 * hi; }
__device__ __forceinline__ unsigned cvtpk(float lo, float hi) { unsigned r; asm volatile("v_cvt_pk_bf16_f32 %0, %1, %2" : "=v"(r) : "v"(lo), "v"(hi)); return r; }

__device__ __forceinline__ void partialSM(f32x16& p0, f32x16& p1, float& m_reg, float& mn, float& alpha) {
  constexpr float C = SCALE * LOG2E;
  float pmax = p0[0];
#pragma unroll
  for (int r = 1; r < 16; ++r) pmax = fmaxf(pmax, p0[r]);
#pragma unroll
  for (int r = 0; r < 16; ++r) pmax = fmaxf(pmax, p1[r]);
  { auto rr = __builtin_amdgcn_permlane32_swap(__float_as_uint(pmax), __float_as_uint(pmax), false, false);
    pmax = fmaxf(__uint_as_float(rr[0]), __uint_as_float(rr[1])); }
  if (__builtin_expect(__all(pmax - m_reg <= THR / SCALE), 1)) { mn = m_reg; alpha = 1.f; }
  else { mn = fmaxf(m_reg, pmax); alpha = __builtin_amdgcn_exp2f((m_reg - mn) * C); m_reg = mn; }
  float mnC = -mn * C;
#pragma unroll
  for (int r = 0; r < 16; ++r) p0[r] = fmaf(p0[r], C, mnC);
#pragma unroll
  for (int r = 0; r < 16; ++r) p1[r] = fmaf(p1[r], C, mnC);
#pragma unroll
  for (int r = 0; r < 16; ++r) p0[r] = __builtin_amdgcn_exp2f(p0[r]);
}
__device__ __forceinline__ void finishSM(f32x16& p0, f32x16& p1, float alpha, float& l_reg, bf16x8& pa0, bf16x8& pa1, bf16x8& pa2, bf16x8& pa3) {
#pragma unroll
  for (int r = 0; r < 16; ++r) p1[r] = __builtin_amdgcn_exp2f(p1[r]);
  float ps = 0;
#pragma unroll
  for (int r = 0; r < 16; ++r) ps += p0[r];
#pragma unroll
  for (int r = 0; r < 16; ++r) ps += p1[r];
  { auto rr = __builtin_amdgcn_permlane32_swap(__float_as_uint(ps), __float_as_uint(ps), false, false);
    ps = __uint_as_float(rr[0]) + __uint_as_float(rr[1]); }
  l_reg = l_reg * alpha + ps;
#define PK4(P, BASE, OUT) do { unsigned a0 = cvtpk(P[BASE + 0], P[BASE + 1]), a1 = cvtpk(P[BASE + 2], P[BASE + 3]);   \
    unsigned b0 = cvtpk(P[BASE + 4], P[BASE + 5]), b1 = cvtpk(P[BASE + 6], P[BASE + 7]);                              \
    auto r0 = __builtin_amdgcn_permlane32_swap(a0, b0, false, false); auto r1 = __builtin_amdgcn_permlane32_swap(a1, b1, false, false); \
    u32x4 w = {r0[0], r1[0], r0[1], r1[1]}; OUT = __builtin_bit_cast(bf16x8, w); } while (0)
  PK4(p0, 0, pa0); PK4(p0, 8, pa1); PK4(p1, 0, pa2); PK4(p1, 8, pa3);
#undef PK4
}
__device__ __forceinline__ void qkt(f32x16& p0, f32x16& p1, lptr Ks, const bf16x8* qr, int r32, int hi) {
#pragma unroll
  for (int d0 = 0; d0 < 8; ++d0) { int cb = (d0 * 16 + hi * 8) * 2;
    bf16x8 b0 = *(const ALAS bf16x8*)(Ks + KSWZ(r32, cb));
    bf16x8 b1 = *(const ALAS bf16x8*)(Ks + KSWZ(32 + r32, cb));
    p0 = __builtin_amdgcn_mfma_f32_32x32x16_bf16(b0, qr[d0], p0, 0, 0, 0);
    p1 = __builtin_amdgcn_mfma_f32_32x32x16_bf16(b1, qr[d0], p1, 0, 0, 0); }
}
__device__ __forceinline__ int v_st(int k, int c) { const int kk = (k & ~0xC) | ((k & 4) << 1) | ((k & 8) >> 1); return ((kk >> 3) * 4 + (c >> 5)) * 512 + ((kk & 7) * 32 + (c & 31)) * 2; }
__device__ __forceinline__ int v_rd_base(int lane) { return ((lane & 3) << 3) | (((lane >> 2) & 3) << 6) | (((lane >> 4) & 1) << 5) | (((lane >> 5) & 1) << 8); }
constexpr int v_rd_off(int d0, int ks, int half) { return d0 * 512 + ks * 4096 + half * 2048; }
template <int OFF> __device__ __forceinline__ s16x4 tr_read(int vb) {
  s16x4 r; asm volatile("ds_read_b64_tr_b16 %0, %1 offset:%2" : "=&v"(r) : "v"(vb), "i"(OFF) : "memory"); return r;
}
template <int D0> __device__ __forceinline__ void pv_one(f32x16& od, int vb, bf16x8 pa0, bf16x8 pa1, bf16x8 pa2, bf16x8 pa3) {
  const s16x4 l0 = tr_read<v_rd_off(D0, 0, 0)>(vb), h0 = tr_read<v_rd_off(D0, 0, 1)>(vb), l1 = tr_read<v_rd_off(D0, 1, 0)>(vb), h1 = tr_read<v_rd_off(D0, 1, 1)>(vb);
  const s16x4 l2 = tr_read<v_rd_off(D0, 2, 0)>(vb), h2 = tr_read<v_rd_off(D0, 2, 1)>(vb), l3 = tr_read<v_rd_off(D0, 3, 0)>(vb), h3 = tr_read<v_rd_off(D0, 3, 1)>(vb);
  asm volatile("s_waitcnt lgkmcnt(0)" ::: "memory"); SBAR();
#define PK(L, H) (bf16x8){L[0], L[1], L[2], L[3], H[0], H[1], H[2], H[3]}
  od = __builtin_amdgcn_mfma_f32_32x32x16_bf16(pa0, PK(l0, h0), od, 0, 0, 0);
  od = __builtin_amdgcn_mfma_f32_32x32x16_bf16(pa1, PK(l1, h1), od, 0, 0, 0);
  od = __builtin_amdgcn_mfma_f32_32x32x16_bf16(pa2, PK(l2, h2), od, 0, 0, 0);
  od = __builtin_amdgcn_mfma_f32_32x32x16_bf16(pa3, PK(l3, h3), od, 0, 0, 0);
#undef PK
}
__device__ __forceinline__ void pv_d0(f32x16* o, int vb, bf16x8 pa0, bf16x8 pa1, bf16x8 pa2, bf16x8 pa3) {
  pv_one<0>(o[0], vb, pa0, pa1, pa2, pa3); pv_one<1>(o[1], vb, pa0, pa1, pa2, pa3); pv_one<2>(o[2], vb, pa0, pa1, pa2, pa3); pv_one<3>(o[3], vb, pa0, pa1, pa2, pa3);
}

typedef short v4i16_t __attribute__((ext_vector_type(4)));
#define PIN(x) asm volatile("" : "+v"(x))
#define MF(a, b, c) __builtin_amdgcn_mfma_f32_32x32x16_bf16(a, b, c, 0, 0, 0)
#define EX2(x) __builtin_amdgcn_exp2f(x)
#define MX3(a, b, c) __builtin_fmaxf(__builtin_fmaxf((a), (b)), (c))
__device__ __forceinline__ unsigned cvtpk_s(float lo, float hi) { unsigned r; asm("v_cvt_pk_bf16_f32 %0, %1, %2" : "=v"(r) : "v"(lo), "v"(hi)); return r; }
#define KRD2(Ks, D0, K0, K1) do { const int cb_ = ((D0) * 16 + hi * 8) * 2; K0 = *(const ALAS bf16x8*)((Ks) + KSWZ(r32, cb_)); K1 = *(const ALAS bf16x8*)((Ks) + KSWZ(32 + r32, cb_)); } while (0)
#define VTR(vp, OFF) __builtin_bit_cast(s16x4, __builtin_amdgcn_ds_read_tr16_b64_v4i16((ALAS v4i16_t*)((vp) + (OFF))))
#define PKV(L, H) (bf16x8){L[0], L[1], L[2], L[3], H[0], H[1], H[2], H[3]}
#define VRDG(vp, GI, L0, H0, L1, H1) do { L0 = VTR(vp, v_rd_off(2 * ((GI) >> 2), (GI) & 3, 0)); H0 = VTR(vp, v_rd_off(2 * ((GI) >> 2), (GI) & 3, 1)); \
    L1 = VTR(vp, v_rd_off(2 * ((GI) >> 2) + 1, (GI) & 3, 0)); H1 = VTR(vp, v_rd_off(2 * ((GI) >> 2) + 1, (GI) & 3, 1)); } while (0)
#define SWP(a, b, r) auto r = __builtin_amdgcn_permlane32_swap(a, b, false, false)

__device__ __forceinline__ void bias_init(f32x16& p0, f32x16& p1, int mode, int k0, int qw, int r32, int hi, const ALAS float* tab) {
  if (mode == MODE_B) { p0 = f32x16{}; p1 = f32x16{}; return; }
  if (mode == MODE_A) {
    const int kr = k0 >> 6, rq = qw >> 6, rs = min(max(rq - 4, 0), 24);
    if (kr < rs || kr >= rs + 8) {
#pragma unroll
      for (int r = 0; r < 16; ++r) { p0[r] = MASKV; p1[r] = MASKV; } }
    else { const int cq = (qw & 63) + r32, cs = min(max(cq - 8, 0), 48), d = 4 * hi - cs; const ALAS float* rt = tab + ((kr - rq + 7) * 128 + 48 + 15 + 4 * hi - cq); asm volatile("" : "+v"(rt));
#pragma unroll
      for (int r = 0; r < 16; ++r) { const int c0 = (r & 3) + 8 * (r >> 2), c1 = c0 + 32; const bool ok0 = (unsigned)(c0 + d) < 16u, ok1 = (unsigned)(c1 + d) < 16u;
        const float t0 = rt[c0], t1 = rt[c1]; p0[r] = ok0 ? t0 : MASKV; p1[r] = ok1 ? t1 : MASKV; if ((r & 3) == 3) asm volatile("" ::: "memory"); } }
  } else {
    const int dq = k0 - qw;
    if (mode == MODE_D && (dq >= 128 || dq <= -160)) { const float c = tab[dq > 0 ? TREL + 300 : TREL - 300];
#pragma unroll
      for (int r = 0; r < 16; ++r) { p0[r] = c; p1[r] = c; } }
    else { const ALAS float* tl = tab + (dq + 4 * hi - r32 + TREL); asm volatile("" : "+v"(tl));
#pragma unroll
      for (int r = 0; r < 16; ++r) { const int c0 = (r & 3) + 8 * (r >> 2); p0[r] = tl[c0]; p1[r] = tl[c0 + 32]; if ((r & 3) == 3) asm volatile("" ::: "memory"); } }
  }
}

template <int LD>
__device__ __forceinline__ void attn_unit(const bf16* __restrict__ Qb, const bf16* __restrict__ Kh, int vdelta, int nkeys,
                                          int mode, int kbeg, int qbase, const ALAS float* tab, float sink, void* __restrict__ Op, lptr lds, int tid_in) {
  int tid_o = tid_in; asm volatile("" : "+v"(tid_o));
  const int tid = tid_o, wid = __builtin_amdgcn_readfirstlane(tid >> 6), lane = tid & 63, r32 = lane & 31, hi = lane >> 5;
  lptr V_lds = lds; lptr K_lds = lds + OFF_K;
  ALAS float* ws = (ALAS float*)(lds + OFF_WS) + wid * 64; ALAS float* li_l = ws; ALAS float* al_l = ws + 32;
  float m_reg = MINIT, l_reg = 0; f32x16 o[4] = {}; bf16x8 qr[8];
  const bf16* Qw = Qb + (unsigned)((wid * QBLK + r32) * LD + hi * 8);
#pragma unroll
  for (int d0 = 0; d0 < 8; ++d0) qr[d0] = *(const bf16x8*)(Qw + d0 * 16);
  const int sr = tid >> 4, sc = (tid & 15) * 8; const unsigned vo = (unsigned)(sr * LD + sc); const int vst0 = v_st(sr, sc), vst1 = v_st(32 + sr, sc);
  const int vb0 = (int)(unsigned)(size_t)V_lds + v_rd_base(lane);
  const int qw = qbase + wid * QBLK;
  struct { bf16x8 vs0, vs1, ks0, ks1; } sr_[2];
#define SLOAD(i, k0) do { const bf16* Kt = Kh + (size_t)(k0) * LD; const bf16* Vt = Kt + vdelta; \
    sr_[i].vs0 = *(const bf16x8*)(Vt + vo); sr_[i].vs1 = *(const bf16x8*)(Vt + 32 * LD + vo); \
    sr_[i].ks0 = *(const bf16x8*)(Kt + vo); sr_[i].ks1 = *(const bf16x8*)(Kt + 32 * LD + vo); } while (0)
#define SWRITE_K(b, i) do { int kc = sc * 2; *(ALAS bf16x8*)(K_lds + (b) * SHM_K + KSWZ(sr, kc)) = sr_[i].ks0; *(ALAS bf16x8*)(K_lds + (b) * SHM_K + KSWZ(32 + sr, kc)) = sr_[i].ks1; } while (0)
#define SWRITE_V(b, i) do { *(ALAS bf16x8*)(V_lds + (b) * SHM_V + vst0) = sr_[i].vs0; *(ALAS bf16x8*)(V_lds + (b) * SHM_V + vst1) = sr_[i].vs1; } while (0)
#define SWAIT() asm volatile("s_waitcnt vmcnt(4)" ::: "memory")
#define RESC(a) do { if (__any((a) < 1.f)) { if (hi == 0) al_l[r32] = (a); asm volatile("s_waitcnt lgkmcnt(0)" ::: "memory"); \
    _Pragma("unroll") for (int d = 0; d < 4; ++d) _Pragma("unroll") for (int r = 0; r < 16; ++r) o[d][r] *= al_l[crow(r, hi)]; } } while (0)
  f32x16 pA0, pA1, pB0, pB1; float mnA, mnB, alA, alB; bf16x8 pa0, pa1, pa2, pa3; const int NT = nkeys / KVBLK;
  constexpr int SE = 0, SO = 1;
  SLOAD(SE, 0); asm volatile("s_waitcnt vmcnt(0)" ::: "memory"); SWRITE_K(0, SE); SWRITE_V(0, SE);
  SLOAD(SO, KVBLK); if (2 < NT) SLOAD(SE, 2 * KVBLK);
  __syncthreads();
  bias_init(pA0, pA1, mode, kbeg, qw, r32, hi, tab); qkt(pA0, pA1, K_lds, qr, r32, hi); partialSM(pA0, pA1, m_reg, mnA, alA);
  SWAIT(); SWRITE_K(1, SO); __syncthreads();
  constexpr float C = SCALE * LOG2E;
  lptr vbp = V_lds + v_rd_base(lane);
  bf16x8 kA0, kA1, kB0, kB1; s16x4 vAl0, vAh0, vAl1, vAh1, vBl0, vBh0, vBl1, vBh1; float ps; unsigned ca0, ca1, cb0, cb1;
#define GA(C0, C1, Ks, D0, KC0, KC1, KN0, KN1, FILL) do { if ((D0) < 7) KRD2(Ks, ((D0) + 1) & 7, KN0, KN1); \
    C0 = MF(KC0, qr[D0], C0); C1 = MF(KC1, qr[D0], C1); FILL; SBAR(); } while (0)
#define E3(P, i) do { P[i] = EX2(P[i]); P[(i) + 1] = EX2(P[(i) + 1]); P[(i) + 2] = EX2(P[(i) + 2]); } while (0)
#define E2(P, i) do { P[i] = EX2(P[i]); P[(i) + 1] = EX2(P[(i) + 1]); } while (0)
#define S4(P, i) do { ps += P[i]; ps += P[(i) + 1]; ps += P[(i) + 2]; ps += P[(i) + 3]; } while (0)
#define CA(P, i) do { ca0 = cvtpk_s(P[i], P[(i) + 1]); ca1 = cvtpk_s(P[(i) + 2], P[(i) + 3]); } while (0)
#define CB(P, i, OUT) do { cb0 = cvtpk_s(P[i], P[(i) + 1]); cb1 = cvtpk_s(P[(i) + 2], P[(i) + 3]); SWP(ca0, cb0, r0_); SWP(ca1, cb1, r1_); \
    u32x4 w_ = {r0_[0], r1_[0], r0_[1], r1_[1]}; OUT = __builtin_bit_cast(bf16x8, w_); PIN(OUT); } while (0)
#define GB(vp, GI, CL0, CH0, CL1, CH1, NL0, NH0, NL1, NH1, PAK, FILL) do { if ((GI) < 7) VRDG(vp, ((GI) + 1) & 7, NL0, NH0, NL1, NH1); \
    o[2 * ((GI) >> 2)] = MF(PAK, PKV(CL0, CH0), o[2 * ((GI) >> 2)]); o[2 * ((GI) >> 2) + 1] = MF(PAK, PKV(CL1, CH1), o[2 * ((GI) >> 2) + 1]); FILL; SBAR(); } while (0)
#define FE(C0, C1, i) do { C0[i] = EX2(__builtin_fmaf(C0[i], C, mnC_)); C1[i] = __builtin_fmaf(C1[i], C, mnC_); } while (0)
#define FE3(C0, C1, i) do { FE(C0, C1, i); FE(C0, C1, (i) + 1); FE(C0, C1, (i) + 2); PIN(C0); PIN(C1); } while (0)
#define FE2(C0, C1, i) do { FE(C0, C1, i); FE(C0, C1, (i) + 1); PIN(C0); PIN(C1); } while (0)
#define STEP(C0, C1, ALC, P0, P1, ALP, T, KB_, DOLOAD, DOWK) do { \
    lptr Ks_ = K_lds + (KB_) * SHM_K; lptr vp_ = vbp + (1 - (KB_)) * SHM_V; \
    KRD2(Ks_, 0, kA0, kA1); \
    SWRITE_V(KB_, KB_); SBAR(); \
    bias_init(C0, C1, mode, kbeg + (T) * KVBLK, qw, r32, hi, tab); SBAR(); \
    GA(C0, C1, Ks_, 0, kA0, kA1, kB0, kB1, E3(P1, 0); ps = P0[0] + P0[1]; ps += P0[2]; ps += P0[3]; CA(P0, 0); PIN(P1); PIN(ps); PIN(ca0); PIN(ca1)); \
    GA(C0, C1, Ks_, 1, kB0, kB1, kA0, kA1, E3(P1, 3); S4(P0, 4); CB(P0, 4, pa0); PIN(P1); PIN(ps)); \
    GA(C0, C1, Ks_, 2, kA0, kA1, kB0, kB1, E3(P1, 6); S4(P0, 8); CA(P0, 8); PIN(P1); PIN(ps); PIN(ca0); PIN(ca1)); \
    GA(C0, C1, Ks_, 3, kB0, kB1, kA0, kA1, E3(P1, 9); S4(P0, 12); CB(P0, 12, pa1); PIN(P1); PIN(ps)); \
    GA(C0, C1, Ks_, 4, kA0, kA1, kB0, kB1, E2(P1, 12); S4(P1, 0); CA(P1, 0); PIN(P1); PIN(ps); PIN(ca0); PIN(ca1)); \
    GA(C0, C1, Ks_, 5, kB0, kB1, kA0, kA1, E2(P1, 14); S4(P1, 4); CB(P1, 4, pa2); PIN(P1); PIN(ps)); \
    GA(C0, C1, Ks_, 6, kA0, kA1, kB0, kB1, S4(P1, 8); CA(P1, 8); PIN(ps); PIN(ca0); PIN(ca1)); \
    GA(C0, C1, Ks_, 7, kB0, kB1, kA0, kA1, VRDG(vp_, 0, vAl0, vAh0, vAl1, vAh1); S4(P1, 12); CB(P1, 12, pa3); \
       { SWP(__float_as_uint(ps), __float_as_uint(ps), rr_); ps = __uint_as_float(rr_[0]) + __uint_as_float(rr_[1]); } l_reg = l_reg * (ALP) + ps; PIN(l_reg)); \
    if (DOLOAD) SLOAD(KB_, ((T) + 2) * KVBLK); \
    float mxa_, mxb_, mnC_; \
    GB(vp_, 0, vAl0, vAh0, vAl1, vAh1, vBl0, vBh0, vBl1, vBh1, pa0, \
       mxa_ = MX3(C0[0], C0[1], C1[0]); mxb_ = MX3(C0[2], C0[3], C1[1]); mxa_ = MX3(mxa_, C1[2], C1[3]); mxa_ = MX3(mxa_, C0[4], C0[5]); mxb_ = MX3(mxb_, C0[6], C0[7]); \
       mxa_ = MX3(mxa_, C1[4], C1[5]); mxb_ = MX3(mxb_, C1[6], C1[7]); PIN(mxa_); PIN(mxb_)); \
    GB(vp_, 1, vBl0, vBh0, vBl1, vBh1, vAl0, vAh0, vAl1, vAh1, pa1, \
       mxa_ = MX3(mxa_, C0[8], C0[9]); mxb_ = MX3(mxb_, C0[10], C0[11]); mxa_ = MX3(mxa_, C1[8], C1[9]); mxb_ = MX3(mxb_, C1[10], C1[11]); \
       mxa_ = MX3(mxa_, C0[12], C0[13]); mxb_ = MX3(mxb_, C0[14], C0[15]); mxa_ = MX3(mxa_, C1[12], C1[13]); mxb_ = MX3(mxb_, C1[14], C1[15]); \
       { float pm_ = __builtin_fmaxf(mxa_, mxb_); SWP(__float_as_uint(pm_), __float_as_uint(pm_), rr_); pm_ = __builtin_fmaxf(__uint_as_float(rr_[0]), __uint_as_float(rr_[1])); float mn_; \
         if (__builtin_expect(__all(pm_ - m_reg <= THR / SCALE), 1)) { mn_ = m_reg; ALC = 1.f; } \
         else { mn_ = __builtin_fmaxf(m_reg, pm_); ALC = EX2((m_reg - mn_) * C); m_reg = mn_; } \
         mnC_ = -mn_ * C; } PIN(mnC_); PIN(ALC)); \
    GB(vp_, 2, vAl0, vAh0, vAl1, vAh1, vBl0, vBh0, vBl1, vBh1, pa2, FE3(C0, C1, 0)); \
    GB(vp_, 3, vBl0, vBh0, vBl1, vBh1, vAl0, vAh0, vAl1, vAh1, pa3, FE3(C0, C1, 3)); \
    GB(vp_, 4, vAl0, vAh0, vAl1, vAh1, vBl0, vBh0, vBl1, vBh1, pa0, FE3(C0, C1, 6)); \
    GB(vp_, 5, vBl0, vBh0, vBl1, vBh1, vAl0, vAh0, vAl1, vAh1, pa1, FE3(C0, C1, 9)); \
    GB(vp_, 6, vAl0, vAh0, vAl1, vAh1, vBl0, vBh0, vBl1, vBh1, pa2, FE2(C0, C1, 12)); \
    GB(vp_, 7, vBl0, vBh0, vBl1, vBh1, vAl0, vAh0, vAl1, vAh1, pa3, FE2(C0, C1, 14)); \
    if (DOWK) { SWAIT(); SWRITE_K(1 - (KB_), 1 - (KB_)); } \
    RESC(ALC); __syncthreads(); } while (0)
  for (int j = 1; j + 1 < NT; j += 2) {
    STEP(pB0, pB1, alB, pA0, pA1, alA, j, 1, true, true);
    STEP(pA0, pA1, alA, pB0, pB1, alB, j + 1, 0, (j + 3 < NT), true);
  }
  STEP(pB0, pB1, alB, pA0, pA1, alA, NT - 1, 1, false, false);
  finishSM(pB0, pB1, alB, l_reg, pa0, pa1, pa2, pa3); SBAR();
  pv_d0(o, vb0 + SHM_V, pa0, pa1, pa2, pa3);
  __syncthreads();
  if (mode == MODE_C) l_reg += __builtin_amdgcn_exp2f(sink * LOG2E - m_reg * (SCALE * LOG2E));
  if (hi == 0) li_l[r32] = l_reg; asm volatile("s_waitcnt lgkmcnt(0)" ::: "memory");
  float rli[16];
#pragma unroll
  for (int r = 0; r < 16; ++r) rli[r] = __builtin_amdgcn_rcpf(li_l[crow(r, hi)]);
  { lptr stg = lds + OFF_STG + wid * 4096; const int psh = (mode == MODE_D) ? 10 : 12;
    bf16* Ob = (bf16*)Op + ((unsigned)(wid * QBLK) << psh);
#pragma unroll
    for (int p = 0; p < 2; ++p) {
#pragma unroll
      for (int r = 0; r < 16; ++r) { const unsigned w = cvtpk(o[2 * p][r] * rli[r], o[2 * p + 1][r] * rli[r]); ALAS unsigned short* sp = (ALAS unsigned short*)(stg + crow(r, hi) * 128 + r32 * 2);
        sp[0] = (unsigned short)w; sp[32] = (unsigned short)(w >> 16); }
      asm volatile("s_waitcnt lgkmcnt(0)" ::: "memory");
#pragma unroll
      for (int i = 0; i < 4; ++i) { const int row = i * 8 + (lane >> 3), ch = lane & 7; const u32x4 v = *(const ALAS u32x4*)(stg + row * 128 + ch * 16);
        *(u32x4*)(Ob + (((unsigned)row << psh) + p * 64 + ch * 8)) = v; }
      asm volatile("s_waitcnt lgkmcnt(0)" ::: "memory"); } }
#undef SLOAD
#undef SWRITE_K
#undef SWRITE_V
#undef SWAIT
#undef RESC
}
}

constexpr int NWAVES = 8;
constexpr int BATCH = 4, SEQ = 2048, DM = 4096, DIN = 9216, DFF = 16384, MTOK = BATCH * SEQ, DEPTH = 2;
constexpr float EPS = 1e-6f;
constexpr float U_SCALE = 8.0f, WMO_SCALE = 2048.0f;
constexpr int C_AQ = 0, C_AK = 1024, C_AV = 2048, C_BQ = 3072, C_BK = 4096, C_BV = 4352, C_CQ = 4608, C_CK = 5632, C_CV = 5888, C_DQ = 6144, C_DK = 7168, C_DV = 8192;
constexpr size_t MiB = 1u << 20;
constexpr size_t WS_CTL = 0, CTL_ZERO_BYTES = 1 * MiB;
constexpr size_t WS_RS = 1 * MiB;
constexpr size_t WS_ROPE = 2 * MiB;
constexpr size_t WS_PART = 4 * MiB;
constexpr size_t WS_W = 8 * MiB;
constexpr size_t W_IN_B = (size_t)DIN * DM * 2, W_OUT_B = (size_t)DM * DM * 2, W_MI_B = (size_t)DFF * DM * 2, W_MO_B = (size_t)DM * DFF * 2, W_LAYER_B = W_IN_B + W_OUT_B + W_MI_B + W_MO_B;
constexpr size_t WS_XB = WS_W + DEPTH * W_LAYER_B;
constexpr size_t WS_PROJ = WS_XB + (size_t)MTOK * DM * 2;
constexpr size_t WS_MIX = WS_PROJ + (size_t)MTOK * DIN * 2;
constexpr size_t WS_Y = WS_MIX + (size_t)MTOK * DM * 2;
constexpr size_t WS_U = WS_Y + (size_t)MTOK * DM * 2;
constexpr size_t WS_DT = WS_U + (size_t)MTOK * DFF * 2;
constexpr size_t WS_XQ = WS_DT + (size_t)2 * MTOK * 1024 * 4;
constexpr size_t WS_END = WS_XQ + (size_t)MTOK * DM;
constexpr size_t WS_AS = WS_RS + 65536;
constexpr size_t WS_MAS = WS_RS + 196608;
constexpr size_t WS_WQS = WS_RS + 131072;
constexpr int CW_BAR = 4096;
constexpr int RING_BYTES = 131072, LDSCTL_OFF = RING_BYTES, MISC_OFF = LDSCTL_OFF + 320, LDS_BYTES = 147456;
static_assert(att::ATT_LDS <= RING_BYTES, "attention LDS fits the ring region");

#define GAS __attribute__((address_space(1)))
#define LAS __attribute__((address_space(3)))
typedef unsigned short bf16;
typedef unsigned v4u __attribute__((ext_vector_type(4)));
typedef unsigned v2u __attribute__((ext_vector_type(2)));
typedef float f32x4 __attribute__((ext_vector_type(4)));
typedef GAS unsigned gu32;
#define RLX_AGENT __ATOMIC_RELAXED, __HIP_MEMORY_SCOPE_AGENT
#define LDS_WAIT() asm volatile("s_waitcnt lgkmcnt(0)" ::: "memory")
__device__ __forceinline__ unsigned pk2(float lo, float hi) { return pg8::cvt_pk_bf16(lo, hi); }
__device__ __forceinline__ float bf_lo(unsigned w) { return __uint_as_float(w << 16); }
__device__ __forceinline__ float bf_hi(unsigned w) { return __uint_as_float(w & 0xffff0000u); }
__device__ __forceinline__ float wave_sum(float v) {
    v += xsw<1>(v); v += xsw<2>(v); v += xsw<4>(v); v += xsw<8>(v); v += xsw<16>(v);
    return xsum32(v);
}

__device__ __forceinline__ int lane_id() { int l; asm volatile("v_mbcnt_lo_u32_b32 %0, -1, 0\n\tv_mbcnt_hi_u32_b32 %0, -1, %0" : "=v"(l)); return l; }
#define XB_TMO      128
#define XB_XCNT(j)  (256  + 64 * (j))
#define XB_XSUB(j)  (1280 + 64 * (j))
#define XB_XGEN(j)  (2304 + 64 * (j))
#define XB_TOP      3328
#define XB_TOPGEN   3392
#define XCD_BAR_WORDS 3456
#define XB_SPIN_CAP (1u << 18)

__device__ __forceinline__ unsigned xb_ld(unsigned* p)              { return __hip_atomic_load(p, __ATOMIC_RELAXED, __HIP_MEMORY_SCOPE_AGENT); }
__device__ __forceinline__ unsigned xb_add(unsigned* p, unsigned v) { return __hip_atomic_fetch_add(p, v, __ATOMIC_RELAXED, __HIP_MEMORY_SCOPE_AGENT); }
__device__ __forceinline__ unsigned xb_xcc_id() { return (unsigned)__builtin_amdgcn_s_getreg((3 << 11) | 20) & 0xFu; }
#define XB_SPIN(cond, bar) do { unsigned _sp = 0; while (cond) { __builtin_amdgcn_s_sleep(1); \
    if ((++_sp & 255u) == 0u) { if (xb_ld(&(bar)[XB_TMO])) break; if (_sp > XB_SPIN_CAP) { atomicAdd(&(bar)[XB_TMO], 1u); break; } } } } while (0)

struct XcdBarrier {
    unsigned* bar; unsigned x; int w0;
    volatile LAS unsigned* st;
};

__device__ __forceinline__ XcdBarrier xcd_barrier_post(unsigned* bar, volatile LAS unsigned* st) {
    XcdBarrier b; b.bar = bar; b.x = xb_xcc_id(); b.st = st; b.w0 = __builtin_amdgcn_readfirstlane((int)threadIdx.x >> 6);
    if (threadIdx.x == 0) (void)xb_add(&bar[XB_XCNT(b.x)], 1u);
    return b;
}
__device__ __forceinline__ void xcd_barrier_complete(unsigned* bar, unsigned x, unsigned& nloc, unsigned& nx) {
    const unsigned G = gridDim.x * gridDim.y * gridDim.z;
    unsigned sum, cnt, mine, sp = 0u;
    for (;;) {
        sum = 0u; cnt = 0u; mine = 0u;
#pragma unroll
        for (unsigned j = 0; j < 16; ++j) { const unsigned c = xb_ld(&bar[XB_XCNT(j)]); sum += c; cnt += (c > 0u) ? 1u : 0u; mine = (j == x) ? c : mine; }
        if (sum == G) break;
        __builtin_amdgcn_s_sleep(1);
        if ((++sp & 255u) == 0u) { if (xb_ld(&bar[XB_TMO])) break; if (sp > XB_SPIN_CAP) { atomicAdd(&bar[XB_TMO], 1u); break; } }
    }
    nloc = mine > 0u ? mine : 1u; nx = cnt > 0u ? cnt : 1u;
}

__device__ __forceinline__ void xcd_barrier(const XcdBarrier& b) {
    asm volatile("s_waitcnt vmcnt(0)" ::: "memory");
    __syncthreads();
    if (b.w0 == 0 && lane_id() == 0) {
        unsigned* bar = b.bar;
        __builtin_amdgcn_s_waitcnt(0);
        unsigned nloc = b.st[0], nx = b.st[1];
        if (nloc == 0u) { xcd_barrier_complete(bar, b.x, nloc, nx); b.st[0] = nloc; b.st[1] = nx; }
        const unsigned old = xb_add(&bar[XB_XSUB(b.x)], 1u);
        const unsigned gen = old / nloc;
        if (old + 1u == (gen + 1u) * nloc) {
            __builtin_amdgcn_fence(__ATOMIC_RELEASE, "agent");
            asm volatile("s_waitcnt vmcnt(0)" ::: "memory");
            const unsigned og = xb_add(&bar[XB_TOP], 1u);
            const unsigned tg = og / nx;
            if (og + 1u == (tg + 1u) * nx) xb_add(&bar[XB_TOPGEN], 1u);
            else XB_SPIN(xb_ld(&bar[XB_TOPGEN]) == tg, bar);
            __builtin_amdgcn_fence(__ATOMIC_ACQUIRE, "agent");
            xb_add(&bar[XB_XGEN(b.x)], 1u);
            asm volatile("s_waitcnt vmcnt(0)" ::: "memory");
        } else {
            XB_SPIN(xb_ld(&bar[XB_XGEN(b.x)]) == gen, bar);
            __builtin_amdgcn_fence(__ATOMIC_ACQUIRE, "agent");
            asm volatile("s_waitcnt vmcnt(0)" ::: "memory");
        }
    }
    __syncthreads();
}

__device__ __forceinline__ void tr_item(const float* __restrict__ W, int K, int N, const float* __restrict__ gain, bf16* __restrict__ WT, LAS float* scr, int item, int lane) {
    const int nblk = N / 32, kb = item / nblk, nb = item - kb * nblk, k0 = 64 * kb, n0 = 32 * nb;
    f32x4 v[8];
#pragma unroll
    for (int i = 0; i < 8; ++i) { const int kk = 8 * i + (lane >> 3); v[i] = *(const f32x4*)(W + (size_t)(k0 + kk) * N + n0 + (lane & 7) * 4); }
#pragma unroll
    for (int i = 0; i < 8; ++i) { const int kk = 8 * i + (lane >> 3); const float g = gain ? gain[k0 + kk] : 1.f; LAS float* s = scr + kk * 33 + (lane & 7) * 4;
        s[0] = v[i].x * g; s[1] = v[i].y * g; s[2] = v[i].z * g; s[3] = v[i].w * g; }
    LDS_WAIT(); asm volatile("" ::: "memory");
    const int c = lane & 7;
#pragma unroll
    for (int j = 0; j < 4; ++j) { const int n = (lane >> 3) + 8 * j; const LAS float* s = scr + (8 * c) * 33 + n;
        v4u o; o.x = pk2(s[0 * 33], s[1 * 33]); o.y = pk2(s[2 * 33], s[3 * 33]); o.z = pk2(s[4 * 33], s[5 * 33]); o.w = pk2(s[6 * 33], s[7 * 33]);
        *(v4u*)(WT + (size_t)(n0 + n) * K + k0 + 8 * c) = o; }
    LDS_WAIT(); asm volatile("" ::: "memory");
}
template <bool I8>
__device__ __forceinline__ void tr_item8(const float* __restrict__ W, int K, int N, const float* __restrict__ gain, float scale, unsigned char* __restrict__ WT, LAS float* scr, int item, int lane) {
    const int nblk = N / 32, kb = item / nblk, nb = item - kb * nblk, k0 = 64 * kb, n0 = 32 * nb;
    f32x4 v[8];
#pragma unroll
    for (int i = 0; i < 8; ++i) { const int kk = 8 * i + (lane >> 3); v[i] = *(const f32x4*)(W + (size_t)(k0 + kk) * N + n0 + (lane & 7) * 4); }
#pragma unroll
    for (int i = 0; i < 8; ++i) { const int kk = 8 * i + (lane >> 3); const float g = (gain ? gain[k0 + kk] : 1.f) * scale; LAS float* s = scr + kk * 33 + (lane & 7) * 4;
        s[0] = v[i].x * g; s[1] = v[i].y * g; s[2] = v[i].z * g; s[3] = v[i].w * g; }
    LDS_WAIT(); asm volatile("" ::: "memory");
    const int c = lane & 7;
#pragma unroll
    for (int j = 0; j < 4; ++j) { const int n = (lane >> 3) + 8 * j; const LAS float* s = scr + (8 * c) * 33 + n;
        float f[8]; v2u o;
        if (I8) {
#pragma unroll
            for (int q = 0; q < 8; ++q) f[q] = rintf(fminf(fmaxf(s[q * 33], -127.f), 127.f));
            o.x = ((unsigned)(int)f[0] & 255u) | (((unsigned)(int)f[1] & 255u) << 8) | (((unsigned)(int)f[2] & 255u) << 16) | ((unsigned)(int)f[3] << 24);
            o.y = ((unsigned)(int)f[4] & 255u) | (((unsigned)(int)f[5] & 255u) << 8) | (((unsigned)(int)f[6] & 255u) << 16) | ((unsigned)(int)f[7] << 24);
        } else {
#pragma unroll
            for (int q = 0; q < 8; ++q) f[q] = fminf(fmaxf(s[q * 33], -448.f), 448.f);
            o.x = pg8::pk4_fp8(f[0], f[1], f[2], f[3]); o.y = pg8::pk4_fp8(f[4], f[5], f[6], f[7]); }
        *(v2u*)(WT + (size_t)(n0 + n) * K + k0 + 8 * c) = o; }
    LDS_WAIT(); asm volatile("" ::: "memory");
}
__device__ __forceinline__ float wave_max(float v) {
    v = fmaxf(v, xsw<1>(v)); v = fmaxf(v, xsw<2>(v)); v = fmaxf(v, xsw<4>(v)); v = fmaxf(v, xsw<8>(v)); v = fmaxf(v, xsw<16>(v));
    return xmax32(v);
}
__device__ __forceinline__ void row_load(const float* __restrict__ xrow, int lane, f32x4 (&ov)[16]) {
#pragma unroll
    for (int j = 0; j < 16; ++j) ov[j] = *(const f32x4*)(xrow + (lane + 64 * j) * 4);
}
__device__ __forceinline__ void row_to_bf16(const f32x4 (&ov)[16], bf16* __restrict__ orow, float* rs_out, unsigned* __restrict__ xq, float* as_out, int lane) {
    float ss = 0.f, am = 0.f;
#pragma unroll
    for (int j = 0; j < 16; ++j) { const int c = (lane + 64 * j) * 4; const f32x4 v = ov[j];
        ss += (v.x * v.x + v.y * v.y) + (v.z * v.z + v.w * v.w); am = fmaxf(fmaxf(am, fmaxf(fabsf(v.x), fabsf(v.y))), fmaxf(fabsf(v.z), fabsf(v.w)));
        v2u o; o.x = pk2(v.x, v.y); o.y = pk2(v.z, v.w); *(v2u*)(orow + c) = o; }
    ss = wave_sum(ss); am = fmaxf(wave_max(am), 1e-20f); const float qs = 127.0f / am;
#pragma unroll
    for (int j = 0; j < 16; ++j) { const int q0 = (int)rintf(ov[j].x * qs), q1 = (int)rintf(ov[j].y * qs), q2 = (int)rintf(ov[j].z * qs), q3 = (int)rintf(ov[j].w * qs);
        xq[lane + 64 * j] = ((unsigned)q0 & 255u) | (((unsigned)q1 & 255u) << 8) | (((unsigned)q2 & 255u) << 16) | ((unsigned)q3 << 24); }
    if (lane == 0) { *rs_out = 1.0f / sqrtf(ss * (1.0f / DM) + EPS); *as_out = am * (1.0f / 127.0f); }
}
__device__ __forceinline__ void resid_rows(bf16* __restrict__ XB, const bf16* __restrict__ Y, const float* __restrict__ PART, const float* __restrict__ g, float* __restrict__ RS,
                                           float* __restrict__ outf, unsigned* __restrict__ XQ, float* __restrict__ AS, int gw, int NGW, int lane) {
    f32x4 gv[16];
#pragma unroll
    for (int j = 0; j < 16; ++j) gv[j] = *(const f32x4*)(g + (lane + 64 * j) * 4);
    for (int m = gw; m < MTOK; m += NGW) {
        const float pv = PART[(size_t)m * 64 + lane];
        bf16* xrow = XB + (size_t)m * DM; const bf16* yrow = Y + (size_t)m * DM;
        v2u xr[16], yr[16];
#pragma unroll
        for (int j = 0; j < 16; ++j) { xr[j] = *(const v2u*)(xrow + (lane + 64 * j) * 4); yr[j] = *(const v2u*)(yrow + (lane + 64 * j) * 4); }
        const float ry = 1.0f / sqrtf(wave_sum(pv) * (1.0f / DM) + EPS);
        float ss = 0.f, am = 0.f; f32x4 ov[16];
#pragma unroll
        for (int j = 0; j < 16; ++j) { const int c = (lane + 64 * j) * 4;
            f32x4 o; o.x = bf_lo(xr[j].x) + bf_lo(yr[j].x) * ry * gv[j].x; o.y = bf_hi(xr[j].x) + bf_hi(yr[j].x) * ry * gv[j].y; o.z = bf_lo(xr[j].y) + bf_lo(yr[j].y) * ry * gv[j].z; o.w = bf_hi(xr[j].y) + bf_hi(yr[j].y) * ry * gv[j].w;
            ss += (o.x * o.x + o.y * o.y) + (o.z * o.z + o.w * o.w); ov[j] = o; am = fmaxf(fmaxf(am, fmaxf(fabsf(o.x), fabsf(o.y))), fmaxf(fabsf(o.z), fabsf(o.w)));
            if (outf) *(f32x4*)(outf + (size_t)m * DM + c) = o; else { v2u ob; ob.x = pk2(o.x, o.y); ob.y = pk2(o.z, o.w); *(v2u*)(xrow + c) = ob; } }
        if (XQ) {
            am = fmaxf(wave_max(am), 1e-20f); const float qs = 127.0f / am;
#pragma unroll
            for (int j = 0; j < 16; ++j) { const int q0 = (int)rintf(ov[j].x * qs), q1 = (int)rintf(ov[j].y * qs), q2 = (int)rintf(ov[j].z * qs), q3 = (int)rintf(ov[j].w * qs);
                XQ[(size_t)m * (DM / 4) + lane + 64 * j] = ((unsigned)q0 & 255u) | (((unsigned)q1 & 255u) << 8) | (((unsigned)q2 & 255u) << 16) | ((unsigned)q3 << 24); }
            if (lane == 0) AS[m] = am * (1.0f / 127.0f); }
        ss = wave_sum(ss);
        if (lane == 0) RS[m] = 1.0f / sqrtf(ss * (1.0f / DM) + EPS);
    }
}
__device__ __forceinline__ void mixpost_load(const bf16* __restrict__ MIX, const bf16* __restrict__ DT, int tok, int lane, v4u (&mx)[6], v2u (&ab)[4], v2u (&cb)[4]) {
#pragma unroll
    for (int j = 0; j < 6; ++j) mx[j] = *(const v4u*)(MIX + (size_t)tok * DM + (lane + 64 * j) * 8);
#pragma unroll
    for (int h = 0; h < 4; ++h) { const size_t off = (size_t)tok * 1024 + h * 256 + lane * 4; ab[h] = *(const v2u*)(DT + off); cb[h] = *(const v2u*)(DT + (size_t)MTOK * 1024 + off); }
}
__device__ __forceinline__ void mixpost_row(int tok, int lane, const v4u (&mx)[6], const v2u (&ab)[4], const v2u (&cb)[4], float lam, float oscale, f32x4 sg, unsigned char* __restrict__ MQ, float* __restrict__ MAS) {
    f32x4 yd[4]; float am = 0.f;
#pragma unroll
    for (int h = 0; h < 4; ++h) {
        f32x4 a, c; a.x = bf_lo(ab[h].x); a.y = bf_hi(ab[h].x); a.z = bf_lo(ab[h].y); a.w = bf_hi(ab[h].y); c.x = bf_lo(cb[h].x); c.y = bf_hi(cb[h].x); c.z = bf_lo(cb[h].y); c.w = bf_hi(cb[h].y);
        f32x4 d; d.x = a.x - lam * c.x; d.y = a.y - lam * c.y; d.z = a.z - lam * c.z; d.w = a.w - lam * c.w;
        const float ss = wave_sum((d.x * d.x + d.y * d.y) + (d.z * d.z + d.w * d.w)); const float r = oscale / sqrtf(ss * (1.0f / 256.0f) + EPS);
        yd[h].x = d.x * r * sg.x; yd[h].y = d.y * r * sg.y; yd[h].z = d.z * r * sg.z; yd[h].w = d.w * r * sg.w;
        am = fmaxf(fmaxf(am, fmaxf(fabsf(yd[h].x), fabsf(yd[h].y))), fmaxf(fabsf(yd[h].z), fabsf(yd[h].w))); }
    float mv[6][8];
#pragma unroll
    for (int j = 0; j < 6; ++j) { const unsigned w4[4] = {mx[j].x, mx[j].y, mx[j].z, mx[j].w};
#pragma unroll
        for (int e = 0; e < 4; ++e) { mv[j][2 * e] = bf_lo(w4[e]); mv[j][2 * e + 1] = bf_hi(w4[e]); am = fmaxf(am, fmaxf(fabsf(mv[j][2 * e]), fabsf(mv[j][2 * e + 1]))); } }
    am = fmaxf(wave_max(am), 1e-20f); const float qs = 127.0f / am;
    unsigned char* qrow = MQ + (size_t)tok * DM;
#pragma unroll
    for (int j = 0; j < 6; ++j) { int q[8];
#pragma unroll
        for (int e = 0; e < 8; ++e) q[e] = (int)rintf(mv[j][e] * qs);
        v2u o; o.x = ((unsigned)q[0] & 255u) | (((unsigned)q[1] & 255u) << 8) | (((unsigned)q[2] & 255u) << 16) | ((unsigned)q[3] << 24);
        o.y = ((unsigned)q[4] & 255u) | (((unsigned)q[5] & 255u) << 8) | (((unsigned)q[6] & 255u) << 16) | ((unsigned)q[7] << 24);
        *(v2u*)(qrow + (lane + 64 * j) * 8) = o; }
#pragma unroll
    for (int h = 0; h < 4; ++h) { const int q0 = (int)rintf(yd[h].x * qs), q1 = (int)rintf(yd[h].y * qs), q2 = (int)rintf(yd[h].z * qs), q3 = (int)rintf(yd[h].w * qs);
        *(unsigned*)(qrow + 3072 + h * 256 + lane * 4) = ((unsigned)q0 & 255u) | (((unsigned)q1 & 255u) << 8) | (((unsigned)q2 & 255u) << 16) | ((unsigned)q3 << 24); }
    if (lane == 0) MAS[tok] = am * (1.0f / 127.0f);
}
__device__ __forceinline__ int t5_bucket(int rel) {
    const int n = rel < 0 ? -rel : rel; int b;
    if (n < 8) b = n; else { const int l2 = 31 - __builtin_clz((unsigned)(n * n)); b = 8 + (l2 - 6); if (b > 15) b = 15; }
    return b + (rel > 0 ? 16 : 0);
}

constexpr int I_IN = (DM / 128) * (DIN / 32), I_OUT = (DM / 128) * (DM / 32), I_MI = (DM / 128) * (DFF / 32), I_MO = (DFF / 128) * (DM / 32);
struct ItemD { const float* W; const float* gain; unsigned char* WT; float scale; int K, N, r, kind; };
__device__ __forceinline__ void conv_load(const ItemD& d, int lane, f32x4 (&v)[16]) {
    const int nblk = d.N / 32, kb = d.r / nblk, nb = d.r - kb * nblk, k0 = 128 * kb + 16 * (lane >> 3), n0 = 32 * nb + 4 * (lane & 7);
#pragma unroll
    for (int i = 0; i < 16; ++i) v[i] = *(const f32x4*)(d.W + (size_t)(k0 + i) * d.N + n0);
}
template <int KIND>
__device__ __forceinline__ void conv_finish(const ItemD& d, int lane, const f32x4 (&v)[16]) {
    const int nblk = d.N / 32, kb = d.r / nblk, nb = d.r - kb * nblk, k0 = 128 * kb + 16 * (lane >> 3), n0 = 32 * nb + 4 * (lane & 7);
    float gs[16];
    if (d.gain) {
#pragma unroll
        for (int i = 0; i < 4; ++i) { const f32x4 g4 = *(const f32x4*)(d.gain + k0 + 4 * i); gs[4 * i] = g4.x * d.scale; gs[4 * i + 1] = g4.y * d.scale; gs[4 * i + 2] = g4.z * d.scale; gs[4 * i + 3] = g4.w * d.scale; }
    } else {
#pragma unroll
        for (int i = 0; i < 16; ++i) gs[i] = d.scale; }
#pragma unroll
    for (int j = 0; j < 4; ++j) {
        if (KIND == 0) { v4u o0, o1;
            o0.x = pk2(v[0][j] * gs[0], v[1][j] * gs[1]); o0.y = pk2(v[2][j] * gs[2], v[3][j] * gs[3]); o0.z = pk2(v[4][j] * gs[4], v[5][j] * gs[5]); o0.w = pk2(v[6][j] * gs[6], v[7][j] * gs[7]);
            o1.x = pk2(v[8][j] * gs[8], v[9][j] * gs[9]); o1.y = pk2(v[10][j] * gs[10], v[11][j] * gs[11]); o1.z = pk2(v[12][j] * gs[12], v[13][j] * gs[13]); o1.w = pk2(v[14][j] * gs[14], v[15][j] * gs[15]);
            bf16* dst = (bf16*)d.WT + (size_t)(n0 + j) * d.K + k0; *(v4u*)dst = o0; *(v4u*)(dst + 8) = o1;
        } else { unsigned w[4];
#pragma unroll
            for (int t = 0; t < 4; ++t) {
                if (KIND == 1) { int b[4];
#pragma unroll
                    for (int e = 0; e < 4; ++e) { const int bits = __float_as_int(fmaf(v[4 * t + e][j], gs[4 * t + e], 12582912.0f)); b[e] = min(max(bits, 0x4B400000 - 127), 0x4B400000 + 127); }
                    w[t] = __builtin_amdgcn_perm((unsigned)b[1], (unsigned)b[0], 0x0c0c0400u) | __builtin_amdgcn_perm((unsigned)b[3], (unsigned)b[2], 0x04000c0cu);
                } else { float f[4];
#pragma unroll
                    for (int e = 0; e < 4; ++e) f[e] = __builtin_amdgcn_fmed3f(v[4 * t + e][j] * gs[4 * t + e], -448.f, 448.f);
                    w[t] = pg8::pk4_fp8(f[0], f[1], f[2], f[3]); } }
            v4u o; o.x = w[0]; o.y = w[1]; o.z = w[2]; o.w = w[3];
            *(v4u*)(d.WT + (size_t)(n0 + j) * d.K + k0) = o; } }
}
constexpr int CONV_TAIL_ITEMS = 8192;
struct ConvSrc { const float *w_in, *w_out, *w_mlp_in, *w_mlp_out, *ln_attn_pre, *ln_mlp_pre; };
__device__ __forceinline__ int conv_cnt(int t0, int t1, int t) { return (t0 <= t && t < t1) ? (t == 0 ? I_IN : t == 1 ? I_OUT : t == 2 ? I_MI : I_MO) : 0; }
__device__ __forceinline__ void conv_decode(const ConvSrc& cs, unsigned char* ws, float sa_in, float sa_mi, float sa_out, float sb_in, int la, int a0, int a1, int lb, int b0, int b1, int na, int it, ItemD& d) {
    const bool inA = it < na; const int l = inA ? la : lb, t0 = inA ? a0 : b0, t1 = inA ? a1 : b1; int r = inA ? it : it - na; unsigned char* wl = ws + WS_W + (size_t)l * W_LAYER_B;
    const int n0 = conv_cnt(t0, t1, 0), n1 = conv_cnt(t0, t1, 1), n2 = conv_cnt(t0, t1, 2);
    if (r < n0) { d = ItemD{cs.w_in + (size_t)l * DM * DIN, cs.ln_attn_pre + l * DM, wl, inA ? sa_in : sb_in, DM, DIN, r, 1}; return; } r -= n0;
    if (r < n1) { d = ItemD{cs.w_out + (size_t)l * DM * DM, nullptr, wl + W_IN_B, sa_out, DM, DM, r, 1}; return; } r -= n1;
    if (r < n2) { d = ItemD{cs.w_mlp_in + (size_t)l * DM * DFF, cs.ln_mlp_pre + l * DM, wl + W_IN_B + W_OUT_B, sa_mi, DM, DFF, r, 1}; return; } r -= n2;
    d = ItemD{cs.w_mlp_out + (size_t)l * DFF * DM, nullptr, wl + W_IN_B + W_OUT_B + W_MI_B, WMO_SCALE, DFF, DM, r, 2};
}
__device__ __forceinline__ void conv_stream(const ConvSrc& cs, unsigned char* ws, float sa_in, float sa_mi, float sa_out, float sb_in, int la, int a0, int a1, int lb, int b0, int b1, int it0, int it1, int gw, int NGW, int lane) {
    const int na = conv_cnt(a0, a1, 0) + conv_cnt(a0, a1, 1) + conv_cnt(a0, a1, 2) + conv_cnt(a0, a1, 3), nb = conv_cnt(b0, b1, 0) + conv_cnt(b0, b1, 1) + conv_cnt(b0, b1, 2) + conv_cnt(b0, b1, 3), ntot = na + nb;
    const int iend = it1 < ntot ? it1 : ntot;
    for (int it = it0 + gw; it < iend; it += 2 * NGW) { ItemD c0, c1; f32x4 v0[16], v1[16]; const bool two = it + NGW < iend;
        conv_decode(cs, ws, sa_in, sa_mi, sa_out, sb_in, la, a0, a1, lb, b0, b1, na, it, c0); conv_load(c0, lane, v0);
        if (two) { conv_decode(cs, ws, sa_in, sa_mi, sa_out, sb_in, la, a0, a1, lb, b0, b1, na, it + NGW, c1); conv_load(c1, lane, v1); }
        if (c0.kind == 1) conv_finish<1>(c0, lane, v0); else if (c0.kind == 2) conv_finish<2>(c0, lane, v0); else conv_finish<0>(c0, lane, v0);
        if (two) { if (c1.kind == 1) conv_finish<1>(c1, lane, v1); else if (c1.kind == 2) conv_finish<2>(c1, lane, v1); else conv_finish<0>(c1, lane, v1); } }
}

struct Args { const float* in[16]; float* out; unsigned char* ws; int ph_lo, ph_hi, li, pad; };
constexpr int NPHASES = 1 + 9 * DEPTH;

typedef __attribute__((address_space(4))) const Args* CArgs;
#define PH_ENTER() CArgs A_ = (CArgs)__builtin_amdgcn_kernarg_segment_ptr(); asm volatile("" : "+s"(A_)); unsigned char* ws = A_->ws; \
    int wave = wave0; asm volatile("" : "+s"(wave)); int lane = lane_id(); asm volatile("" : "+v"(lane)); const int tid = wave * 64 + lane; (void)tid; \
    const int G = gridDim.x, bx = blockIdx.x, vcu = (G % 8 == 0) ? (bx % 8) * (G / 8) + bx / 8 : bx; const int gw = vcu * NWAVES + wave, NGW = G * NWAVES; (void)lane; (void)gw; (void)NGW; (void)ws; (void)bx;
#define IN_(k) (A_->in[k])

__global__ void __launch_bounds__(NWAVES * 64, 2) mk_fwd(Args args) {
    extern __shared__ __attribute__((aligned(16))) unsigned char lds_raw[];
    LAS unsigned char* lds = (LAS unsigned char*)lds_raw;
    XcdBarrier bar; const int wave0 = __builtin_amdgcn_readfirstlane((int)threadIdx.x >> 6);
    { volatile LAS unsigned* MISC = (volatile LAS unsigned*)(lds + MISC_OFF);
      for (int u = threadIdx.x; u < (LDS_BYTES - LDSCTL_OFF) / 4; u += NWAVES * 64) ((LAS unsigned*)(lds + LDSCTL_OFF))[u] = 0u;
      __syncthreads();
      bar = xcd_barrier_post((unsigned*)(args.ws + WS_CTL) + CW_BAR + args.li * XCD_BAR_WORDS, MISC + 8); }
    const int lo = args.ph_lo, hi = args.ph_hi;
#define IN(k) (lo <= (k) && (k) < hi)
#ifndef PROBE_DUP
#define PROBE_DUP 0
#endif
#define DUPN(bit) (((PROBE_DUP >> (bit)) & 1) ? 2 : 1)
#define SEAM(k) do { if (IN(k) && IN((k) + 1)) xcd_barrier(bar); } while (0)

    if (IN(0)) for (int dup_ = 0; dup_ < DUPN(0); ++dup_) {
        PH_ENTER();
        const float* x_in = IN_(0); const float* ln_attn_pre = IN_(1); const float* ln_mlp_pre = IN_(3); const float* w_in = IN_(5); const float* w_out = IN_(6); const float* w_mlp_in = IN_(14); const float* w_mlp_out = IN_(15);
        float* RS = (float*)(ws + WS_RS); float* ROPE = (float*)(ws + WS_ROPE); bf16* XB = (bf16*)(ws + WS_XB);
        LAS float* scr = (LAS float*)(lds + wave * 16384);
        float wqi0 = 0.f;
        { float am[3 * DEPTH], gm[3 * DEPTH];
#pragma unroll
          for (int t = 0; t < 3 * DEPTH; ++t) { const int l = t / 3, kd = t - 3 * l;
            const float* wsrc = kd == 0 ? w_in + (size_t)l * DM * DIN : kd == 1 ? w_mlp_in + (size_t)l * DM * DFF : w_out + (size_t)l * DM * DM; const float* gs = (kd == 0 ? ln_attn_pre : ln_mlp_pre) + l * DM; float a = 0.f, g = 0.f;
#pragma unroll 8
            for (int i = 0; i < 32; ++i) { const f32x4 v = *(const f32x4*)(wsrc + (size_t)(tid + 512 * i) * 4); a = fmaxf(fmaxf(a, fmaxf(fabsf(v.x), fabsf(v.y))), fmaxf(fabsf(v.z), fabsf(v.w))); }
            if (kd == 2) g = 1.f; else {
#pragma unroll
                for (int i = 0; i < 8; ++i) g = fmaxf(g, fabsf(gs[tid + 512 * i])); }
            am[t] = wave_max(a); gm[t] = wave_max(g); }
          LAS float* red = (LAS float*)(lds + 131072 - 1024);
          __syncthreads();
          if (lane == 0) {
#pragma unroll
            for (int t = 0; t < 3 * DEPTH; ++t) { red[t * 16 + wave] = am[t]; red[t * 16 + 8 + wave] = gm[t]; } }
          __syncthreads();
#pragma unroll
          for (int t = 0; t < 3 * DEPTH; ++t) { float a2 = 0.f, g2 = 0.f;
#pragma unroll
            for (int w = 0; w < 8; ++w) { a2 = fmaxf(a2, red[t * 16 + w]); g2 = fmaxf(g2, red[t * 16 + 8 + w]); }
            const float amax = fmaxf(a2 * g2 * 1.0f, 1e-20f); if (t == 0) wqi0 = 127.0f / amax;
            if (bx == 0 && tid == 0) { ((float*)(ws + WS_WQS))[t] = amax * (1.0f / 127.0f); ((float*)(ws + WS_WQS))[8 + t] = 127.0f / amax; } } }
        { const ConvSrc cs{w_in, w_out, w_mlp_in, w_mlp_out, ln_attn_pre, ln_mlp_pre};
          conv_stream(cs, ws, wqi0, 0.f, 0.f, 0.f, 0, 0, 1, 0, 0, 0, 0, 1 << 30, gw, NGW, lane); }
        if (gw < MTOK) {
            const int n = (MTOK - gw + NGW - 1) / NGW, lastm = gw + (n - 1) * NGW; f32x4 rA[16], rB[16];
#define ROW_OUT(m_, r_) row_to_bf16(r_, XB + (size_t)(m_) * DM, RS + (m_), (unsigned*)(ws + WS_XQ) + (size_t)(m_) * (DM / 4), (float*)(ws + WS_AS) + (m_), lane)
            row_load(x_in + (size_t)gw * DM, lane, rA);
            for (int k = 0; k < n; k += 2) { const int m1 = min(gw + (k + 1) * NGW, lastm), m2 = min(gw + (k + 2) * NGW, lastm);
                row_load(x_in + (size_t)m1 * DM, lane, rB); ROW_OUT(gw + k * NGW, rA);
                row_load(x_in + (size_t)m2 * DM, lane, rA); ROW_OUT(m1, rB); }
#undef ROW_OUT
        }
        for (int i = gw * 64 + lane; i < SEQ * 64; i += NGW * 64) { const int pos = i >> 6, pi = i & 63, j = pi & 31; const float p = (float)((pi < 32) ? (pos >> 6) : (pos & 63));
            const float inv = exp2f(-(float)j * (13.287712379549449f / 32.0f)); float t = (p * inv) * 0.15915494309189535f; t -= floorf(t);
            ROPE[2 * i] = __builtin_amdgcn_cosf(t); ROPE[2 * i + 1] = __builtin_amdgcn_sinf(t); }
    }
    SEAM(0);

    for (int l = 0; l < DEPTH; ++l) {
        const int pb = 1 + 9 * l;

        if (IN(pb + 0)) for (int dup_ = 0; dup_ < DUPN(1); ++dup_) {
            PH_ENTER();
            const bf16* Win_t = (const bf16*)(ws + WS_W + (size_t)l * W_LAYER_B);
            pg8::Gemm g{(const bf16*)(ws + WS_XQ), Win_t, MTOK, DIN, DM / 2}; pg8::StaticOrder S; S.init(MTOK, DIN, G, bx);
            pg8::EpiProjI8 E{(bf16*)(ws + WS_PROJ), DIN, (const float*)(ws + WS_RS), (const float*)(ws + WS_AS), (const float*)(ws + WS_WQS) + 3 * l, (LAS float*)(lds + RING_BYTES + 1024), IN_(8) + l * 128, IN_(9) + l * 128, (const float*)(ws + WS_ROPE), SEQ};
            pg8::gemm_phase<pg8::EpiProjI8, pg8::StaticOrder, true, true, 2>(lds, g, S, E, tid);
            { const int nwg = (MTOK / 256) * (DIN / 256), rem = nwg % G;
              if (dup_ == 0 && rem > 0 && bx >= rem) { const float* qsc = (const float*)(ws + WS_WQS) + 8; const ConvSrc cs{IN_(5), IN_(6), IN_(14), IN_(15), IN_(1), IN_(3)};
                  conv_stream(cs, ws, 0.f, qsc[3 * l + 1], qsc[3 * l + 2], (l + 1 < DEPTH) ? qsc[3 * l + 3] : 0.f, l, 1, 4, l + 1, 0, (l + 1 < DEPTH) ? 1 : 0, 0, CONV_TAIL_ITEMS, (bx - rem) * NWAVES + wave, (G - rem) * NWAVES, lane); }
            }
        }
        SEAM(pb + 0);


        if (IN(pb + 2)) for (int dup_ = 0; dup_ < DUPN(3); ++dup_) {
            PH_ENTER();
            const bf16* PROJ = (const bf16*)(ws + WS_PROJ); bf16* MIX = (bf16*)(ws + WS_MIX); bf16* DT = (bf16*)(ws + WS_DT);
            const float* na_rpb = IN_(7); const float* sw_sink = IN_(10); const float* t5_table = IN_(13);
            LAS float* tab = (LAS float*)(lds + att::OFF_TAB);
            const int cslot = vcu % 5; int ui = 0;
            for (int s = vcu; s < 1280; s += G, ++ui) {
                if (ui == cslot) {
                    CArgs A2 = (CArgs)__builtin_amdgcn_kernarg_segment_ptr(); asm volatile("" : "+s"(A2)); unsigned char* ws2 = A2->ws;
                    int wv2 = wave0; asm volatile("" : "+s"(wv2)); int ln2 = lane_id(); asm volatile("" : "+v"(ln2)); const int gw2 = vcu * NWAVES + wv2;
                    const float* qsc = (const float*)(ws2 + WS_WQS) + 8;
                    const ConvSrc cs{A2->in[5], A2->in[6], A2->in[14], A2->in[15], A2->in[1], A2->in[3]};
                    conv_stream(cs, ws2, 0.f, qsc[3 * l + 1], qsc[3 * l + 2], (l + 1 < DEPTH) ? qsc[3 * l + 3] : 0.f, l, 1, 4, l + 1, 0, (l + 1 < DEPTH) ? 1 : 0, (((MTOK / 256) * (DIN / 256)) % G) ? CONV_TAIL_ITEMS : 0, 1 << 30, gw2, NGW, ln2); }
                const int kind = s >> 8, v = s & 255; int t2 = wave * 64 + lane_id(); asm volatile("" : "+v"(t2));
                const bf16 *Qp, *Kp; int vdelta, mode, kbeg = 0, nkeys = SEQ, qt = v & 7; float sink = 0.f; void* Op;
                if (kind == 0) {
                    const int b = v >> 6, hq = (v >> 3) & 7; mode = att::MODE_B;
                    const bf16* base = PROJ + (size_t)(b * SEQ) * DIN;
                    Qp = base + (size_t)(qt * 256) * DIN + C_BQ + hq * 128; Kp = base + C_BK + (hq >> 2) * 128; vdelta = C_BV - C_BK;
                    Op = MIX + (size_t)(b * SEQ + qt * 256) * DM + 1024 + hq * 128;
                } else if (kind <= 2) {
                    const int u = v + 256 * (kind - 1), b = u >> 7, h = (u >> 5) & 3, sm = (u >> 4) & 1, vh = (u >> 3) & 1; mode = att::MODE_D;
                    const bf16* base = PROJ + (size_t)(b * SEQ) * DIN;
                    Qp = base + (size_t)(qt * 256) * DIN + C_DQ + sm * 512 + h * 128; Kp = base + C_DK + sm * 512 + h * 128; vdelta = (C_DV + h * 256 + vh * 128) - (C_DK + sm * 512 + h * 128);
                    Op = DT + (size_t)sm * MTOK * 1024 + (size_t)(b * SEQ + qt * 256) * 1024 + h * 256 + vh * 128;
                    for (int i = t2; i < 768; i += NWAVES * 64) tab[i] = t5_table[t5_bucket(i - att::TREL) * 12 + 8 + h] * att::INV_SCALE;
                } else if (kind == 3) {
                    const int b = v >> 6, h = (v >> 3) & 7; mode = att::MODE_A;
                    int rlo = min(max(4 * qt - 4, 0), 24), rhi = min(max(4 * qt + 3 - 4, 0), 24) + 8;
                    if ((rhi - rlo) & 1) { if (rlo > 0) --rlo; else ++rhi; }
                    kbeg = rlo * 64; nkeys = (rhi - rlo) * 64;
                    const bf16* base = PROJ + (size_t)(b * SEQ) * DIN;
                    Qp = base + (size_t)(qt * 256) * DIN + C_AQ + h * 128; Kp = base + (size_t)kbeg * DIN + C_AK + h * 128; vdelta = C_AV - C_AK;
                    Op = MIX + (size_t)(b * SEQ + qt * 256) * DM + h * 128;
                    const float* rp = na_rpb + ((size_t)l * 8 + h) * 15 * 31;
                    for (int i = t2; i < 15 * 128; i += NWAVES * 64) { const int dr = i >> 7, dc = (i & 127) - 48; tab[i] = (dc >= 0 && dc < 31) ? rp[dr * 31 + dc] * att::INV_SCALE : 0.f; }
                } else {
                    const int b = v >> 6, hq = (v >> 3) & 7; qt = (v + 4) & 7; mode = att::MODE_C;
                    kbeg = max(0, qt * 256 - 128); const int kend = min(SEQ, qt * 256 + 256 + 128); nkeys = kend - kbeg;
                    const bf16* base = PROJ + (size_t)(b * SEQ) * DIN;
                    Qp = base + (size_t)(qt * 256) * DIN + C_CQ + hq * 128; Kp = base + (size_t)kbeg * DIN + C_CK + (hq >> 2) * 128; vdelta = C_CV - C_CK;
                    Op = MIX + (size_t)(b * SEQ + qt * 256) * DM + 2048 + hq * 128;
                    sink = sw_sink[l * 8 + hq];
                    for (int i = t2; i < 768; i += NWAVES * 64) { const int rel = i - att::TREL; tab[i] = (rel >= -128 && rel <= 128) ? t5_table[t5_bucket(rel) * 12 + hq] * att::INV_SCALE : att::MASKV; }
                }
                att::attn_unit<DIN>(Qp, Kp, vdelta, nkeys, mode, kbeg, qt * 256, (const LAS float*)tab, sink, Op, (att::lptr)lds, t2);
            }
            if (ui <= cslot) {
                int ln3 = lane_id(); asm volatile("" : "+v"(ln3)); const float* qsc = (const float*)(ws + WS_WQS) + 8;
                const ConvSrc cs{IN_(5), IN_(6), IN_(14), IN_(15), IN_(1), IN_(3)};
                conv_stream(cs, ws, 0.f, qsc[3 * l + 1], qsc[3 * l + 2], (l + 1 < DEPTH) ? qsc[3 * l + 3] : 0.f, l, 1, 4, l + 1, 0, (l + 1 < DEPTH) ? 1 : 0, (((MTOK / 256) * (DIN / 256)) % G) ? CONV_TAIL_ITEMS : 0, 1 << 30, gw, NGW, ln3); }
        }
        SEAM(pb + 2);

        if (IN(pb + 3)) for (int dup_ = 0; dup_ < DUPN(4); ++dup_) {
            PH_ENTER();
            const bf16* DT = (const bf16*)(ws + WS_DT); const bf16* MIX = (const bf16*)(ws + WS_MIX); unsigned char* MQ = ws + WS_XQ; float* MAS = (float*)(ws + WS_MAS);
            const float lam_init = 0.8f - 0.6f * expf(-0.3f * (float)l);
            const float* lp = IN_(11) + l * 512;
            const float s1 = wave_sum(lp[lane] * lp[128 + lane] + lp[64 + lane] * lp[192 + lane]), s2 = wave_sum(lp[256 + lane] * lp[384 + lane] + lp[320 + lane] * lp[448 + lane]);
            const float lam = expf(s1) - expf(s2) + lam_init, oscale = 1.0f - lam_init;
            const f32x4 sg = *(const f32x4*)(IN_(12) + l * 256 + lane * 4);
            { const int n = (MTOK - gw + NGW - 1) / NGW, lastt = gw + (n - 1) * NGW;
              v4u mxA[6], mxB[6]; v2u abA[4], cbA[4], abB[4], cbB[4];
              mixpost_load(MIX, DT, gw, lane, mxA, abA, cbA);
              for (int k = 0; k < n; k += 2) {
                  mixpost_load(MIX, DT, min(gw + (k + 1) * NGW, lastt), lane, mxB, abB, cbB);
                  mixpost_row(gw + k * NGW, lane, mxA, abA, cbA, lam, oscale, sg, MQ, MAS);
                  mixpost_load(MIX, DT, min(gw + (k + 2) * NGW, lastt), lane, mxA, abA, cbA);
                  mixpost_row(min(gw + (k + 1) * NGW, lastt), lane, mxB, abB, cbB, lam, oscale, sg, MQ, MAS);
              } }
        }
        SEAM(pb + 3);

        if (IN(pb + 4)) for (int dup_ = 0; dup_ < DUPN(5); ++dup_) {
            PH_ENTER();
            const bf16* Wout_t = (const bf16*)(ws + WS_W + (size_t)l * W_LAYER_B + W_IN_B);
            pg8::Gemm g{(const bf16*)(ws + WS_XQ), Wout_t, MTOK, DM, DM / 2}; pg8::StaticOrder S; S.init(MTOK, DM, G, bx);
            pg8::EpiYStats<true> E{(bf16*)(ws + WS_Y), DM, (float*)(ws + WS_PART), 1.0f, (const float*)(ws + WS_MAS), (const float*)(ws + WS_WQS) + 3 * l + 2};
            pg8::gemm_phase<pg8::EpiYStats<true>, pg8::StaticOrder, true, true, 2>(lds, g, S, E, tid);
        }
        SEAM(pb + 4);

        if (IN(pb + 5)) {
            PH_ENTER();
            resid_rows((bf16*)(ws + WS_XB), (const bf16*)(ws + WS_Y), (const float*)(ws + WS_PART), IN_(2) + l * DM, (float*)(ws + WS_RS), nullptr, (unsigned*)(ws + WS_XQ), (float*)(ws + WS_AS), gw, NGW, lane);
        }
        SEAM(pb + 5);

        if (IN(pb + 6)) for (int dup_ = 0; dup_ < DUPN(7); ++dup_) {
            PH_ENTER();
            const bf16* Wmi_t = (const bf16*)(ws + WS_W + (size_t)l * W_LAYER_B + W_IN_B + W_OUT_B);
            pg8::Gemm g{(const bf16*)(ws + WS_XQ), Wmi_t, MTOK, DFF, DM / 2}; pg8::StaticOrder S; S.init(MTOK, DFF, G, bx);
            pg8::EpiRelu2Fp8<true> E{(unsigned char*)(ws + WS_U), DFF, (const float*)(ws + WS_RS), (const float*)(ws + WS_AS), (const float*)(ws + WS_WQS) + 3 * l + 1, U_SCALE};
            pg8::gemm_phase<pg8::EpiRelu2Fp8<true>, pg8::StaticOrder, true, true, 2>(lds, g, S, E, tid);
        }
        SEAM(pb + 6);

        if (IN(pb + 7)) for (int dup_ = 0; dup_ < DUPN(8); ++dup_) {
            PH_ENTER();
            const bf16* Wmo_t = (const bf16*)(ws + WS_W + (size_t)l * W_LAYER_B + W_IN_B + W_OUT_B + W_MI_B);
            pg8::Gemm g{(const bf16*)(ws + WS_U), Wmo_t, MTOK, DM, DFF / 2}; pg8::StaticOrder S; S.init(MTOK, DM, G, bx);
            pg8::EpiYStats<false> E{(bf16*)(ws + WS_Y), DM, (float*)(ws + WS_PART), 1.0f / (U_SCALE * WMO_SCALE), nullptr, nullptr};
            pg8::gemm_phase<pg8::EpiYStats<false>, pg8::StaticOrder, true, true, 1>(lds, g, S, E, tid);
        }
        SEAM(pb + 7);

        if (IN(pb + 8)) {
            PH_ENTER();
            resid_rows((bf16*)(ws + WS_XB), (const bf16*)(ws + WS_Y), (const float*)(ws + WS_PART), IN_(4) + l * DM, (float*)(ws + WS_RS), (l == DEPTH - 1) ? A_->out : nullptr, (l == DEPTH - 1) ? nullptr : (unsigned*)(ws + WS_XQ), (float*)(ws + WS_AS), gw, NGW, lane);
        }
        SEAM(pb + 8);
    }
#undef IN
#undef SEAM
}

#ifndef MK_PER_PHASE
#define MK_PER_PHASE 0
#endif
extern "C" void kernel_launch(void* const* d_in, const int* in_sizes, int n_in, void* d_out, int out_size, void* d_ws, size_t ws_size, hipStream_t stream) {
    static int grid = 0;
    if (grid == 0) {
        if (n_in != 16 || in_sizes[0] != MTOK * DM || out_size != MTOK * DM || ws_size < WS_END) {
            fprintf(stderr, "kernel_launch: shape mismatch: n_in %d in0 %d out %d ws %zu (need %zu); nothing launched\n", n_in, n_in > 0 ? in_sizes[0] : -1, out_size, ws_size, (size_t)WS_END); grid = -1; return; }
        int dev = 0, cus = 0, per_cu = 0;
        if (hipGetDevice(&dev) != hipSuccess || hipDeviceGetAttribute(&cus, hipDeviceAttributeMultiprocessorCount, dev) != hipSuccess) { fprintf(stderr, "kernel_launch: device query failed\n"); grid = -1; return; }
        if (hipFuncSetAttribute((const void*)mk_fwd, hipFuncAttributeMaxDynamicSharedMemorySize, LDS_BYTES) != hipSuccess) { fprintf(stderr, "kernel_launch: hipFuncSetAttribute failed\n"); grid = -1; return; }
        if (hipOccupancyMaxActiveBlocksPerMultiprocessor(&per_cu, (const void*)mk_fwd, NWAVES * 64, LDS_BYTES) != hipSuccess || per_cu < 1)
            fprintf(stderr, "kernel_launch: note: occupancy query reports %d workgroups per CU\n", per_cu);
        (void)hipGetLastError();
        grid = cus;
    }
    if (grid < 0) return;
    if (hipMemsetAsync((char*)d_ws + WS_CTL, 0, CTL_ZERO_BYTES, stream) != hipSuccess) { fprintf(stderr, "kernel_launch: memset failed\n"); return; }
    Args a{};
    for (int i = 0; i < 16; ++i) a.in[i] = (const float*)d_in[i];
    a.out = (float*)d_out; a.ws = (unsigned char*)d_ws; a.pad = 0;
#if MK_PER_PHASE
    for (int p = 0; p < NPHASES; ++p) { a.ph_lo = p; a.ph_hi = p + 1; a.li = p; hipLaunchKernelGGL(mk_fwd, dim3(grid), dim3(NWAVES * 64), LDS_BYTES, stream, a); }
#else
    a.ph_lo = 0; a.ph_hi = NPHASES; a.li = 0;
    hipLaunchKernelGGL(mk_fwd, dim3(grid), dim3(NWAVES * 64), LDS_BYTES, stream, a);
#endif
    const hipError_t le = hipPeekAtLastError();
    if (le != hipSuccess) fprintf(stderr, "kernel_launch: launch failed: %s\n", hipGetErrorName(le));
}
```

```cpp
#include <hip/hip_runtime.h>
#include <cstdio>
#include <cstdint>

template <int O> __device__ __forceinline__ float xsw(float v) { return __int_as_float(__builtin_amdgcn_ds_swizzle(__float_as_int(v), (O << 10) | 0x1f)); }
__device__ __forceinline__ float xsum32(float v) { auto rr = __builtin_amdgcn_permlane32_swap(__float_as_uint(v), __float_as_uint(v), false, false); return __uint_as_float(rr[0]) + __uint_as_float(rr[1]); }
__device__ __forceinline__ float xmax32(float v) { auto rr = __builtin_amdgcn_permlane32_swap(__float_as_uint(v), __float_as_uint(v), false, false); return fmaxf(__uint_as_float(rr[0]), __uint_as_float(rr[1])); }
namespace pg8 {
#define PG8_LAS __attribute__((address_space(3)))
typedef unsigned short bf16_t;
typedef short bf16x8 __attribute__((ext_vector_type(8)));
typedef float f32x4 __attribute__((ext_vector_type(4)));
typedef unsigned u32x4 __attribute__((ext_vector_type(4)));
typedef int i32x4 __attribute__((ext_vector_type(4)));
typedef int i32x8 __attribute__((ext_vector_type(8)));
typedef unsigned u32x2 __attribute__((ext_vector_type(2)));
constexpr int BM = 256, BK = 64, HALF = 128, HTB = HALF * BK * 2  , STAGE_BYTES = 8 * HTB, NXCD = 8, WGM = 4;

__host__ __device__ __forceinline__ int lds_byte(int r, int c) { const int st = (r >> 4) * 2 + (c >> 5), rr = r & 15, cc = c & 31, ob = rr * 64 + cc * 2; return st * 1024 + (ob ^ (((ob >> 9) & 1) << 5)); }
__host__ __device__ __forceinline__ void stage_rc(int b, int& R, int& C) { const int st = b / 1024, sb = b % 1024, swz = sb ^ (((sb >> 9) & 1) << 5); R = (st >> 1) * 16 + swz / 64; C = (st & 1) * 32 + (swz % 64) / 2; }
__host__ __device__ __forceinline__ int perm32(int rho) { const int n = rho >> 4, i = rho & 15; return 8 * (i >> 2) + 4 * n + (i & 3); }

struct Unit { int pm, pn; };
struct Gemm { const bf16_t* A; const bf16_t* Bt; int M, N, K; };

struct StaticOrder {
    int nM, nN, nwg, G, c;
    __host__ __device__ void init(int M, int N, int G_, int c_) { nM = M / BM; nN = N / BM; nwg = nM * nN; G = G_; c = c_; }
    __host__ __device__ bool next(int i, Unit& u) const {
        const long L = (long)i * G + c; if (L >= nwg) return false;
        int wgid = (int)L; { const int q = nwg / NXCD, r = nwg % NXCD, xcd = wgid % NXCD, off = wgid / NXCD; wgid = (xcd < r ? xcd * (q + 1) : r * (q + 1) + (xcd - r) * q) + off; }
        const int nig = WGM * nN, gid = wgid / nig, fm = gid * WGM, gsz = (nM - fm) < WGM ? (nM - fm) : WGM;
        u.pm = fm + ((wgid % nig) % gsz); u.pn = (wgid % nig) / gsz; return true;
    }
    __device__ __forceinline__ void a_ready(const Unit&) const {}
    __device__ __forceinline__ void done(const Unit&) const {}
};


__device__ __forceinline__ unsigned cvt_pk_bf16(float lo, float hi) { unsigned r; asm volatile("v_cvt_pk_bf16_f32 %0, %1, %2" : "=v"(r) : "v"(lo), "v"(hi)); return r; }

template <int ACT> struct EpiRowScale {
    static constexpr bool PERM = true, AFTER_DRAIN = false;
    bf16_t* O; int ldc; const float* rs;
    __device__ __forceinline__ void operator()(const f32x4 (&acc)[2][2][4][2], const Unit& u, int wr, int wc, int fr, int fq) const {
        asm volatile("" : "+v"(fr), "+v"(fq));
        const int row0 = u.pm * BM + wr * 64 + fr, col0 = u.pn * BM + wc * 32 + 8 * fq;
#pragma unroll
        for (int ai = 0; ai < 2; ++ai)
#pragma unroll
            for (int m = 0; m < 4; ++m) { const int row = row0 + ai * HALF + m * 16; const float s = rs[row]; bf16_t* rowp = O + (size_t)row * ldc + col0;
#pragma unroll
                for (int bj = 0; bj < 2; ++bj) { f32x4 v0 = acc[ai][bj][m][0] * s, v1 = acc[ai][bj][m][1] * s;
                    if (ACT == 1) {
#pragma unroll
                        for (int j = 0; j < 4; ++j) { const float a = fmaxf(v0[j], 0.f), b = fmaxf(v1[j], 0.f); v0[j] = a * a; v1[j] = b * b; } }
                    u32x4 w; w.x = cvt_pk_bf16(v0[0], v0[1]); w.y = cvt_pk_bf16(v0[2], v0[3]); w.z = cvt_pk_bf16(v1[0], v1[1]); w.w = cvt_pk_bf16(v1[2], v1[3]);
                    *(u32x4*)(rowp + bj * HALF) = w; } }
    }
};
template <bool INT> struct EpiYStats {
    static constexpr bool PERM = true, AFTER_DRAIN = false;
    bf16_t* O; int ldc; float* part; float sc; const float* as; const float* wsc;
    __device__ __forceinline__ void operator()(const f32x4 (&acc)[2][2][4][2], const Unit& u, int wr, int wc, int fr, int fq) const {
        asm volatile("" : "+v"(fr), "+v"(fq));
        const int row0 = u.pm * BM + wr * 64 + fr, col0 = u.pn * BM + wc * 32 + 8 * fq;
#pragma unroll
        for (int ai = 0; ai < 2; ++ai)
#pragma unroll
            for (int m = 0; m < 4; ++m) { const int row = row0 + ai * HALF + m * 16; bf16_t* rowp = O + (size_t)row * ldc + col0; float ss = 0.f; const float s = INT ? as[row] * wsc[0] : sc;
#pragma unroll
                for (int bj = 0; bj < 2; ++bj) { f32x4 v0, v1;
#pragma unroll
                    for (int j = 0; j < 4; ++j) { v0[j] = (INT ? (float)__float_as_int(acc[ai][bj][m][0][j]) : acc[ai][bj][m][0][j]) * s; v1[j] = (INT ? (float)__float_as_int(acc[ai][bj][m][1][j]) : acc[ai][bj][m][1][j]) * s; }
                    ss += (v0[0] * v0[0] + v0[1] * v0[1]) + (v0[2] * v0[2] + v0[3] * v0[3]) + (v1[0] * v1[0] + v1[1] * v1[1]) + (v1[2] * v1[2] + v1[3] * v1[3]);
                    u32x4 w; w.x = cvt_pk_bf16(v0[0], v0[1]); w.y = cvt_pk_bf16(v0[2], v0[3]); w.z = cvt_pk_bf16(v1[0], v1[1]); w.w = cvt_pk_bf16(v1[2], v1[3]);
                    *(u32x4*)(rowp + bj * HALF) = w; }
                ss += xsw<16>(ss); ss = xsum32(ss);
                if (fq == 0) part[(size_t)row * 64 + u.pn * 4 + wc] = ss; }
    }
};


__device__ __forceinline__ unsigned pk4_fp8(float a, float b, float c, float d) { int r = __builtin_amdgcn_cvt_pk_fp8_f32(a, b, 0, false); r = __builtin_amdgcn_cvt_pk_fp8_f32(c, d, r, true); return (unsigned)r; }
template <bool INT> struct EpiRelu2Fp8 {
    static constexpr bool PERM = true, AFTER_DRAIN = false;
    unsigned char* O; int ldc; const float* rs; const float* as; const float* wsc; float us;
    __device__ __forceinline__ void operator()(const f32x4 (&acc)[2][2][4][2], const Unit& u, int wr, int wc, int fr, int fq) const {
        asm volatile("" : "+v"(fr), "+v"(fq));
        const int row0 = u.pm * BM + wr * 64 + fr, col0 = u.pn * BM + wc * 32 + 8 * fq;
        const float winv = INT ? wsc[0] : 1.f;
#pragma unroll
        for (int ai = 0; ai < 2; ++ai)
#pragma unroll
            for (int m = 0; m < 4; ++m) { const int row = row0 + ai * HALF + m * 16; const float s = INT ? rs[row] * (as[row] * winv) : rs[row]; unsigned char* rowp = O + (size_t)row * ldc + col0;
#pragma unroll
                for (int bj = 0; bj < 2; ++bj) { f32x4 v0, v1;
#pragma unroll
                    for (int j = 0; j < 4; ++j) { const float x0 = INT ? (float)__float_as_int(acc[ai][bj][m][0][j]) : acc[ai][bj][m][0][j], x1 = INT ? (float)__float_as_int(acc[ai][bj][m][1][j]) : acc[ai][bj][m][1][j];
                        const float a = fmaxf(x0 * s, 0.f), b = fmaxf(x1 * s, 0.f); v0[j] = fminf(a * a * us, 448.f); v1[j] = fminf(b * b * us, 448.f); }
                    u32x2 w; w.x = pk4_fp8(v0[0], v0[1], v0[2], v0[3]); w.y = pk4_fp8(v1[0], v1[1], v1[2], v1[3]);
                    *(u32x2*)(rowp + bj * HALF) = w; } }
    }
};


struct EpiProjI8 {
    static constexpr bool PERM = true, AFTER_DRAIN = false;
    bf16_t* O; int ldc; const float* rs; const float* as; const float* wsc; PG8_LAS float* T; const float* qn; const float* kn; const float* rope; int seq;
    __device__ __forceinline__ void operator()(const f32x4 (&acc)[2][2][4][2], const Unit& u, int wr, int wc, int fr, int fq) const {
        asm volatile("" : "+v"(fr), "+v"(fq));
        const int row0 = u.pm * BM + wr * 64 + fr, col0 = u.pn * BM + wc * 32 + 8 * fq;
        const float winv = wsc[0];
        const bool bt = (u.pn >= 12 && u.pn <= 16);
        if (bt) {
#pragma unroll
            for (int ai = 0; ai < 2; ++ai)
#pragma unroll
                for (int m = 0; m < 4; ++m) { const int lr = ai * HALF + wr * 64 + m * 16 + fr; const float s = rs[row0 + ai * HALF + m * 16] * (as[row0 + ai * HALF + m * 16] * winv);
#pragma unroll
                    for (int bj = 0; bj < 2; ++bj) { float ss = 0.f;
#pragma unroll
                        for (int j = 0; j < 4; ++j) { const float a = (float)__float_as_int(acc[ai][bj][m][0][j]) * s, b = (float)__float_as_int(acc[ai][bj][m][1][j]) * s; ss += a * a + b * b; }
                        ss += xsw<16>(ss); ss = xsum32(ss);
                        if (fq == 0) T[(lr * 2 + bj) * 4 + wc] = ss; } }
            asm volatile("s_waitcnt lgkmcnt(0)" ::: "memory"); __builtin_amdgcn_s_barrier(); asm volatile("" ::: "memory");
        }
        const float* gn = (u.pn == 16) ? kn : qn; f32x4 g0 = {1.f, 1.f, 1.f, 1.f}, g1 = {1.f, 1.f, 1.f, 1.f};
        if (bt) { g0 = *(const f32x4*)(gn + wc * 32 + 8 * fq); g1 = *(const f32x4*)(gn + wc * 32 + 8 * fq + 4); }
#pragma unroll
        for (int ai = 0; ai < 2; ++ai)
#pragma unroll
            for (int m = 0; m < 4; ++m) { const int row = row0 + ai * HALF + m * 16; const float s = rs[row] * (as[row] * winv); bf16_t* rowp = O + (size_t)row * ldc + col0;
                f32x4 c0 = {1.f, 0.f, 1.f, 0.f}, c1 = {1.f, 0.f, 1.f, 0.f};
                if (bt) { const float* cs = rope + ((size_t)(row & (seq - 1)) * 64 + wc * 16 + fq * 4) * 2; c0 = *(const f32x4*)cs; c1 = *(const f32x4*)(cs + 4); }
#pragma unroll
                for (int bj = 0; bj < 2; ++bj) { f32x4 v0, v1;
#pragma unroll
                    for (int j = 0; j < 4; ++j) { v0[j] = (float)__float_as_int(acc[ai][bj][m][0][j]) * s; v1[j] = (float)__float_as_int(acc[ai][bj][m][1][j]) * s; }
                    if (bt) { const int lr = ai * HALF + wr * 64 + m * 16 + fr; const f32x4 t = *(const PG8_LAS f32x4*)(T + (lr * 2 + bj) * 4);
                        const float r = 1.0f / sqrtf(((t[0] + t[1]) + (t[2] + t[3])) * (1.0f / 128.0f) + 1e-6f);
                        v0 = v0 * r * g0; v1 = v1 * r * g1;
                        f32x4 w0, w1;
                        w0[0] = v0[0] * c0[0] - v0[1] * c0[1]; w0[1] = v0[0] * c0[1] + v0[1] * c0[0]; w0[2] = v0[2] * c0[2] - v0[3] * c0[3]; w0[3] = v0[2] * c0[3] + v0[3] * c0[2];
                        w1[0] = v1[0] * c1[0] - v1[1] * c1[1]; w1[1] = v1[0] * c1[1] + v1[1] * c1[0]; w1[2] = v1[2] * c1[2] - v1[3] * c1[3]; w1[3] = v1[2] * c1[3] + v1[3] * c1[2];
                        v0 = w0; v1 = w1; }
                    u32x4 w; w.x = cvt_pk_bf16(v0[0], v0[1]); w.y = cvt_pk_bf16(v0[2], v0[3]); w.z = cvt_pk_bf16(v1[0], v1[1]); w.w = cvt_pk_bf16(v1[2], v1[3]);
                    *(u32x4*)(rowp + bj * HALF) = w; } }
    }
};
template <class Epi, class Sched, bool ALIGN_EPI = false, bool SP2 = false, int DT = 0>
__device__ __forceinline__ void gemm_phase(PG8_LAS unsigned char* lds, const Gemm g, const Sched& S, const Epi& E, int tid_in) {
    int tid_o = tid_in; asm volatile("" : "+v"(tid_o));
    const int tid = tid_o, wid = __builtin_amdgcn_readfirstlane(tid >> 6), lane = tid & 63, wr = wid >> 2, wc = wid & 3, fr = lane & 15, fq = lane >> 4;
    const int K = g.K, nt = K / BK;
    unsigned voffA[2], voffB[2];
#pragma unroll
    for (int i = 0; i < 2; ++i) { int R, C; stage_rc(tid * 16 + i * 8192, R, C); const int Rb = Epi::PERM ? ((R & ~31) + perm32(R & 31)) : R;
        voffA[i] = (unsigned)(R * K + C) * 2u; voffB[i] = (unsigned)(Rb * K + C) * 2u; }
    const size_t kstep = (size_t)(BK * 2);
    const size_t hstep = (size_t)HALF * K * 2;
    const size_t tstep = 2 * hstep;
    const unsigned ldsw = (unsigned)wid * 1024u;
    const int aoff = lds_byte(wr * 64 + fr, fq * 8), boff = lds_byte(wc * 32 + fr, fq * 8);
    const PG8_LAS unsigned char* abase = lds + aoff; const PG8_LAS unsigned char* bbase = lds + 65536 + boff; asm volatile("" : "+v"(abase), "+v"(bbase));
#define PG8_SA(b, h) (((b) * 2 + (h)) * HTB)
#define PG8_SB(b, h) ((4 + (b) * 2 + (h)) * HTB)
#define PG8_STAGE(bufoff, gbase, voff) do { _Pragma("unroll") for (int _i = 0; _i < 2; ++_i) \
        __builtin_amdgcn_global_load_lds((const unsigned*)((const char*)(gbase) + (voff)[_i]), (PG8_LAS unsigned*)(lds + (bufoff) + ldsw + _i * 8192), 16, 0, 0); } while (0)
#define PG8_LDA(dst, b, h) do { _Pragma("unroll") for (int m = 0; m < 4; ++m) dst[m] = __builtin_shufflevector(*(const PG8_LAS i32x4*)(abase + (PG8_SA(b, h) + m * 2048)), *(const PG8_LAS i32x4*)(abase + (PG8_SA(b, h) + m * 2048 + 1024)), 0, 1, 2, 3, 4, 5, 6, 7); } while (0)
#define PG8_LDB(dst, b, h) do { _Pragma("unroll") for (int n = 0; n < 2; ++n) dst[n] = __builtin_shufflevector(*(const PG8_LAS i32x4*)(bbase + (PG8_SB(b, h) - 65536 + n * 2048)), *(const PG8_LAS i32x4*)(bbase + (PG8_SB(b, h) - 65536 + n * 2048 + 1024)), 0, 1, 2, 3, 4, 5, 6, 7); } while (0)
#define PG8_LO(x) __builtin_bit_cast(bf16x8, __builtin_shufflevector(x, x, 0, 1, 2, 3))
#define PG8_HI(x) __builtin_bit_cast(bf16x8, __builtin_shufflevector(x, x, 4, 5, 6, 7))
#define PG8_LOI(x) __builtin_shufflevector(x, x, 0, 1, 2, 3)
#define PG8_HII(x) __builtin_shufflevector(x, x, 4, 5, 6, 7)
#define PG8_MMA(ai, bj, At, Bt) do { __builtin_amdgcn_s_setprio(1); if constexpr (DT == 1) { _Pragma("unroll") for (int m = 0; m < 4; ++m) _Pragma("unroll") for (int n = 0; n < 2; ++n) \
        asm volatile("v_mfma_scale_f32_16x16x128_f8f6f4 %0, %1, %2, %0, %3, %3 op_sel_hi:[0,0,0]" : "+v"(acc[ai][bj][m][n]) : "v"(Bt[n]), "v"(At[m]), "v"(one_scale)); } \
    else if constexpr (DT == 2) { _Pragma("unroll") for (int m = 0; m < 4; ++m) _Pragma("unroll") for (int n = 0; n < 2; ++n) { \
        i32x4 c_ = __builtin_bit_cast(i32x4, acc[ai][bj][m][n]); c_ = __builtin_amdgcn_mfma_i32_16x16x64_i8(PG8_LOI(Bt[n]), PG8_LOI(At[m]), c_, 0, 0, 0); \
        c_ = __builtin_amdgcn_mfma_i32_16x16x64_i8(PG8_HII(Bt[n]), PG8_HII(At[m]), c_, 0, 0, 0); acc[ai][bj][m][n] = __builtin_bit_cast(f32x4, c_); } } \
    else { _Pragma("unroll") for (int m = 0; m < 4; ++m) _Pragma("unroll") for (int n = 0; n < 2; ++n) { \
        acc[ai][bj][m][n] = __builtin_amdgcn_mfma_f32_16x16x32_bf16(PG8_LO(Bt[n]), PG8_LO(At[m]), acc[ai][bj][m][n], 0, 0, 0); \
        acc[ai][bj][m][n] = __builtin_amdgcn_mfma_f32_16x16x32_bf16(PG8_HI(Bt[n]), PG8_HI(At[m]), acc[ai][bj][m][n], 0, 0, 0); } } __builtin_amdgcn_s_setprio(0); } while (0)
#define PG8_WAIT_V(n) asm volatile("s_waitcnt vmcnt(" #n ")" ::: "memory")
#define PG8_WAIT_L(n) asm volatile("s_waitcnt lgkmcnt(" #n ")" ::: "memory")
#define PG8_BAR __builtin_amdgcn_s_barrier()
#define PG8_SCHED __builtin_amdgcn_sched_barrier(0)
    Unit cur, nxt; int ui = 0;
    if (!S.next(0, cur)) return;
    int one_scale = 0x7F7F7F7F; asm volatile("" : "+v"(one_scale));
    f32x4 acc[2][2][4][2];
#pragma unroll
    for (int a = 0; a < 2; ++a)
#pragma unroll
        for (int b = 0; b < 2; ++b)
#pragma unroll
            for (int m = 0; m < 4; ++m)
#pragma unroll
                for (int n = 0; n < 2; ++n) acc[a][b][m][n] = (f32x4){0.f, 0.f, 0.f, 0.f};
    i32x8 At[4], B0[2], B1[2];
    const char* cA = (const char*)g.A + (size_t)cur.pm * tstep; const char* cB = (const char*)g.Bt + (size_t)cur.pn * tstep;
    S.a_ready(cur);
    if constexpr (SP2) {
        PG8_STAGE(PG8_SB(0, 0), cB, voffB); PG8_STAGE(PG8_SB(0, 1), cB + hstep, voffB); PG8_STAGE(PG8_SA(0, 0), cA, voffA); PG8_STAGE(PG8_SA(0, 1), cA + hstep, voffA);
        if (wr == 1) PG8_BAR;
        PG8_WAIT_V(2); PG8_BAR;
        PG8_STAGE(PG8_SB(1, 0), cB + kstep, voffB); PG8_STAGE(PG8_SA(1, 0), cA + kstep, voffA); PG8_STAGE(PG8_SB(1, 1), cB + hstep + kstep, voffB);
        PG8_WAIT_V(6); PG8_BAR;
    } else {
        PG8_STAGE(PG8_SB(0, 0), cB, voffB); PG8_STAGE(PG8_SA(0, 0), cA, voffA); PG8_STAGE(PG8_SB(0, 1), cB + hstep, voffB); PG8_STAGE(PG8_SA(0, 1), cA + hstep, voffA);
        if (wr == 1) PG8_BAR;
        PG8_WAIT_V(4); PG8_BAR;
        PG8_STAGE(PG8_SB(1, 0), cB + kstep, voffB); PG8_STAGE(PG8_SA(1, 0), cA + kstep, voffA); PG8_STAGE(PG8_SB(1, 1), cB + hstep + kstep, voffB);
        PG8_WAIT_V(6); PG8_BAR;
    }
    for (;;) {
        const bool has_next = S.next(ui + 1, nxt);
        const char* nA = has_next ? (const char*)g.A + (size_t)nxt.pm * tstep : cA; const char* nB = has_next ? (const char*)g.Bt + (size_t)nxt.pn * tstep : cB;
        for (int t = 0; t < nt; t += 2) {
            const bool last = (t == nt - 2);
            const char* a1 = cA + (size_t)(t + 1) * kstep;
            const char* a2 = last ? nA : cA + (size_t)(t + 2) * kstep; const char* b2 = last ? nB : cB + (size_t)(t + 2) * kstep;
            const char* a3 = a2 + kstep; const char* b3 = b2 + kstep;
            if (last && has_next) S.a_ready(nxt);
            if constexpr (SP2) {
            PG8_LDB(B0, 0, 0); PG8_LDB(B1, 0, 1); PG8_SCHED; PG8_LDA(At, 0, 0); PG8_STAGE(PG8_SA(1, 1), a1 + hstep, voffA);
            PG8_WAIT_V(8); PG8_WAIT_L(0); PG8_BAR; PG8_MMA(0, 0, At, B0); PG8_MMA(0, 1, At, B1); PG8_BAR; PG8_SCHED;
            PG8_LDA(At, 0, 1); PG8_STAGE(PG8_SB(0, 0), b2, voffB); PG8_STAGE(PG8_SB(0, 1), b2 + hstep, voffB); PG8_STAGE(PG8_SA(0, 0), a2, voffA);
            PG8_WAIT_V(8); PG8_WAIT_L(0); PG8_BAR; PG8_MMA(1, 0, At, B0); PG8_MMA(1, 1, At, B1); PG8_BAR; PG8_SCHED;
            PG8_LDB(B0, 1, 0); PG8_LDB(B1, 1, 1); PG8_SCHED; PG8_LDA(At, 1, 0); PG8_STAGE(PG8_SA(0, 1), a2 + hstep, voffA);
            PG8_WAIT_V(8); PG8_WAIT_L(0); PG8_BAR; PG8_MMA(0, 0, At, B0); PG8_MMA(0, 1, At, B1); PG8_BAR; PG8_SCHED;
            PG8_LDA(At, 1, 1); PG8_STAGE(PG8_SB(1, 0), b3, voffB); PG8_STAGE(PG8_SB(1, 1), b3 + hstep, voffB); PG8_STAGE(PG8_SA(1, 0), a3, voffA);
            PG8_WAIT_V(8); PG8_WAIT_L(0); PG8_BAR; PG8_MMA(1, 0, At, B0); PG8_MMA(1, 1, At, B1); PG8_BAR; PG8_SCHED;
            } else {
            PG8_LDB(B0, 0, 0); PG8_SCHED; PG8_LDA(At, 0, 0); PG8_STAGE(PG8_SA(1, 1), a1 + hstep, voffA);
            PG8_WAIT_L(8); PG8_BAR; PG8_WAIT_L(0); PG8_MMA(0, 0, At, B0); PG8_BAR; PG8_SCHED;
            PG8_LDB(B1, 0, 1); PG8_STAGE(PG8_SB(0, 0), b2, voffB);
            PG8_BAR; PG8_WAIT_L(0); PG8_MMA(0, 1, At, B1); PG8_BAR;
            PG8_LDA(At, 0, 1); PG8_STAGE(PG8_SA(0, 0), a2, voffA);
            PG8_BAR; PG8_WAIT_L(0); PG8_MMA(1, 0, At, B0); PG8_BAR; PG8_SCHED;
            PG8_STAGE(PG8_SB(0, 1), b2 + hstep, voffB);
            PG8_WAIT_V(6); PG8_BAR; PG8_MMA(1, 1, At, B1); PG8_BAR;
            PG8_LDB(B0, 1, 0); PG8_SCHED; PG8_LDA(At, 1, 0); PG8_STAGE(PG8_SA(0, 1), a2 + hstep, voffA);
            PG8_WAIT_L(8); PG8_BAR; PG8_WAIT_L(0); PG8_MMA(0, 0, At, B0); PG8_BAR; PG8_SCHED;
            PG8_LDB(B1, 1, 1); PG8_STAGE(PG8_SB(1, 0), b3, voffB);
            PG8_BAR; PG8_WAIT_L(0); PG8_MMA(0, 1, At, B1); PG8_BAR;
            PG8_LDA(At, 1, 1); PG8_STAGE(PG8_SA(1, 0), a3, voffA);
            PG8_BAR; PG8_WAIT_L(0); PG8_MMA(1, 0, At, B0); PG8_BAR; PG8_SCHED;
            PG8_STAGE(PG8_SB(1, 1), b3 + hstep, voffB);
            PG8_WAIT_V(6); PG8_BAR; PG8_MMA(1, 1, At, B1); PG8_BAR;
            }
        }
        if constexpr (DT == 1) asm volatile("s_nop 15\n\ts_nop 15" ::: "memory");
        if constexpr (ALIGN_EPI) { if (wr == 0) PG8_BAR; }
        if constexpr (!Epi::AFTER_DRAIN) { E(acc, cur, wr, wc, fr, fq); S.done(cur); }
        if (!has_next) break;
#pragma unroll
        for (int a = 0; a < 2; ++a)
#pragma unroll
            for (int b = 0; b < 2; ++b)
#pragma unroll
                for (int m = 0; m < 4; ++m)
#pragma unroll
                    for (int n = 0; n < 2; ++n) acc[a][b][m][n] = (f32x4){0.f, 0.f, 0.f, 0.f};
        cur = nxt; cA = nA; cB = nB; ++ui;
        if constexpr (ALIGN_EPI) { if (wr == 1) PG8_BAR; }
    }
    PG8_WAIT_V(0);
    if constexpr (!ALIGN_EPI) { if (wr == 0) PG8_BAR; }
    PG8_BAR;
    if constexpr (Epi::AFTER_DRAIN) { E.fused(acc, cur, wr, wc, fr, fq, lds, wid, lane); S.done(cur); }
#undef PG8_SA
#undef PG8_SB
#undef PG8_STAGE
#undef PG8_LO
#undef PG8_LOI
#undef PG8_HII
#undef PG8_HI
#undef PG8_LDA
#undef PG8_LDB
#undef PG8_MMA
#undef PG8_WAIT_V
#undef PG8_WAIT_L
#undef PG8_BAR
#undef PG8_SCHED
}
}

namespace att {
#define ALAS __attribute__((address_space(3)))
typedef unsigned short bf16;
using bf16x8 = __attribute__((ext_vector_type(8))) short;
using s16x4  = __attribute__((ext_vector_type(4))) short;
using f32x16 = __attribute__((ext_vector_type(16))) float;
using u32x4  = __attribute__((ext_vector_type(4))) unsigned;
typedef ALAS char* lptr;
constexpr int   D = 128, NW = 8, QBLK = 32, KVBLK = 64;
constexpr float SCALE = 0.088388347648318440f, INV_SCALE = 11.313708498984761f, LOG2E = 1.4426950408889634f;
constexpr float THR = 8.f;
constexpr float MASKV = -1e30f, MINIT = -1e10f;
constexpr int SHM_V = KVBLK * D * 2, SHM_K = KVBLK * D * 2;
constexpr int OFF_K = 2 * SHM_V, OFF_WS = 2 * SHM_V + 2 * SHM_K, OFF_TAB = OFF_WS + NW * 64 * 4, TAB_BYTES = 8192, OFF_STG = OFF_TAB + TAB_BYTES, ATT_LDS = OFF_STG + NW * 4096;
constexpr int TREL = 384;
enum { MODE_B = 0, MODE_C = 1, MODE_D = 2, MODE_A = 3 };
#define KSWZ(row, colB) ((row) * 256 + ((colB) ^ ((((row) & 7) | ((((row) >> 4) & 1) << 3)) << 4)))
#define SBAR() __builtin_amdgcn_sched_barrier(0)
__device__ __forceinline__ int crow(int r, int hi) { return (r & 3) + 8 * (r >> 2) + 4 * hi; }
__device__ __forceinline__ unsigned cvtpk(float lo, float hi) { unsigned r; asm volatile("v_cvt_pk_bf16_f32 %0, %1, %2" : "=v"(r) : "v"(lo), "v"(hi)); return r; }

__device__ __forceinline__ void partialSM(f32x16& p0, f32x16& p1, float& m_reg, float& mn, float& alpha) {
  constexpr float C = SCALE * LOG2E;
  float pmax = p0[0];
#pragma unroll
  for (int r = 1; r < 16; ++r) pmax = fmaxf(pmax, p0[r]);
#pragma unroll
  for (int r = 0; r < 16; ++r) pmax = fmaxf(pmax, p1[r]);
  { auto rr = __builtin_amdgcn_permlane32_swap(__float_as_uint(pmax), __float_as_uint(pmax), false, false);
    pmax = fmaxf(__uint_as_float(rr[0]), __uint_as_float(rr[1])); }
  if (__builtin_expect(__all(pmax - m_reg <= THR / SCALE), 1)) { mn = m_reg; alpha = 1.f; }
  else { mn = fmaxf(m_reg, pmax); alpha = __builtin_amdgcn_exp2f((m_reg - mn) * C); m_reg = mn; }
  float mnC = -mn * C;
#pragma unroll
  for (int r = 0; r < 16; ++r) p0[r] = fmaf(p0[r], C, mnC);
#pragma unroll
  for (int r = 0; r < 16; ++r) p1[r] = fmaf(p1[r], C, mnC);
#pragma unroll
  for (int r = 0; r < 16; ++r) p0[r] = __builtin_amdgcn_exp2f(p0[r]);
}
__device__ __forceinline__ void finishSM(f32x16& p0, f32x16& p1, float alpha, float& l_reg, bf16x8& pa0, bf16x8& pa1, bf16x8& pa2, bf16x8& pa3) {
#pragma unroll
  for (int r = 0; r < 16; ++r) p1[r] = __builtin_amdgcn_exp2f(p1[r]);
  float ps = 0;
#pragma unroll
  for (int r = 0; r < 16; ++r) ps += p0[r];
#pragma unroll
  for (int r = 0; r < 16; ++r) ps += p1[r];
  { auto rr = __builtin_amdgcn_permlane32_swap(__float_as_uint(ps), __float_as_uint(ps), false, false);
    ps = __uint_as_float(rr[0]) + __uint_as_float(rr[1]); }
  l_reg = l_reg * alpha + ps;
#define PK4(P, BASE, OUT) do { unsigned a0 = cvtpk(P[BASE + 0], P[BASE + 1]), a1 = cvtpk(P[BASE + 2], P[BASE + 3]);   \
    unsigned b0 = cvtpk(P[BASE + 4], P[BASE + 5]), b1 = cvtpk(P[BASE + 6], P[BASE + 7]);                              \
    auto r0 = __builtin_amdgcn_permlane32_swap(a0, b0, false, false); auto r1 = __builtin_amdgcn_permlane32_swap(a1, b1, false, false); \
    u32x4 w = {r0[0], r1[0], r0[1], r1[1]}; OUT = __builtin_bit_cast(bf16x8, w); } while (0)
  PK4(p0, 0, pa0); PK4(p0, 8, pa1); PK4(p1, 0, pa2); PK4(p1, 8, pa3);
#undef PK4
}
__device__ __forceinline__ void qkt(f32x16& p0, f32x16& p1, lptr Ks, const bf16x8* qr, int r32, int hi) {
#pragma unroll
  for (int d0 = 0; d0 < 8; ++d0) { int cb = (d0 * 16 + hi * 8) * 2;
    bf16x8 b0 = *(const ALAS bf16x8*)(Ks + KSWZ(r32, cb));
    bf16x8 b1 = *(const ALAS bf16x8*)(Ks + KSWZ(32 + r32, cb));
    p0 = __builtin_amdgcn_mfma_f32_32x32x16_bf16(b0, qr[d0], p0, 0, 0, 0);
    p1 = __builtin_amdgcn_mfma_f32_32x32x16_bf16(b1, qr[d0], p1, 0, 0, 0); }
}
__device__ __forceinline__ int v_st(int k, int c) { const int kk = (k & ~0xC) | ((k & 4) << 1) | ((k & 8) >> 1); return ((kk >> 3) * 4 + (c >> 5)) * 512 + ((kk & 7) * 32 + (c & 31)) * 2; }
__device__ __forceinline__ int v_rd_base(int lane) { return ((lane & 3) << 3) | (((lane >> 2) & 3) << 6) | (((lane >> 4) & 1) << 5) | (((lane >> 5) & 1) << 8); }
constexpr int v_rd_off(int d0, int ks, int half) { return d0 * 512 + ks * 4096 + half * 2048; }
template <int OFF> __device__ __forceinline__ s16x4 tr_read(int vb) {
  s16x4 r; asm volatile("ds_read_b64_tr_b16 %0, %1 offset:%2" : "=&v"(r) : "v"(vb), "i"(OFF) : "memory"); return r;
}
template <int D0> __device__ __forceinline__ void pv_one(f32x16& od, int vb, bf16x8 pa0, bf16x8 pa1, bf16x8 pa2, bf16x8 pa3) {
  const s16x4 l0 = tr_read<v_rd_off(D0, 0, 0)>(vb), h0 = tr_read<v_rd_off(D0, 0, 1)>(vb), l1 = tr_read<v_rd_off(D0, 1, 0)>(vb), h1 = tr_read<v_rd_off(D0, 1, 1)>(vb);
  const s16x4 l2 = tr_read<v_rd_off(D0, 2, 0)>(vb), h2 = tr_read<v_rd_off(D0, 2, 1)>(vb), l3 = tr_read<v_rd_off(D0, 3, 0)>(vb), h3 = tr_read<v_rd_off(D0, 3, 1)>(vb);
  asm volatile("s_waitcnt lgkmcnt(0)" ::: "memory"); SBAR();
#define PK(L, H) (bf16x8){L[0], L[1], L[2], L[3], H[0], H[1], H[2], H[3]}
  od = __builtin_amdgcn_mfma_f32_32x32x16_bf16(pa0, PK(l0, h0), od, 0, 0, 0);
  od = __builtin_amdgcn_mfma_f32_32x32x16_bf16(pa1, PK(l1, h1), od, 0, 0, 0);
  od = __builtin_amdgcn_mfma_f32_32x32x16_bf16(pa2, PK(l2, h2), od, 0, 0, 0);
  od = __builtin_amdgcn_mfma_f32_32x32x16_bf16(pa3, PK(l3, h3), od, 0, 0, 0);
#undef PK
}
__device__ __forceinline__ void pv_d0(f32x16* o, int vb, bf16x8 pa0, bf16x8 pa1, bf16x8 pa2, bf16x8 pa3) {
  pv_one<0>(o[0], vb, pa0, pa1, pa2, pa3); pv_one<1>(o[1], vb, pa0, pa1, pa2, pa3); pv_one<2>(o[2], vb, pa0, pa1, pa2, pa3); pv_one<3>(o[3], vb, pa0, pa1, pa2, pa3);
}

typedef short v4i16_t __attribute__((ext_vector_type(4)));
#define PIN(x) asm volatile("" : "+v"(x))
#define MF(a, b, c) __builtin_amdgcn_mfma_f32_32x32x16_bf16(a, b, c, 0, 0, 0)
#define EX2(x) __builtin_amdgcn_exp2f(x)
#define MX3(a, b, c) __builtin_fmaxf(__builtin_fmaxf((a), (b)), (c))
__device__ __forceinline__ unsigned cvtpk_s(float lo, float hi) { unsigned r; asm("v_cvt_pk_bf16_f32 %0, %1, %2" : "=v"(r) : "v"(lo), "v"(hi)); return r; }
#define KRD2(Ks, D0, K0, K1) do { const int cb_ = ((D0) * 16 + hi * 8) * 2; K0 = *(const ALAS bf16x8*)((Ks) + KSWZ(r32, cb_)); K1 = *(const ALAS bf16x8*)((Ks) + KSWZ(32 + r32, cb_)); } while (0)
#define VTR(vp, OFF) __builtin_bit_cast(s16x4, __builtin_amdgcn_ds_read_tr16_b64_v4i16((ALAS v4i16_t*)((vp) + (OFF))))
#define PKV(L, H) (bf16x8){L[0], L[1], L[2], L[3], H[0], H[1], H[2], H[3]}
#define VRDG(vp, GI, L0, H0, L1, H1) do { L0 = VTR(vp, v_rd_off(2 * ((GI) >> 2), (GI) & 3, 0)); H0 = VTR(vp, v_rd_off(2 * ((GI) >> 2), (GI) & 3, 1)); \
    L1 = VTR(vp, v_rd_off(2 * ((GI) >> 2) + 1, (GI) & 3, 0)); H1 = VTR(vp, v_rd_off(2 * ((GI) >> 2) + 1, (GI) & 3, 1)); } while (0)
#define SWP(a, b, r) auto r = __builtin_amdgcn_permlane32_swap(a, b, false, false)

__device__ __forceinline__ void bias_init(f32x16& p0, f32x16& p1, int mode, int k0, int qw, int r32, int hi, const ALAS float* tab) {
  if (mode == MODE_B) { p0 = f32x16{}; p1 = f32x16{}; return; }
  if (mode == MODE_A) {
    const int kr = k0 >> 6, rq = qw >> 6, rs = min(max(rq - 4, 0), 24);
    if (kr < rs || kr >= rs + 8) {
#pragma unroll
      for (int r = 0; r < 16; ++r) { p0[r] = MASKV; p1[r] = MASKV; } }
    else { const int cq = (qw & 63) + r32, cs = min(max(cq - 8, 0), 48), d = 4 * hi - cs; const ALAS float* rt = tab + ((kr - rq + 7) * 128 + 48 + 15 + 4 * hi - cq); asm volatile("" : "+v"(rt));
#pragma unroll
      for (int r = 0; r < 16; ++r) { const int c0 = (r & 3) + 8 * (r >> 2), c1 = c0 + 32; const bool ok0 = (unsigned)(c0 + d) < 16u, ok1 = (unsigned)(c1 + d) < 16u;
        const float t0 = rt[c0], t1 = rt[c1]; p0[r] = ok0 ? t0 : MASKV; p1[r] = ok1 ? t1 : MASKV; if ((r & 3) == 3) asm volatile("" ::: "memory"); } }
  } else {
    const int dq = k0 - qw;
    if (mode == MODE_D && (dq >= 128 || dq <= -160)) { const float c = tab[dq > 0 ? TREL + 300 : TREL - 300];
#pragma unroll
      for (int r = 0; r < 16; ++r) { p0[r] = c; p1[r] = c; } }
    else { const ALAS float* tl = tab + (dq + 4 * hi - r32 + TREL); asm volatile("" : "+v"(tl));
#pragma unroll
      for (int r = 0; r < 16; ++r) { const int c0 = (r & 3) + 8 * (r >> 2); p0[r] = tl[c0]; p1[r] = tl[c0 + 32]; if ((r & 3) == 3) asm volatile("" ::: "memory"); } }
  }
}

template <int LD>
__device__ __forceinline__ void attn_unit(const bf16* __restrict__ Qb, const bf16* __restrict__ Kh, int vdelta, int nkeys,
                                          int mode, int kbeg, int qbase, const ALAS float* tab, float sink, void* __restrict__ Op, lptr lds, int tid_in) {
  int tid_o = tid_in; asm volatile("" : "+v"(tid_o));
  const int tid = tid_o, wid = __builtin_amdgcn_readfirstlane(tid >> 6), lane = tid & 63, r32 = lane & 31, hi = lane >> 5;
  lptr V_lds = lds; lptr K_lds = lds + OFF_K;
  ALAS float* ws = (ALAS float*)(lds + OFF_WS) + wid * 64; ALAS float* li_l = ws; ALAS float* al_l = ws + 32;
  float m_reg = MINIT, l_reg = 0; f32x16 o[4] = {}; bf16x8 qr[8];
  const bf16* Qw = Qb + (unsigned)((wid * QBLK + r32) * LD + hi * 8);
#pragma unroll
  for (int d0 = 0; d0 < 8; ++d0) qr[d0] = *(const bf16x8*)(Qw + d0 * 16);
  const int sr = tid >> 4, sc = (tid & 15) * 8; const unsigned vo = (unsigned)(sr * LD + sc); const int vst0 = v_st(sr, sc), vst1 = v_st(32 + sr, sc);
  const int vb0 = (int)(unsigned)(size_t)V_lds + v_rd_base(lane);
  const int qw = qbase + wid * QBLK;
  struct { bf16x8 vs0, vs1, ks0, ks1; } sr_[2];
#define SLOAD(i, k0) do { const bf16* Kt = Kh + (size_t)(k0) * LD; const bf16* Vt = Kt + vdelta; \
    sr_[i].vs0 = *(const bf16x8*)(Vt + vo); sr_[i].vs1 = *(const bf16x8*)(Vt + 32 * LD + vo); \
    sr_[i].ks0 = *(const bf16x8*)(Kt + vo); sr_[i].ks1 = *(const bf16x8*)(Kt + 32 * LD + vo); } while (0)
#define SWRITE_K(b, i) do { int kc = sc * 2; *(ALAS bf16x8*)(K_lds + (b) * SHM_K + KSWZ(sr, kc)) = sr_[i].ks0; *(ALAS bf16x8*)(K_lds + (b) * SHM_K + KSWZ(32 + sr, kc)) = sr_[i].ks1; } while (0)
#define SWRITE_V(b, i) do { *(ALAS bf16x8*)(V_lds + (b) * SHM_V + vst0) = sr_[i].vs0; *(ALAS bf16x8*)(V_lds + (b) * SHM_V + vst1) = sr_[i].vs1; } while (0)
#define SWAIT() asm volatile("s_waitcnt vmcnt(4)" ::: "memory")
#define RESC(a) do { if (__any((a) < 1.f)) { if (hi == 0) al_l[r32] = (a); asm volatile("s_waitcnt lgkmcnt(0)" ::: "memory"); \
    _Pragma("unroll") for (int d = 0; d < 4; ++d) _Pragma("unroll") for (int r = 0; r < 16; ++r) o[d][r] *= al_l[crow(r, hi)]; } } while (0)
  f32x16 pA0, pA1, pB0, pB1; float mnA, mnB, alA, alB; bf16x8 pa0, pa1, pa2, pa3; const int NT = nkeys / KVBLK;
  constexpr int SE = 0, SO = 1;
  SLOAD(SE, 0); asm volatile("s_waitcnt vmcnt(0)" ::: "memory"); SWRITE_K(0, SE); SWRITE_V(0, SE);
  SLOAD(SO, KVBLK); if (2 < NT) SLOAD(SE, 2 * KVBLK);
  __syncthreads();
  bias_init(pA0, pA1, mode, kbeg, qw, r32, hi, tab); qkt(pA0, pA1, K_lds, qr, r32, hi); partialSM(pA0, pA1, m_reg, mnA, alA);
  SWAIT(); SWRITE_K(1, SO); __syncthreads();
  constexpr float C = SCALE * LOG2E;
  lptr vbp = V_lds + v_rd_base(lane);
  bf16x8 kA0, kA1, kB0, kB1; s16x4 vAl0, vAh0, vAl1, vAh1, vBl0, vBh0, vBl1, vBh1; float ps; unsigned ca0, ca1, cb0, cb1;
#define GA(C0, C1, Ks, D0, KC0, KC1, KN0, KN1, FILL) do { if ((D0) < 7) KRD2(Ks, ((D0) + 1) & 7, KN0, KN1); \
    C0 = MF(KC0, qr[D0], C0); C1 = MF(KC1, qr[D0], C1); FILL; SBAR(); } while (0)
#define E3(P, i) do { P[i] = EX2(P[i]); P[(i) + 1] = EX2(P[(i) + 1]); P[(i) + 2] = EX2(P[(i) + 2]); } while (0)
#define E2(P, i) do { P[i] = EX2(P[i]); P[(i) + 1] = EX2(P[(i) + 1]); } while (0)
#define S4(P, i) do { ps += P[i]; ps += P[(i) + 1]; ps += P[(i) + 2]; ps += P[(i) + 3]; } while (0)
#define CA(P, i) do { ca0 = cvtpk_s(P[i], P[(i) + 1]); ca1 = cvtpk_s(P[(i) + 2], P[(i) + 3]); } while (0)
#define CB(P, i, OUT) do { cb0 = cvtpk_s(P[i], P[(i) + 1]); cb1 = cvtpk_s(P[(i) + 2], P[(i) + 3]); SWP(ca0, cb0, r0_); SWP(ca1, cb1, r1_); \
    u32x4 w_ = {r0_[0], r1_[0], r0_[1], r1_[1]}; OUT = __builtin_bit_cast(bf16x8, w_); PIN(OUT); } while (0)
#define GB(vp, GI, CL0, CH0, CL1, CH1, NL0, NH0, NL1, NH1, PAK, FILL) do { if ((GI) < 7) VRDG(vp, ((GI) + 1) & 7, NL0, NH0, NL1, NH1); \
    o[2 * ((GI) >> 2)] = MF(PAK, PKV(CL0, CH0), o[2 * ((GI) >> 2)]); o[2 * ((GI) >> 2) + 1] = MF(PAK, PKV(CL1, CH1), o[2 * ((GI) >> 2) + 1]); FILL; SBAR(); } while (0)
#define FE(C0, C1, i) do { C0[i] = EX2(__builtin_fmaf(C0[i], C, mnC_)); C1[i] = __builtin_fmaf(C1[i], C, mnC_); } while (0)
#define FE3(C0, C1, i) do { FE(C0, C1, i); FE(C0, C1, (i) + 1); FE(C0, C1, (i) + 2); PIN(C0); PIN(C1); } while (0)
#define FE2(C0, C1, i) do { FE(C0, C1, i); FE(C0, C1, (i) + 1); PIN(C0); PIN(C1); } while (0)
#define STEP(C0, C1, ALC, P0, P1, ALP, T, KB_, DOLOAD, DOWK) do { \
    lptr Ks_ = K_lds + (KB_) * SHM_K; lptr vp_ = vbp + (1 - (KB_)) * SHM_V; \
    KRD2(Ks_, 0, kA0, kA1); \
    SWRITE_V(KB_, KB_); SBAR(); \
    bias_init(C0, C1, mode, kbeg + (T) * KVBLK, qw, r32, hi, tab); SBAR(); \
    GA(C0, C1, Ks_, 0, kA0, kA1, kB0, kB1, E3(P1, 0); ps = P0[0] + P0[1]; ps += P0[2]; ps += P0[3]; CA(P0, 0); PIN(P1); PIN(ps); PIN(ca0); PIN(ca1)); \
    GA(C0, C1, Ks_, 1, kB0, kB1, kA0, kA1, E3(P1, 3); S4(P0, 4); CB(P0, 4, pa0); PIN(P1); PIN(ps)); \
    GA(C0, C1, Ks_, 2, kA0, kA1, kB0, kB1, E3(P1, 6); S4(P0, 8); CA(P0, 8); PIN(P1); PIN(ps); PIN(ca0); PIN(ca1)); \
    GA(C0, C1, Ks_, 3, kB0, kB1, kA0, kA1, E3(P1, 9); S4(P0, 12); CB(P0, 12, pa1); PIN(P1); PIN(ps)); \
    GA(C0, C1, Ks_, 4, kA0, kA1, kB0, kB1, E2(P1, 12); S4(P1, 0); CA(P1, 0); PIN(P1); PIN(ps); PIN(ca0); PIN(ca1)); \
    GA(C0, C1, Ks_, 5, kB0, kB1, kA0, kA1, E2(P1, 14); S4(P1, 4); CB(P1, 4, pa2); PIN(P1); PIN(ps)); \
    GA(C0, C1, Ks_, 6, kA0, kA1, kB0, kB1, S4(P1, 8); CA(P1, 8); PIN(ps); PIN(ca0); PIN(ca1)); \
    GA(C0, C1, Ks_, 7, kB0, kB1, kA0, kA1, VRDG(vp_, 0, vAl0, vAh0, vAl1, vAh1); S4(P1, 12); CB(P1, 12, pa3); \
       { SWP(__float_as_uint(ps), __float_as_uint(ps), rr_); ps = __uint_as_float(rr_[0]) + __uint_as_float(rr_[1]); } l_reg = l_reg * (ALP) + ps; PIN(l_reg)); \
    if (DOLOAD) SLOAD(KB_, ((T) + 2) * KVBLK); \
    float mxa_, mxb_, mnC_; \
    GB(vp_, 0, vAl0, vAh0, vAl1, vAh1, vBl0, vBh0, vBl1, vBh1, pa0, \
       mxa_ = MX3(C0[0], C0[1], C1[0]); mxb_ = MX3(C0[2], C0[3], C1[1]); mxa_ = MX3(mxa_, C1[2], C1[3]); mxa_ = MX3(mxa_, C0[4], C0[5]); mxb_ = MX3(mxb_, C0[6], C0[7]); \
       mxa_ = MX3(mxa_, C1[4], C1[5]); mxb_ = MX3(mxb_, C1[6], C1[7]); PIN(mxa_); PIN(mxb_)); \
    GB(vp_, 1, vBl0, vBh0, vBl1, vBh1, vAl0, vAh0, vAl1, vAh1, pa1, \
       mxa_ = MX3(mxa_, C0[8], C0[9]); mxb_ = MX3(mxb_, C0[10], C0[11]); mxa_ = MX3(mxa_, C1[8], C1[9]); mxb_ = MX3(mxb_, C1[10], C1[11]); \
       mxa_ = MX3(mxa_, C0[12], C0[13]); mxb_ = MX3(mxb_, C0[14], C0[15]); mxa_ = MX3(mxa_, C1[12], C1[13]); mxb_ = MX3(mxb_, C1[14], C1[15]); \
       { float pm_ = __builtin_fmaxf(mxa_, mxb_); SWP(__float_as_uint(pm_), __float_as_uint(pm_), rr_); pm_ = __builtin_fmaxf(__uint_as_float(rr_[0]), __uint_as_float(rr_[1])); float mn_; \
         if (__builtin_expect(__all(pm_ - m_reg <= THR / SCALE), 1)) { mn_ = m_reg; ALC = 1.f; } \
         else { mn_ = __builtin_fmaxf(m_reg, pm_); ALC = EX2((m_reg - mn_) * C); m_reg = mn_; } \
         mnC_ = -mn_ * C; } PIN(mnC_); PIN(ALC)); \
    GB(vp_, 2, vAl0, vAh0, vAl1, vAh1, vBl0, vBh0, vBl1, vBh1, pa2, FE3(C0, C1, 0)); \
    GB(vp_, 3, vBl0, vBh0, vBl1, vBh1, vAl0, vAh0, vAl1, vAh1, pa3, FE3(C0, C1, 3)); \
    GB(vp_, 4, vAl0, vAh0, vAl1, vAh1, vBl0, vBh0, vBl1, vBh1, pa0, FE3(C0, C1, 6)); \
    GB(vp_, 5, vBl0, vBh0, vBl1, vBh1, vAl0, vAh0, vAl1, vAh1, pa1, FE3(C0, C1, 9)); \
    GB(vp_, 6, vAl0, vAh0, vAl1, vAh1, vBl0, vBh0, vBl1, vBh1, pa2, FE2(C0, C1, 12)); \
    GB(vp_, 7, vBl0, vBh0, vBl1, vBh1, vAl0, vAh0, vAl1, vAh1, pa3, FE2(C0, C1, 14)); \
    if (DOWK) { SWAIT(); SWRITE_K(1 - (KB_), 1 - (KB_)); } \
    RESC(ALC); __syncthreads(); } while (0)
  for (int j = 1; j + 1 < NT; j += 2) {
    STEP(pB0, pB1, alB, pA0, pA1, alA, j, 1, true, true);
    STEP(pA0, pA1, alA, pB0, pB1, alB, j + 1, 0, (j + 3 < NT), true);
  }
  STEP(pB0, pB1, alB, pA0, pA1, alA, NT - 1, 1, false, false);
  finishSM(pB0, pB1, alB, l_reg, pa0, pa1, pa2, pa3); SBAR();
  pv_d0(o, vb0 + SHM_V, pa0, pa1, pa2, pa3);
  __syncthreads();
  if (mode == MODE_C) l_reg += __builtin_amdgcn_exp2f(sink * LOG2E - m_reg * (SCALE * LOG2E));
  if (hi == 0) li_l[r32] = l_reg; asm volatile("s_waitcnt lgkmcnt(0)" ::: "memory");
  float rli[16];
#pragma unroll
  for (int r = 0; r < 16; ++r) rli[r] = __builtin_amdgcn_rcpf(li_l[crow(r, hi)]);
  { lptr stg = lds + OFF_STG + wid * 4096; const int psh = (mode == MODE_D) ? 10 : 12;
    bf16* Ob = (bf16*)Op + ((unsigned)(wid * QBLK) << psh);
#pragma unroll
    for (int p = 0; p < 2; ++p) {
#pragma unroll
      for (int r = 0; r < 16; ++r) { const unsigned w = cvtpk(o[2 * p][r] * rli[r], o[2 * p + 1][r] * rli[r]); ALAS unsigned short* sp = (ALAS unsigned short*)(stg + crow(r, hi) * 128 + r32 * 2);
        sp[0] = (unsigned short)w; sp[32] = (unsigned short)(w >> 16); }
      asm volatile("s_waitcnt lgkmcnt(0)" ::: "memory");
#pragma unroll
      for (int i = 0; i < 4; ++i) { const int row = i * 8 + (lane >> 3), ch = lane & 7; const u32x4 v = *(const ALAS u32x4*)(stg + row * 128 + ch * 16);
        *(u32x4*)(Ob + (((unsigned)row << psh) + p * 64 + ch * 8)) = v; }
      asm volatile("s_waitcnt lgkmcnt(0)" ::: "memory"); } }
#undef SLOAD
#undef SWRITE_K
#undef SWRITE_V
#undef SWAIT
#undef RESC
}
}

constexpr int NWAVES = 8;
constexpr int BATCH = 4, SEQ = 2048, DM = 4096, DIN = 9216, DFF = 16384, MTOK = BATCH * SEQ, DEPTH = 2;
constexpr float EPS = 1e-6f;
constexpr float U_SCALE = 8.0f, WMO_SCALE = 2048.0f;
constexpr int C_AQ = 0, C_AK = 1024, C_AV = 2048, C_BQ = 3072, C_BK = 4096, C_BV = 4352, C_CQ = 4608, C_CK = 5632, C_CV = 5888, C_DQ = 6144, C_DK = 7168, C_DV = 8192;
constexpr size_t MiB = 1u << 20;
constexpr size_t WS_CTL = 0, CTL_ZERO_BYTES = 1 * MiB;
constexpr size_t WS_RS = 1 * MiB;
constexpr size_t WS_ROPE = 2 * MiB;
constexpr size_t WS_PART = 4 * MiB;
constexpr size_t WS_W = 8 * MiB;
constexpr size_t W_IN_B = (size_t)DIN * DM * 2, W_OUT_B = (size_t)DM * DM * 2, W_MI_B = (size_t)DFF * DM * 2, W_MO_B = (size_t)DM * DFF * 2, W_LAYER_B = W_IN_B + W_OUT_B + W_MI_B + W_MO_B;
constexpr size_t WS_XB = WS_W + DEPTH * W_LAYER_B;
constexpr size_t WS_PROJ = WS_XB + (size_t)MTOK * DM * 2;
constexpr size_t WS_MIX = WS_PROJ + (size_t)MTOK * DIN * 2;
constexpr size_t WS_Y = WS_MIX + (size_t)MTOK * DM * 2;
constexpr size_t WS_U = WS_Y + (size_t)MTOK * DM * 2;
constexpr size_t WS_DT = WS_U + (size_t)MTOK * DFF * 2;
constexpr size_t WS_XQ = WS_DT + (size_t)2 * MTOK * 1024 * 4;
constexpr size_t WS_END = WS_XQ + (size_t)MTOK * DM;
constexpr size_t WS_AS = WS_RS + 65536;
constexpr size_t WS_MAS = WS_RS + 196608;
constexpr size_t WS_WQS = WS_RS + 131072;
constexpr int CW_BAR = 4096;
constexpr int RING_BYTES = 131072, LDSCTL_OFF = RING_BYTES, MISC_OFF = LDSCTL_OFF + 320, LDS_BYTES = 147456;
static_assert(att::ATT_LDS <= RING_BYTES, "attention LDS fits the ring region");

#define GAS __attribute__((address_space(1)))
#define LAS __attribute__((address_space(3)))
typedef unsigned short bf16;
typedef unsigned v4u __attribute__((ext_vector_type(4)));
typedef unsigned v2u __attribute__((ext_vector_type(2)));
typedef float f32x4 __attribute__((ext_vector_type(4)));
typedef GAS unsigned gu32;
#define RLX_AGENT __ATOMIC_RELAXED, __HIP_MEMORY_SCOPE_AGENT
#define LDS_WAIT() asm volatile("s_waitcnt lgkmcnt(0)" ::: "memory")
__device__ __forceinline__ unsigned pk2(float lo, float hi) { return pg8::cvt_pk_bf16(lo, hi); }
__device__ __forceinline__ float bf_lo(unsigned w) { return __uint_as_float(w << 16); }
__device__ __forceinline__ float bf_hi(unsigned w) { return __uint_as_float(w & 0xffff0000u); }
__device__ __forceinline__ float wave_sum(float v) {
    v += xsw<1>(v); v += xsw<2>(v); v += xsw<4>(v); v += xsw<8>(v); v += xsw<16>(v);
    return xsum32(v);
}

__device__ __forceinline__ int lane_id() { int l; asm volatile("v_mbcnt_lo_u32_b32 %0, -1, 0\n\tv_mbcnt_hi_u32_b32 %0, -1, %0" : "=v"(l)); return l; }
#define XB_TMO      128
#define XB_XCNT(j)  (256  + 64 * (j))
#define XB_XSUB(j)  (1280 + 64 * (j))
#define XB_XGEN(j)  (2304 + 64 * (j))
#define XB_TOP      3328
#define XB_TOPGEN   3392
#define XCD_BAR_WORDS 3456
#define XB_SPIN_CAP (1u << 18)

__device__ __forceinline__ unsigned xb_ld(unsigned* p)              { return __hip_atomic_load(p, __ATOMIC_RELAXED, __HIP_MEMORY_SCOPE_AGENT); }
__device__ __forceinline__ unsigned xb_add(unsigned* p, unsigned v) { return __hip_atomic_fetch_add(p, v, __ATOMIC_RELAXED, __HIP_MEMORY_SCOPE_AGENT); }
__device__ __forceinline__ unsigned xb_xcc_id() { return (unsigned)__builtin_amdgcn_s_getreg((3 << 11) | 20) & 0xFu; }
#define XB_SPIN(cond, bar) do { unsigned _sp = 0; while (cond) { __builtin_amdgcn_s_sleep(1); \
    if ((++_sp & 255u) == 0u) { if (xb_ld(&(bar)[XB_TMO])) break; if (_sp > XB_SPIN_CAP) { atomicAdd(&(bar)[XB_TMO], 1u); break; } } } } while (0)

struct XcdBarrier {
    unsigned* bar; unsigned x; int w0;
    volatile LAS unsigned* st;
};

__device__ __forceinline__ XcdBarrier xcd_barrier_post(unsigned* bar, volatile LAS unsigned* st) {
    XcdBarrier b; b.bar = bar; b.x = xb_xcc_id(); b.st = st; b.w0 = __builtin_amdgcn_readfirstlane((int)threadIdx.x >> 6);
    if (threadIdx.x == 0) (void)xb_add(&bar[XB_XCNT(b.x)], 1u);
    return b;
}
__device__ __forceinline__ void xcd_barrier_complete(unsigned* bar, unsigned x, unsigned& nloc, unsigned& nx) {
    const unsigned G = gridDim.x * gridDim.y * gridDim.z;
    unsigned sum, cnt, mine, sp = 0u;
    for (;;) {
        sum = 0u; cnt = 0u; mine = 0u;
#pragma unroll
        for (unsigned j = 0; j < 16; ++j) { const unsigned c = xb_ld(&bar[XB_XCNT(j)]); sum += c; cnt += (c > 0u) ? 1u : 0u; mine = (j == x) ? c : mine; }
        if (sum == G) break;
        __builtin_amdgcn_s_sleep(1);
        if ((++sp & 255u) == 0u) { if (xb_ld(&bar[XB_TMO])) break; if (sp > XB_SPIN_CAP) { atomicAdd(&bar[XB_TMO], 1u); break; } }
    }
    nloc = mine > 0u ? mine : 1u; nx = cnt > 0u ? cnt : 1u;
}

__device__ __forceinline__ void xcd_barrier(const XcdBarrier& b) {
    asm volatile("s_waitcnt vmcnt(0)" ::: "memory");
    __syncthreads();
    if (b.w0 == 0 && lane_id() == 0) {
        unsigned* bar = b.bar;
        __builtin_amdgcn_s_waitcnt(0);
        unsigned nloc = b.st[0], nx = b.st[1];
        if (nloc == 0u) { xcd_barrier_complete(bar, b.x, nloc, nx); b.st[0] = nloc; b.st[1] = nx; }
        const unsigned old = xb_add(&bar[XB_XSUB(b.x)], 1u);
        const unsigned gen = old / nloc;
        if (old + 1u == (gen + 1u) * nloc) {
            __builtin_amdgcn_fence(__ATOMIC_RELEASE, "agent");
            asm volatile("s_waitcnt vmcnt(0)" ::: "memory");
            const unsigned og = xb_add(&bar[XB_TOP], 1u);
            const unsigned tg = og / nx;
            if (og + 1u == (tg + 1u) * nx) xb_add(&bar[XB_TOPGEN], 1u);
            else XB_SPIN(xb_ld(&bar[XB_TOPGEN]) == tg, bar);
            __builtin_amdgcn_fence(__ATOMIC_ACQUIRE, "agent");
            xb_add(&bar[XB_XGEN(b.x)], 1u);
            asm volatile("s_waitcnt vmcnt(0)" ::: "memory");
        } else {
            XB_SPIN(xb_ld(&bar[XB_XGEN(b.x)]) == gen, bar);
            __builtin_amdgcn_fence(__ATOMIC_ACQUIRE, "agent");
            asm volatile("s_waitcnt vmcnt(0)" ::: "memory");
        }
    }
    __syncthreads();
}

__device__ __forceinline__ void tr_item(const float* __restrict__ W, int K, int N, const float* __restrict__ gain, bf16* __restrict__ WT, LAS float* scr, int item, int lane) {
    const int nblk = N / 32, kb = item / nblk, nb = item - kb * nblk, k0 = 64 * kb, n0 = 32 * nb;
    f32x4 v[8];
#pragma unroll
    for (int i = 0; i < 8; ++i) { const int kk = 8 * i + (lane >> 3); v[i] = *(const f32x4*)(W + (size_t)(k0 + kk) * N + n0 + (lane & 7) * 4); }
#pragma unroll
    for (int i = 0; i < 8; ++i) { const int kk = 8 * i + (lane >> 3); const float g = gain ? gain[k0 + kk] : 1.f; LAS float* s = scr + kk * 33 + (lane & 7) * 4;
        s[0] = v[i].x * g; s[1] = v[i].y * g; s[2] = v[i].z * g; s[3] = v[i].w * g; }
    LDS_WAIT(); asm volatile("" ::: "memory");
    const int c = lane & 7;
#pragma unroll
    for (int j = 0; j < 4; ++j) { const int n = (lane >> 3) + 8 * j; const LAS float* s = scr + (8 * c) * 33 + n;
        v4u o; o.x = pk2(s[0 * 33], s[1 * 33]); o.y = pk2(s[2 * 33], s[3 * 33]); o.z = pk2(s[4 * 33], s[5 * 33]); o.w = pk2(s[6 * 33], s[7 * 33]);
        *(v4u*)(WT + (size_t)(n0 + n) * K + k0 + 8 * c) = o; }
    LDS_WAIT(); asm volatile("" ::: "memory");
}
template <bool I8>
__device__ __forceinline__ void tr_item8(const float* __restrict__ W, int K, int N, const float* __restrict__ gain, float scale, unsigned char* __restrict__ WT, LAS float* scr, int item, int lane) {
    const int nblk = N / 32, kb = item / nblk, nb = item - kb * nblk, k0 = 64 * kb, n0 = 32 * nb;
    f32x4 v[8];
#pragma unroll
    for (int i = 0; i < 8; ++i) { const int kk = 8 * i + (lane >> 3); v[i] = *(const f32x4*)(W + (size_t)(k0 + kk) * N + n0 + (lane & 7) * 4); }
#pragma unroll
    for (int i = 0; i < 8; ++i) { const int kk = 8 * i + (lane >> 3); const float g = (gain ? gain[k0 + kk] : 1.f) * scale; LAS float* s = scr + kk * 33 + (lane & 7) * 4;
        s[0] = v[i].x * g; s[1] = v[i].y * g; s[2] = v[i].z * g; s[3] = v[i].w * g; }
    LDS_WAIT(); asm volatile("" ::: "memory");
    const int c = lane & 7;
#pragma unroll
    for (int j = 0; j < 4; ++j) { const int n = (lane >> 3) + 8 * j; const LAS float* s = scr + (8 * c) * 33 + n;
        float f[8]; v2u o;
        if (I8) {
#pragma unroll
            for (int q = 0; q < 8; ++q) f[q] = rintf(fminf(fmaxf(s[q * 33], -127.f), 127.f));
            o.x = ((unsigned)(int)f[0] & 255u) | (((unsigned)(int)f[1] & 255u) << 8) | (((unsigned)(int)f[2] & 255u) << 16) | ((unsigned)(int)f[3] << 24);
            o.y = ((unsigned)(int)f[4] & 255u) | (((unsigned)(int)f[5] & 255u) << 8) | (((unsigned)(int)f[6] & 255u) << 16) | ((unsigned)(int)f[7] << 24);
        } else {
#pragma unroll
            for (int q = 0; q < 8; ++q) f[q] = fminf(fmaxf(s[q * 33], -448.f), 448.f);
            o.x = pg8::pk4_fp8(f[0], f[1], f[2], f[3]); o.y = pg8::pk4_fp8(f[4], f[5], f[6], f[7]); }
        *(v2u*)(WT + (size_t)(n0 + n) * K + k0 + 8 * c) = o; }
    LDS_WAIT(); asm volatile("" ::: "memory");
}
__device__ __forceinline__ float wave_max(float v) {
    v = fmaxf(v, xsw<1>(v)); v = fmaxf(v, xsw<2>(v)); v = fmaxf(v, xsw<4>(v)); v = fmaxf(v, xsw<8>(v)); v = fmaxf(v, xsw<16>(v));
    return xmax32(v);
}
__device__ __forceinline__ void row_load(const float* __restrict__ xrow, int lane, f32x4 (&ov)[16]) {
#pragma unroll
    for (int j = 0; j < 16; ++j) ov[j] = *(const f32x4*)(xrow + (lane + 64 * j) * 4);
}
__device__ __forceinline__ void row_to_bf16(const f32x4 (&ov)[16], bf16* __restrict__ orow, float* rs_out, unsigned* __restrict__ xq, float* as_out, int lane) {
    float ss = 0.f, am = 0.f;
#pragma unroll
    for (int j = 0; j < 16; ++j) { const int c = (lane + 64 * j) * 4; const f32x4 v = ov[j];
        ss += (v.x * v.x + v.y * v.y) + (v.z * v.z + v.w * v.w); am = fmaxf(fmaxf(am, fmaxf(fabsf(v.x), fabsf(v.y))), fmaxf(fabsf(v.z), fabsf(v.w)));
        v2u o; o.x = pk2(v.x, v.y); o.y = pk2(v.z, v.w); *(v2u*)(orow + c) = o; }
    ss = wave_sum(ss); am = fmaxf(wave_max(am), 1e-20f); const float qs = 127.0f / am;
#pragma unroll
    for (int j = 0; j < 16; ++j) { const int q0 = (int)rintf(ov[j].x * qs), q1 = (int)rintf(ov[j].y * qs), q2 = (int)rintf(ov[j].z * qs), q3 = (int)rintf(ov[j].w * qs);
        xq[lane + 64 * j] = ((unsigned)q0 & 255u) | (((unsigned)q1 & 255u) << 8) | (((unsigned)q2 & 255u) << 16) | ((unsigned)q3 << 24); }
    if (lane == 0) { *rs_out = 1.0f / sqrtf(ss * (1.0f / DM) + EPS); *as_out = am * (1.0f / 127.0f); }
}
__device__ __forceinline__ void resid_rows(bf16* __restrict__ XB, const bf16* __restrict__ Y, const float* __restrict__ PART, const float* __restrict__ g, float* __restrict__ RS,
                                           float* __restrict__ outf, unsigned* __restrict__ XQ, float* __restrict__ AS, int gw, int NGW, int lane) {
    f32x4 gv[16];
#pragma unroll
    for (int j = 0; j < 16; ++j) gv[j] = *(const f32x4*)(g + (lane + 64 * j) * 4);
    for (int m = gw; m < MTOK; m += NGW) {
        const float pv = PART[(size_t)m * 64 + lane];
        bf16* xrow = XB + (size_t)m * DM; const bf16* yrow = Y + (size_t)m * DM;
        v2u xr[16], yr[16];
#pragma unroll
        for (int j = 0; j < 16; ++j) { xr[j] = *(const v2u*)(xrow + (lane + 64 * j) * 4); yr[j] = *(const v2u*)(yrow + (lane + 64 * j) * 4); }
        const float ry = 1.0f / sqrtf(wave_sum(pv) * (1.0f / DM) + EPS);
        float ss = 0.f, am = 0.f; f32x4 ov[16];
#pragma unroll
        for (int j = 0; j < 16; ++j) { const int c = (lane + 64 * j) * 4;
            f32x4 o; o.x = bf_lo(xr[j].x) + bf_lo(yr[j].x) * ry * gv[j].x; o.y = bf_hi(xr[j].x) + bf_hi(yr[j].x) * ry * gv[j].y; o.z = bf_lo(xr[j].y) + bf_lo(yr[j].y) * ry * gv[j].z; o.w = bf_hi(xr[j].y) + bf_hi(yr[j].y) * ry * gv[j].w;
            ss += (o.x * o.x + o.y * o.y) + (o.z * o.z + o.w * o.w); ov[j] = o; am = fmaxf(fmaxf(am, fmaxf(fabsf(o.x), fabsf(o.y))), fmaxf(fabsf(o.z), fabsf(o.w)));
            if (outf) *(f32x4*)(outf + (size_t)m * DM + c) = o; else { v2u ob; ob.x = pk2(o.x, o.y); ob.y = pk2(o.z, o.w); *(v2u*)(xrow + c) = ob; } }
        if (XQ) {
            am = fmaxf(wave_max(am), 1e-20f); const float qs = 127.0f / am;
#pragma unroll
            for (int j = 0; j < 16; ++j) { const int q0 = (int)rintf(ov[j].x * qs), q1 = (int)rintf(ov[j].y * qs), q2 = (int)rintf(ov[j].z * qs), q3 = (int)rintf(ov[j].w * qs);
                XQ[(size_t)m * (DM / 4) + lane + 64 * j] = ((unsigned)q0 & 255u) | (((unsigned)q1 & 255u) << 8) | (((unsigned)q2 & 255u) << 16) | ((unsigned)q3 << 24); }
            if (lane == 0) AS[m] = am * (1.0f / 127.0f); }
        ss = wave_sum(ss);
        if (lane == 0) RS[m] = 1.0f / sqrtf(ss * (1.0f / DM) + EPS);
    }
}
__device__ __forceinline__ void mixpost_load(const bf16* __restrict__ MIX, const bf16* __restrict__ DT, int tok, int lane, v4u (&mx)[6], v2u (&ab)[4], v2u (&cb)[4]) {
#pragma unroll
    for (int j = 0; j < 6; ++j) mx[j] = *(const v4u*)(MIX + (size_t)tok * DM + (lane + 64 * j) * 8);
#pragma unroll
    for (int h = 0; h < 4; ++h) { const size_t off = (size_t)tok * 1024 + h * 256 + lane * 4; ab[h] = *(const v2u*)(DT + off); cb[h] = *(const v2u*)(DT + (size_t)MTOK * 1024 + off); }
}
__device__ __forceinline__ void mixpost_row(int tok, int lane, const v4u (&mx)[6], const v2u (&ab)[4], const v2u (&cb)[4], float lam, float oscale, f32x4 sg, unsigned char* __restrict__ MQ, float* __restrict__ MAS) {
    f32x4 yd[4]; float am = 0.f;
#pragma unroll
    for (int h = 0; h < 4; ++h) {
        f32x4 a, c; a.x = bf_lo(ab[h].x); a.y = bf_hi(ab[h].x); a.z = bf_lo(ab[h].y); a.w = bf_hi(ab[h].y); c.x = bf_lo(cb[h].x); c.y = bf_hi(cb[h].x); c.z = bf_lo(cb[h].y); c.w = bf_hi(cb[h].y);
        f32x4 d; d.x = a.x - lam * c.x; d.y = a.y - lam * c.y; d.z = a.z - lam * c.z; d.w = a.w - lam * c.w;
        const float ss = wave_sum((d.x * d.x + d.y * d.y) + (d.z * d.z + d.w * d.w)); const float r = oscale / sqrtf(ss * (1.0f / 256.0f) + EPS);
        yd[h].x = d.x * r * sg.x; yd[h].y = d.y * r * sg.y; yd[h].z = d.z * r * sg.z; yd[h].w = d.w * r * sg.w;
        am = fmaxf(fmaxf(am, fmaxf(fabsf(yd[h].x), fabsf(yd[h].y))), fmaxf(fabsf(yd[h].z), fabsf(yd[h].w))); }
    float mv[6][8];
#pragma unroll
    for (int j = 0; j < 6; ++j) { const unsigned w4[4] = {mx[j].x, mx[j].y, mx[j].z, mx[j].w};
#pragma unroll
        for (int e = 0; e < 4; ++e) { mv[j][2 * e] = bf_lo(w4[e]); mv[j][2 * e + 1] = bf_hi(w4[e]); am = fmaxf(am, fmaxf(fabsf(mv[j][2 * e]), fabsf(mv[j][2 * e + 1]))); } }
    am = fmaxf(wave_max(am), 1e-20f); const float qs = 127.0f / am;
    unsigned char* qrow = MQ + (size_t)tok * DM;
#pragma unroll
    for (int j = 0; j < 6; ++j) { int q[8];
#pragma unroll
        for (int e = 0; e < 8; ++e) q[e] = (int)rintf(mv[j][e] * qs);
        v2u o; o.x = ((unsigned)q[0] & 255u) | (((unsigned)q[1] & 255u) << 8) | (((unsigned)q[2] & 255u) << 16) | ((unsigned)q[3] << 24);
        o.y = ((unsigned)q[4] & 255u) | (((unsigned)q[5] & 255u) << 8) | (((unsigned)q[6] & 255u) << 16) | ((unsigned)q[7] << 24);
        *(v2u*)(qrow + (lane + 64 * j) * 8) = o; }
#pragma unroll
    for (int h = 0; h < 4; ++h) { const int q0 = (int)rintf(yd[h].x * qs), q1 = (int)rintf(yd[h].y * qs), q2 = (int)rintf(yd[h].z * qs), q3 = (int)rintf(yd[h].w * qs);
        *(unsigned*)(qrow + 3072 + h * 256 + lane * 4) = ((unsigned)q0 & 255u) | (((unsigned)q1 & 255u) << 8) | (((unsigned)q2 & 255u) << 16) | ((unsigned)q3 << 24); }
    if (lane == 0) MAS[tok] = am * (1.0f / 127.0f);
}
__device__ __forceinline__ int t5_bucket(int rel) {
    const int n = rel < 0 ? -rel : rel; int b;
    if (n < 8) b = n; else { const int l2 = 31 - __builtin_clz((unsigned)(n * n)); b = 8 + (l2 - 6); if (b > 15) b = 15; }
    return b + (rel > 0 ? 16 : 0);
}

constexpr int I_IN = (DM / 128) * (DIN / 32), I_OUT = (DM / 128) * (DM / 32), I_MI = (DM / 128) * (DFF / 32), I_MO = (DFF / 128) * (DM / 32);
struct ItemD { const float* W; const float* gain; unsigned char* WT; float scale; int K, N, r, kind; };
__device__ __forceinline__ void conv_load(const ItemD& d, int lane, f32x4 (&v)[16]) {
    const int nblk = d.N / 32, kb = d.r / nblk, nb = d.r - kb * nblk, k0 = 128 * kb + 16 * (lane >> 3), n0 = 32 * nb + 4 * (lane & 7);
#pragma unroll
    for (int i = 0; i < 16; ++i) v[i] = *(const f32x4*)(d.W + (size_t)(k0 + i) * d.N + n0);
}
template <int KIND>
__device__ __forceinline__ void conv_finish(const ItemD& d, int lane, const f32x4 (&v)[16]) {
    const int nblk = d.N / 32, kb = d.r / nblk, nb = d.r - kb * nblk, k0 = 128 * kb + 16 * (lane >> 3), n0 = 32 * nb + 4 * (lane & 7);
    float gs[16];
    if (d.gain) {
#pragma unroll
        for (int i = 0; i < 4; ++i) { const f32x4 g4 = *(const f32x4*)(d.gain + k0 + 4 * i); gs[4 * i] = g4.x * d.scale; gs[4 * i + 1] = g4.y * d.scale; gs[4 * i + 2] = g4.z * d.scale; gs[4 * i + 3] = g4.w * d.scale; }
    } else {
#pragma unroll
        for (int i = 0; i < 16; ++i) gs[i] = d.scale; }
#pragma unroll
    for (int j = 0; j < 4; ++j) {
        if (KIND == 0) { v4u o0, o1;
            o0.x = pk2(v[0][j] * gs[0], v[1][j] * gs[1]); o0.y = pk2(v[2][j] * gs[2], v[3][j] * gs[3]); o0.z = pk2(v[4][j] * gs[4], v[5][j] * gs[5]); o0.w = pk2(v[6][j] * gs[6], v[7][j] * gs[7]);
            o1.x = pk2(v[8][j] * gs[8], v[9][j] * gs[9]); o1.y = pk2(v[10][j] * gs[10], v[11][j] * gs[11]); o1.z = pk2(v[12][j] * gs[12], v[13][j] * gs[13]); o1.w = pk2(v[14][j] * gs[14], v[15][j] * gs[15]);
            bf16* dst = (bf16*)d.WT + (size_t)(n0 + j) * d.K + k0; *(v4u*)dst = o0; *(v4u*)(dst + 8) = o1;
        } else { unsigned w[4];
#pragma unroll
            for (int t = 0; t < 4; ++t) {
                if (KIND == 1) { int b[4];
#pragma unroll
                    for (int e = 0; e < 4; ++e) { const int bits = __float_as_int(fmaf(v[4 * t + e][j], gs[4 * t + e], 12582912.0f)); b[e] = min(max(bits, 0x4B400000 - 127), 0x4B400000 + 127); }
                    w[t] = __builtin_amdgcn_perm((unsigned)b[1], (unsigned)b[0], 0x0c0c0400u) | __builtin_amdgcn_perm((unsigned)b[3], (unsigned)b[2], 0x04000c0cu);
                } else { float f[4];
#pragma unroll
                    for (int e = 0; e < 4; ++e) f[e] = __builtin_amdgcn_fmed3f(v[4 * t + e][j] * gs[4 * t + e], -448.f, 448.f);
                    w[t] = pg8::pk4_fp8(f[0], f[1], f[2], f[3]); } }
            v4u o; o.x = w[0]; o.y = w[1]; o.z = w[2]; o.w = w[3];
            *(v4u*)(d.WT + (size_t)(n0 + j) * d.K + k0) = o; } }
}
constexpr int CONV_TAIL_ITEMS = 8192;
struct ConvSrc { const float *w_in, *w_out, *w_mlp_in, *w_mlp_out, *ln_attn_pre, *ln_mlp_pre; };
__device__ __forceinline__ int conv_cnt(int t0, int t1, int t) { return (t0 <= t && t < t1) ? (t == 0 ? I_IN : t == 1 ? I_OUT : t == 2 ? I_MI : I_MO) : 0; }
__device__ __forceinline__ void conv_decode(const ConvSrc& cs, unsigned char* ws, float sa_in, float sa_mi, float sa_out, float sb_in, int la, int a0, int a1, int lb, int b0, int b1, int na, int it, ItemD& d) {
    const bool inA = it < na; const int l = inA ? la : lb, t0 = inA ? a0 : b0, t1 = inA ? a1 : b1; int r = inA ? it : it - na; unsigned char* wl = ws + WS_W + (size_t)l * W_LAYER_B;
    const int n0 = conv_cnt(t0, t1, 0), n1 = conv_cnt(t0, t1, 1), n2 = conv_cnt(t0, t1, 2);
    if (r < n0) { d = ItemD{cs.w_in + (size_t)l * DM * DIN, cs.ln_attn_pre + l * DM, wl, inA ? sa_in : sb_in, DM, DIN, r, 1}; return; } r -= n0;
    if (r < n1) { d = ItemD{cs.w_out + (size_t)l * DM * DM, nullptr, wl + W_IN_B, sa_out, DM, DM, r, 1}; return; } r -= n1;
    if (r < n2) { d = ItemD{cs.w_mlp_in + (size_t)l * DM * DFF, cs.ln_mlp_pre + l * DM, wl + W_IN_B + W_OUT_B, sa_mi, DM, DFF, r, 1}; return; } r -= n2;
    d = ItemD{cs.w_mlp_out + (size_t)l * DFF * DM, nullptr, wl + W_IN_B + W_OUT_B + W_MI_B, WMO_SCALE, DFF, DM, r, 2};
}
__device__ __forceinline__ void conv_stream(const ConvSrc& cs, unsigned char* ws, float sa_in, float sa_mi, float sa_out, float sb_in, int la, int a0, int a1, int lb, int b0, int b1, int it0, int it1, int gw, int NGW, int lane) {
    const int na = conv_cnt(a0, a1, 0) + conv_cnt(a0, a1, 1) + conv_cnt(a0, a1, 2) + conv_cnt(a0, a1, 3), nb = conv_cnt(b0, b1, 0) + conv_cnt(b0, b1, 1) + conv_cnt(b0, b1, 2) + conv_cnt(b0, b1, 3), ntot = na + nb;
    const int iend = it1 < ntot ? it1 : ntot;
    for (int it = it0 + gw; it < iend; it += 2 * NGW) { ItemD c0, c1; f32x4 v0[16], v1[16]; const bool two = it + NGW < iend;
        conv_decode(cs, ws, sa_in, sa_mi, sa_out, sb_in, la, a0, a1, lb, b0, b1, na, it, c0); conv_load(c0, lane, v0);
        if (two) { conv_decode(cs, ws, sa_in, sa_mi, sa_out, sb_in, la, a0, a1, lb, b0, b1, na, it + NGW, c1); conv_load(c1, lane, v1); }
        if (c0.kind == 1) conv_finish<1>(c0, lane, v0); else if (c0.kind == 2) conv_finish<2>(c0, lane, v0); else conv_finish<0>(c0, lane, v0);
        if (two) { if (c1.kind == 1) conv_finish<1>(c1, lane, v1); else if (c1.kind == 2) conv_finish<2>(c1, lane, v1); else conv_finish<0>(c1, lane, v1); } }
}

struct Args { const float* in[16]; float* out; unsigned char* ws; int ph_lo, ph_hi, li, pad; };
constexpr int NPHASES = 1 + 9 * DEPTH;

typedef __attribute__((address_space(4))) const Args* CArgs;
#define PH_ENTER() CArgs A_ = (CArgs)__builtin_amdgcn_kernarg_segment_ptr(); asm volatile("" : "+s"(A_)); unsigned char* ws = A_->ws; \
    int wave = wave0; asm volatile("" : "+s"(wave)); int lane = lane_id(); asm volatile("" : "+v"(lane)); const int tid = wave * 64 + lane; (void)tid; \
    const int G = gridDim.x, bx = blockIdx.x, vcu = (G % 8 == 0) ? (bx % 8) * (G / 8) + bx / 8 : bx; const int gw = vcu * NWAVES + wave, NGW = G * NWAVES; (void)lane; (void)gw; (void)NGW; (void)ws; (void)bx;
#define IN_(k) (A_->in[k])

__global__ void __launch_bounds__(NWAVES * 64, 2) mk_fwd(Args args) {
    extern __shared__ __attribute__((aligned(16))) unsigned char lds_raw[];
    LAS unsigned char* lds = (LAS unsigned char*)lds_raw;
    XcdBarrier bar; const int wave0 = __builtin_amdgcn_readfirstlane((int)threadIdx.x >> 6);
    { volatile LAS unsigned* MISC = (volatile LAS unsigned*)(lds + MISC_OFF);
      for (int u = threadIdx.x; u < (LDS_BYTES - LDSCTL_OFF) / 4; u += NWAVES * 64) ((LAS unsigned*)(lds + LDSCTL_OFF))[u] = 0u;
      __syncthreads();
      bar = xcd_barrier_post((unsigned*)(args.ws + WS_CTL) + CW_BAR + args.li * XCD_BAR_WORDS, MISC + 8); }
    const int lo = args.ph_lo, hi = args.ph_hi;
#define IN(k) (lo <= (k) && (k) < hi)
#ifndef PROBE_DUP
#define PROBE_DUP 0
#endif
#define DUPN(bit) (((PROBE_DUP >> (bit)) & 1) ? 2 : 1)
#define SEAM(k) do { if (IN(k) && IN((k) + 1)) xcd_barrier(bar); } while (0)

    if (IN(0)) for (int dup_ = 0; dup_ < DUPN(0); ++dup_) {
        PH_ENTER();
        const float* x_in = IN_(0); const float* ln_attn_pre = IN_(1); const float* ln_mlp_pre = IN_(3); const float* w_in = IN_(5); const float* w_out = IN_(6); const float* w_mlp_in = IN_(14); const float* w_mlp_out = IN_(15);
        float* RS = (float*)(ws + WS_RS); float* ROPE = (float*)(ws + WS_ROPE); bf16* XB = (bf16*)(ws + WS_XB);
        LAS float* scr = (LAS float*)(lds + wave * 16384);
        float wqi0 = 0.f;
        { float am[3 * DEPTH], gm[3 * DEPTH];
#pragma unroll
          for (int t = 0; t < 3 * DEPTH; ++t) { const int l = t / 3, kd = t - 3 * l;
            am[t] = 0.f; gm[t] = 0.f; if (t != 0 && (t % G) != bx) continue;
            const float* wsrc = kd == 0 ? w_in + (size_t)l * DM * DIN : kd == 1 ? w_mlp_in + (size_t)l * DM * DFF : w_out + (size_t)l * DM * DM; const float* gs = (kd == 0 ? ln_attn_pre : ln_mlp_pre) + l * DM; float a = 0.f, g = 0.f;
#pragma unroll 8
            for (int i = 0; i < 32; ++i) { const f32x4 v = *(const f32x4*)(wsrc + (size_t)(tid + 512 * i) * 4); a = fmaxf(fmaxf(a, fmaxf(fabsf(v.x), fabsf(v.y))), fmaxf(fabsf(v.z), fabsf(v.w))); }
            if (kd == 2) g = 1.f; else {
#pragma unroll
                for (int i = 0; i < 8; ++i) g = fmaxf(g, fabsf(gs[tid + 512 * i])); }
            am[t] = wave_max(a); gm[t] = wave_max(g); }
          LAS float* red = (LAS float*)(lds + 131072 - 1024);
          __syncthreads();
          if (lane == 0) {
#pragma unroll
            for (int t = 0; t < 3 * DEPTH; ++t) { red[t * 16 + wave] = am[t]; red[t * 16 + 8 + wave] = gm[t]; } }
          __syncthreads();
#pragma unroll
          for (int t = 0; t < 3 * DEPTH; ++t) { float a2 = 0.f, g2 = 0.f;
#pragma unroll
            for (int w = 0; w < 8; ++w) { a2 = fmaxf(a2, red[t * 16 + w]); g2 = fmaxf(g2, red[t * 16 + 8 + w]); }
            const float amax = fmaxf(a2 * g2 * 1.0f, 1e-20f); if (t == 0) wqi0 = 127.0f / amax;
            if ((t % G) == bx && tid == 0) { ((float*)(ws + WS_WQS))[t] = amax * (1.0f / 127.0f); ((float*)(ws + WS_WQS))[8 + t] = 127.0f / amax; } } }
        { const ConvSrc cs{w_in, w_out, w_mlp_in, w_mlp_out, ln_attn_pre, ln_mlp_pre};
          conv_stream(cs, ws, wqi0, 0.f, 0.f, 0.f, 0, 0, 1, 0, 0, 0, 0, 1 << 30, gw, NGW, lane); }
        if (gw < MTOK) {
            const int n = (MTOK - gw + NGW - 1) / NGW, lastm = gw + (n - 1) * NGW; f32x4 rA[16], rB[16];
#define ROW_OUT(m_, r_) row_to_bf16(r_, XB + (size_t)(m_) * DM, RS + (m_), (unsigned*)(ws + WS_XQ) + (size_t)(m_) * (DM / 4), (float*)(ws + WS_AS) + (m_), lane)
            row_load(x_in + (size_t)gw * DM, lane, rA);
            for (int k = 0; k < n; k += 2) { const int m1 = min(gw + (k + 1) * NGW, lastm), m2 = min(gw + (k + 2) * NGW, lastm);
                row_load(x_in + (size_t)m1 * DM, lane, rB); ROW_OUT(gw + k * NGW, rA);
                row_load(x_in + (size_t)m2 * DM, lane, rA); ROW_OUT(m1, rB); }
#undef ROW_OUT
        }
        for (int i = gw * 64 + lane; i < SEQ * 64; i += NGW * 64) { const int pos = i >> 6, pi = i & 63, j = pi & 31; const float p = (float)((pi < 32) ? (pos >> 6) : (pos & 63));
            const float inv = exp2f(-(float)j * (13.287712379549449f / 32.0f)); float t = (p * inv) * 0.15915494309189535f; t -= floorf(t);
            ROPE[2 * i] = __builtin_amdgcn_cosf(t); ROPE[2 * i + 1] = __builtin_amdgcn_sinf(t); }
    }
    SEAM(0);

    for (int l = 0; l < DEPTH; ++l) {
        const int pb = 1 + 9 * l;

        if (IN(pb + 0)) for (int dup_ = 0; dup_ < DUPN(1); ++dup_) {
            PH_ENTER();
            const bf16* Win_t = (const bf16*)(ws + WS_W + (size_t)l * W_LAYER_B);
            pg8::Gemm g{(const bf16*)(ws + WS_XQ), Win_t, MTOK, DIN, DM / 2}; pg8::StaticOrder S; S.init(MTOK, DIN, G, bx);
            pg8::EpiProjI8 E{(bf16*)(ws + WS_PROJ), DIN, (const float*)(ws + WS_RS), (const float*)(ws + WS_AS), (const float*)(ws + WS_WQS) + 3 * l, (LAS float*)(lds + RING_BYTES + 1024), IN_(8) + l * 128, IN_(9) + l * 128, (const float*)(ws + WS_ROPE), SEQ};
            pg8::gemm_phase<pg8::EpiProjI8, pg8::StaticOrder, true, true, 2>(lds, g, S, E, tid);
            { const int nwg = (MTOK / 256) * (DIN / 256), rem = nwg % G;
              if (dup_ == 0 && rem > 0 && bx >= rem) { const float* qsc = (const float*)(ws + WS_WQS) + 8; const ConvSrc cs{IN_(5), IN_(6), IN_(14), IN_(15), IN_(1), IN_(3)};
                  conv_stream(cs, ws, 0.f, qsc[3 * l + 1], qsc[3 * l + 2], (l + 1 < DEPTH) ? qsc[3 * l + 3] : 0.f, l, 1, 4, l + 1, 0, (l + 1 < DEPTH) ? 1 : 0, 0, CONV_TAIL_ITEMS, (bx - rem) * NWAVES + wave, (G - rem) * NWAVES, lane); }
            }
        }
        SEAM(pb + 0);


        if (IN(pb + 2)) for (int dup_ = 0; dup_ < DUPN(3); ++dup_) {
            PH_ENTER();
            const bf16* PROJ = (const bf16*)(ws + WS_PROJ); bf16* MIX = (bf16*)(ws + WS_MIX); bf16* DT = (bf16*)(ws + WS_DT);
            const float* na_rpb = IN_(7); const float* sw_sink = IN_(10); const float* t5_table = IN_(13);
            LAS float* tab = (LAS float*)(lds + att::OFF_TAB);
            const int cslot = vcu % 5; int ui = 0;
            for (int s = vcu; s < 1280; s += G, ++ui) {
                if (ui == cslot) {
                    CArgs A2 = (CArgs)__builtin_amdgcn_kernarg_segment_ptr(); asm volatile("" : "+s"(A2)); unsigned char* ws2 = A2->ws;
                    int wv2 = wave0; asm volatile("" : "+s"(wv2)); int ln2 = lane_id(); asm volatile("" : "+v"(ln2)); const int gw2 = vcu * NWAVES + wv2;
                    const float* qsc = (const float*)(ws2 + WS_WQS) + 8;
                    const ConvSrc cs{A2->in[5], A2->in[6], A2->in[14], A2->in[15], A2->in[1], A2->in[3]};
                    conv_stream(cs, ws2, 0.f, qsc[3 * l + 1], qsc[3 * l + 2], (l + 1 < DEPTH) ? qsc[3 * l + 3] : 0.f, l, 1, 4, l + 1, 0, (l + 1 < DEPTH) ? 1 : 0, (((MTOK / 256) * (DIN / 256)) % G) ? CONV_TAIL_ITEMS : 0, 1 << 30, gw2, NGW, ln2); }
                const int kind = s >> 8, v = s & 255; int t2 = wave * 64 + lane_id(); asm volatile("" : "+v"(t2));
                const bf16 *Qp, *Kp; int vdelta, mode, kbeg = 0, nkeys = SEQ, qt = v & 7; float sink = 0.f; void* Op;
                if (kind == 0) {
                    const int b = v >> 6, hq = (v >> 3) & 7; mode = att::MODE_B;
                    const bf16* base = PROJ + (size_t)(b * SEQ) * DIN;
                    Qp = base + (size_t)(qt * 256) * DIN + C_BQ + hq * 128; Kp = base + C_BK + (hq >> 2) * 128; vdelta = C_BV - C_BK;
                    Op = MIX + (size_t)(b * SEQ + qt * 256) * DM + 1024 + hq * 128;
                } else if (kind <= 2) {
                    const int u = v + 256 * (kind - 1), b = u >> 7, h = (u >> 5) & 3, sm = (u >> 4) & 1, vh = (u >> 3) & 1; mode = att::MODE_D;
                    const bf16* base = PROJ + (size_t)(b * SEQ) * DIN;
                    Qp = base + (size_t)(qt * 256) * DIN + C_DQ + sm * 512 + h * 128; Kp = base + C_DK + sm * 512 + h * 128; vdelta = (C_DV + h * 256 + vh * 128) - (C_DK + sm * 512 + h * 128);
                    Op = DT + (size_t)sm * MTOK * 1024 + (size_t)(b * SEQ + qt * 256) * 1024 + h * 256 + vh * 128;
                    for (int i = t2; i < 768; i += NWAVES * 64) tab[i] = t5_table[t5_bucket(i - att::TREL) * 12 + 8 + h] * att::INV_SCALE;
                } else if (kind == 3) {
                    const int b = v >> 6, h = (v >> 3) & 7; mode = att::MODE_A;
                    int rlo = min(max(4 * qt - 4, 0), 24), rhi = min(max(4 * qt + 3 - 4, 0), 24) + 8;
                    if ((rhi - rlo) & 1) { if (rlo > 0) --rlo; else ++rhi; }
                    kbeg = rlo * 64; nkeys = (rhi - rlo) * 64;
                    const bf16* base = PROJ + (size_t)(b * SEQ) * DIN;
                    Qp = base + (size_t)(qt * 256) * DIN + C_AQ + h * 128; Kp = base + (size_t)kbeg * DIN + C_AK + h * 128; vdelta = C_AV - C_AK;
                    Op = MIX + (size_t)(b * SEQ + qt * 256) * DM + h * 128;
                    const float* rp = na_rpb + ((size_t)l * 8 + h) * 15 * 31;
                    for (int i = t2; i < 15 * 128; i += NWAVES * 64) { const int dr = i >> 7, dc = (i & 127) - 48; tab[i] = (dc >= 0 && dc < 31) ? rp[dr * 31 + dc] * att::INV_SCALE : 0.f; }
                } else {
                    const int b = v >> 6, hq = (v >> 3) & 7; qt = (v + 4) & 7; mode = att::MODE_C;
                    kbeg = max(0, qt * 256 - 128); const int kend = min(SEQ, qt * 256 + 256 + 128); nkeys = kend - kbeg;
                    const bf16* base = PROJ + (size_t)(b * SEQ) * DIN;
                    Qp = base + (size_t)(qt * 256) * DIN + C_CQ + hq * 128; Kp = base + (size_t)kbeg * DIN + C_CK + (hq >> 2) * 128; vdelta = C_CV - C_CK;
                    Op = MIX + (size_t)(b * SEQ + qt * 256) * DM + 2048 + hq * 128;
                    sink = sw_sink[l * 8 + hq];
                    for (int i = t2; i < 768; i += NWAVES * 64) { const int rel = i - att::TREL; tab[i] = (rel >= -128 && rel <= 128) ? t5_table[t5_bucket(rel) * 12 + hq] * att::INV_SCALE : att::MASKV; }
                }
                att::attn_unit<DIN>(Qp, Kp, vdelta, nkeys, mode, kbeg, qt * 256, (const LAS float*)tab, sink, Op, (att::lptr)lds, t2);
            }
            if (ui <= cslot) {
                int ln3 = lane_id(); asm volatile("" : "+v"(ln3)); const float* qsc = (const float*)(ws + WS_WQS) + 8;
                const ConvSrc cs{IN_(5), IN_(6), IN_(14), IN_(15), IN_(1), IN_(3)};
                conv_stream(cs, ws, 0.f, qsc[3 * l + 1], qsc[3 * l + 2], (l + 1 < DEPTH) ? qsc[3 * l + 3] : 0.f, l, 1, 4, l + 1, 0, (l + 1 < DEPTH) ? 1 : 0, (((MTOK / 256) * (DIN / 256)) % G) ? CONV_TAIL_ITEMS : 0, 1 << 30, gw, NGW, ln3); }
        }
        SEAM(pb + 2);

        if (IN(pb + 3)) for (int dup_ = 0; dup_ < DUPN(4); ++dup_) {
            PH_ENTER();
            const bf16* DT = (const bf16*)(ws + WS_DT); const bf16* MIX = (const bf16*)(ws + WS_MIX); unsigned char* MQ = ws + WS_XQ; float* MAS = (float*)(ws + WS_MAS);
            const float lam_init = 0.8f - 0.6f * expf(-0.3f * (float)l);
            const float* lp = IN_(11) + l * 512;
            const float s1 = wave_sum(lp[lane] * lp[128 + lane] + lp[64 + lane] * lp[192 + lane]), s2 = wave_sum(lp[256 + lane] * lp[384 + lane] + lp[320 + lane] * lp[448 + lane]);
            const float lam = expf(s1) - expf(s2) + lam_init, oscale = 1.0f - lam_init;
            const f32x4 sg = *(const f32x4*)(IN_(12) + l * 256 + lane * 4);
            { const int n = (MTOK - gw + NGW - 1) / NGW, lastt = gw + (n - 1) * NGW;
              v4u mxA[6], mxB[6]; v2u abA[4], cbA[4], abB[4], cbB[4];
              mixpost_load(MIX, DT, gw, lane, mxA, abA, cbA);
              for (int k = 0; k < n; k += 2) {
                  mixpost_load(MIX, DT, min(gw + (k + 1) * NGW, lastt), lane, mxB, abB, cbB);
                  mixpost_row(gw + k * NGW, lane, mxA, abA, cbA, lam, oscale, sg, MQ, MAS);
                  mixpost_load(MIX, DT, min(gw + (k + 2) * NGW, lastt), lane, mxA, abA, cbA);
                  mixpost_row(min(gw + (k + 1) * NGW, lastt), lane, mxB, abB, cbB, lam, oscale, sg, MQ, MAS);
              } }
        }
        SEAM(pb + 3);

        if (IN(pb + 4)) for (int dup_ = 0; dup_ < DUPN(5); ++dup_) {
            PH_ENTER();
            const bf16* Wout_t = (const bf16*)(ws + WS_W + (size_t)l * W_LAYER_B + W_IN_B);
            pg8::Gemm g{(const bf16*)(ws + WS_XQ), Wout_t, MTOK, DM, DM / 2}; pg8::StaticOrder S; S.init(MTOK, DM, G, bx);
            pg8::EpiYStats<true> E{(bf16*)(ws + WS_Y), DM, (float*)(ws + WS_PART), 1.0f, (const float*)(ws + WS_MAS), (const float*)(ws + WS_WQS) + 3 * l + 2};
            pg8::gemm_phase<pg8::EpiYStats<true>, pg8::StaticOrder, true, true, 2>(lds, g, S, E, tid);
        }
        SEAM(pb + 4);

        if (IN(pb + 5)) {
            PH_ENTER();
            resid_rows((bf16*)(ws + WS_XB), (const bf16*)(ws + WS_Y), (const float*)(ws + WS_PART), IN_(2) + l * DM, (float*)(ws + WS_RS), nullptr, (unsigned*)(ws + WS_XQ), (float*)(ws + WS_AS), gw, NGW, lane);
        }
        SEAM(pb + 5);

        if (IN(pb + 6)) for (int dup_ = 0; dup_ < DUPN(7); ++dup_) {
            PH_ENTER();
            const bf16* Wmi_t = (const bf16*)(ws + WS_W + (size_t)l * W_LAYER_B + W_IN_B + W_OUT_B);
            pg8::Gemm g{(const bf16*)(ws + WS_XQ), Wmi_t, MTOK, DFF, DM / 2}; pg8::StaticOrder S; S.init(MTOK, DFF, G, bx);
            pg8::EpiRelu2Fp8<true> E{(unsigned char*)(ws + WS_U), DFF, (const float*)(ws + WS_RS), (const float*)(ws + WS_AS), (const float*)(ws + WS_WQS) + 3 * l + 1, U_SCALE};
            pg8::gemm_phase<pg8::EpiRelu2Fp8<true>, pg8::StaticOrder, true, true, 2>(lds, g, S, E, tid);
        }
        SEAM(pb + 6);

        if (IN(pb + 7)) for (int dup_ = 0; dup_ < DUPN(8); ++dup_) {
            PH_ENTER();
            const bf16* Wmo_t = (const bf16*)(ws + WS_W + (size_t)l * W_LAYER_B + W_IN_B + W_OUT_B + W_MI_B);
            pg8::Gemm g{(const bf16*)(ws + WS_U), Wmo_t, MTOK, DM, DFF / 2}; pg8::StaticOrder S; S.init(MTOK, DM, G, bx);
            pg8::EpiYStats<false> E{(bf16*)(ws + WS_Y), DM, (float*)(ws + WS_PART), 1.0f / (U_SCALE * WMO_SCALE), nullptr, nullptr};
            pg8::gemm_phase<pg8::EpiYStats<false>, pg8::StaticOrder, true, true, 1>(lds, g, S, E, tid);
        }
        SEAM(pb + 7);

        if (IN(pb + 8)) {
            PH_ENTER();
            resid_rows((bf16*)(ws + WS_XB), (const bf16*)(ws + WS_Y), (const float*)(ws + WS_PART), IN_(4) + l * DM, (float*)(ws + WS_RS), (l == DEPTH - 1) ? A_->out : nullptr, (l == DEPTH - 1) ? nullptr : (unsigned*)(ws + WS_XQ), (float*)(ws + WS_AS), gw, NGW, lane);
        }
        SEAM(pb + 8);
    }
#undef IN
#undef SEAM
}

#ifndef MK_PER_PHASE
#define MK_PER_PHASE 0
#endif
extern "C" void kernel_launch(void* const* d_in, const int* in_sizes, int n_in, void* d_out, int out_size, void* d_ws, size_t ws_size, hipStream_t stream) {
    static int grid = 0;
    if (grid == 0) {
        if (n_in != 16 || in_sizes[0] != MTOK * DM || out_size != MTOK * DM || ws_size < WS_END) {
            fprintf(stderr, "kernel_launch: shape mismatch: n_in %d in0 %d out %d ws %zu (need %zu); nothing launched\n", n_in, n_in > 0 ? in_sizes[0] : -1, out_size, ws_size, (size_t)WS_END); grid = -1; return; }
        int dev = 0, cus = 0, per_cu = 0;
        if (hipGetDevice(&dev) != hipSuccess || hipDeviceGetAttribute(&cus, hipDeviceAttributeMultiprocessorCount, dev) != hipSuccess) { fprintf(stderr, "kernel_launch: device query failed\n"); grid = -1; return; }
        if (hipFuncSetAttribute((const void*)mk_fwd, hipFuncAttributeMaxDynamicSharedMemorySize, LDS_BYTES) != hipSuccess) { fprintf(stderr, "kernel_launch: hipFuncSetAttribute failed\n"); grid = -1; return; }
        if (hipOccupancyMaxActiveBlocksPerMultiprocessor(&per_cu, (const void*)mk_fwd, NWAVES * 64, LDS_BYTES) != hipSuccess || per_cu < 1)
            fprintf(stderr, "kernel_launch: note: occupancy query reports %d workgroups per CU\n", per_cu);
        (void)hipGetLastError();
        grid = cus;
    }
    if (grid < 0) return;
    if (hipMemsetAsync((char*)d_ws + WS_CTL, 0, CTL_ZERO_BYTES, stream) != hipSuccess) { fprintf(stderr, "kernel_launch: memset failed\n"); return; }
    Args a{};
    for (int i = 0; i < 16; ++i) a.in[i] = (const float*)d_in[i];
    a.out = (float*)d_out; a.ws = (unsigned char*)d_ws; a.pad = 0;
#if MK_PER_PHASE
    for (int p = 0; p < NPHASES; ++p) { a.ph_lo = p; a.ph_hi = p + 1; a.li = p; hipLaunchKernelGGL(mk_fwd, dim3(grid), dim3(NWAVES * 64), LDS_BYTES, stream, a); }
#else
    a.ph_lo = 0; a.ph_hi = NPHASES; a.li = 0;
    hipLaunchKernelGGL(mk_fwd, dim3(grid), dim3(NWAVES * 64), LDS_BYTES, stream, a);
#endif
    const hipError_t le = hipPeekAtLastError();
    if (le != hipSuccess) fprintf(stderr, "kernel_launch: launch failed: %s\n", hipGetErrorName(le));
}
```

```cpp
#include <hip/hip_runtime.h>
#include <cstdio>
#include <cstdint>

template <int O> __device__ __forceinline__ float xsw(float v) { return __int_as_float(__builtin_amdgcn_ds_swizzle(__float_as_int(v), (O << 10) | 0x1f)); }
__device__ __forceinline__ float xsum32(float v) { auto rr = __builtin_amdgcn_permlane32_swap(__float_as_uint(v), __float_as_uint(v), false, false); return __uint_as_float(rr[0]) + __uint_as_float(rr[1]); }
__device__ __forceinline__ float xmax32(float v) { auto rr = __builtin_amdgcn_permlane32_swap(__float_as_uint(v), __float_as_uint(v), false, false); return fmaxf(__uint_as_float(rr[0]), __uint_as_float(rr[1])); }

template <int OFF = 0, class V> __device__ __forceinline__ void st_wt16(void* p, V v) { static_assert(sizeof(V) == 16, ""); asm volatile("global_store_dwordx4 %0, %1, off offset:%2 sc1\n\ts_nop 1" :: "v"(p), "v"(v), "i"(OFF)); }
template <int OFF = 0, class V> __device__ __forceinline__ void st_wt8(void* p, V v) { static_assert(sizeof(V) == 8, ""); asm volatile("global_store_dwordx2 %0, %1, off offset:%2 sc1\n\ts_nop 1" :: "v"(p), "v"(v), "i"(OFF)); }
__device__ __forceinline__ void st_wt4(void* p, unsigned v) { asm volatile("global_store_dword %0, %1, off sc1\n\ts_nop 1" :: "v"(p), "v"(v)); }
namespace pg8 {
#define PG8_LAS __attribute__((address_space(3)))
typedef unsigned short bf16_t;
typedef short bf16x8 __attribute__((ext_vector_type(8)));
typedef float f32x4 __attribute__((ext_vector_type(4)));
typedef unsigned u32x4 __attribute__((ext_vector_type(4)));
typedef int i32x4 __attribute__((ext_vector_type(4)));
typedef int i32x8 __attribute__((ext_vector_type(8)));
typedef unsigned u32x2 __attribute__((ext_vector_type(2)));
constexpr int BM = 256, BK = 64, HALF = 128, HTB = HALF * BK * 2  , STAGE_BYTES = 8 * HTB, NXCD = 8, WGM = 4;

__host__ __device__ __forceinline__ int lds_byte(int r, int c) { const int st = (r >> 4) * 2 + (c >> 5), rr = r & 15, cc = c & 31, ob = rr * 64 + cc * 2; return st * 1024 + (ob ^ (((ob >> 9) & 1) << 5)); }
__host__ __device__ __forceinline__ void stage_rc(int b, int& R, int& C) { const int st = b / 1024, sb = b % 1024, swz = sb ^ (((sb >> 9) & 1) << 5); R = (st >> 1) * 16 + swz / 64; C = (st & 1) * 32 + (swz % 64) / 2; }
__host__ __device__ __forceinline__ int perm32(int rho) { const int n = rho >> 4, i = rho & 15; return 8 * (i >> 2) + 4 * n + (i & 3); }

struct Unit { int pm, pn; };
struct Gemm { const bf16_t* A; const bf16_t* Bt; int M, N, K; };

struct StaticOrder {
    int nM, nN, nwg, G, c;
    __host__ __device__ void init(int M, int N, int G_, int c_) { nM = M / BM; nN = N / BM; nwg = nM * nN; G = G_; c = c_; }
    __host__ __device__ bool next(int i, Unit& u) const {
        const long L = (long)i * G + c; if (L >= nwg) return false;
        int wgid = (int)L; { const int q = nwg / NXCD, r = nwg % NXCD, xcd = wgid % NXCD, off = wgid / NXCD; wgid = (xcd < r ? xcd * (q + 1) : r * (q + 1) + (xcd - r) * q) + off; }
        const int nig = WGM * nN, gid = wgid / nig, fm = gid * WGM, gsz = (nM - fm) < WGM ? (nM - fm) : WGM;
        u.pm = fm + ((wgid % nig) % gsz); u.pn = (wgid % nig) / gsz; return true;
    }
    __device__ __forceinline__ void a_ready(const Unit&) const {}
    __device__ __forceinline__ void done(const Unit&) const {}
};


__device__ __forceinline__ unsigned cvt_pk_bf16(float lo, float hi) { unsigned r; asm volatile("v_cvt_pk_bf16_f32 %0, %1, %2" : "=v"(r) : "v"(lo), "v"(hi)); return r; }

template <int ACT> struct EpiRowScale {
    static constexpr bool PERM = true, AFTER_DRAIN = false;
    bf16_t* O; int ldc; const float* rs;
    __device__ __forceinline__ void operator()(const f32x4 (&acc)[2][2][4][2], const Unit& u, int wr, int wc, int fr, int fq) const {
        asm volatile("" : "+v"(fr), "+v"(fq));
        const int row0 = u.pm * BM + wr * 64 + fr, col0 = u.pn * BM + wc * 32 + 8 * fq;
#pragma unroll
        for (int ai = 0; ai < 2; ++ai)
#pragma unroll
            for (int m = 0; m < 4; ++m) { const int row = row0 + ai * HALF + m * 16; const float s = rs[row]; bf16_t* rowp = O + (size_t)row * ldc + col0;
#pragma unroll
                for (int bj = 0; bj < 2; ++bj) { f32x4 v0 = acc[ai][bj][m][0] * s, v1 = acc[ai][bj][m][1] * s;
                    if (ACT == 1) {
#pragma unroll
                        for (int j = 0; j < 4; ++j) { const float a = fmaxf(v0[j], 0.f), b = fmaxf(v1[j], 0.f); v0[j] = a * a; v1[j] = b * b; } }
                    u32x4 w; w.x = cvt_pk_bf16(v0[0], v0[1]); w.y = cvt_pk_bf16(v0[2], v0[3]); w.z = cvt_pk_bf16(v1[0], v1[1]); w.w = cvt_pk_bf16(v1[2], v1[3]);
                    *(u32x4*)(rowp + bj * HALF) = w; } }
    }
};
template <bool INT> struct EpiYStats {
    static constexpr bool PERM = true, AFTER_DRAIN = false;
    bf16_t* O; int ldc; float* part; float sc; const float* as; const float* wsc;
    __device__ __forceinline__ void operator()(const f32x4 (&acc)[2][2][4][2], const Unit& u, int wr, int wc, int fr, int fq) const {
        asm volatile("" : "+v"(fr), "+v"(fq));
        const int row0 = u.pm * BM + wr * 64 + fr, col0 = u.pn * BM + wc * 32 + 8 * fq;
#pragma unroll
        for (int ai = 0; ai < 2; ++ai)
#pragma unroll
            for (int m = 0; m < 4; ++m) { const int row = row0 + ai * HALF + m * 16; bf16_t* rowp = O + (size_t)row * ldc + col0; float ss = 0.f; const float s = INT ? as[row] * wsc[0] : sc;
#pragma unroll
                for (int bj = 0; bj < 2; ++bj) { f32x4 v0, v1;
#pragma unroll
                    for (int j = 0; j < 4; ++j) { v0[j] = (INT ? (float)__float_as_int(acc[ai][bj][m][0][j]) : acc[ai][bj][m][0][j]) * s; v1[j] = (INT ? (float)__float_as_int(acc[ai][bj][m][1][j]) : acc[ai][bj][m][1][j]) * s; }
                    ss += (v0[0] * v0[0] + v0[1] * v0[1]) + (v0[2] * v0[2] + v0[3] * v0[3]) + (v1[0] * v1[0] + v1[1] * v1[1]) + (v1[2] * v1[2] + v1[3] * v1[3]);
                    u32x4 w; w.x = cvt_pk_bf16(v0[0], v0[1]); w.y = cvt_pk_bf16(v0[2], v0[3]); w.z = cvt_pk_bf16(v1[0], v1[1]); w.w = cvt_pk_bf16(v1[2], v1[3]);
                    *(u32x4*)(rowp + bj * HALF) = w; }
                ss += xsw<16>(ss); ss = xsum32(ss);
                if (fq == 0) part[(size_t)row * 64 + u.pn * 4 + wc] = ss; }
    }
};


__device__ __forceinline__ unsigned pk4_fp8(float a, float b, float c, float d) { int r = __builtin_amdgcn_cvt_pk_fp8_f32(a, b, 0, false); r = __builtin_amdgcn_cvt_pk_fp8_f32(c, d, r, true); return (unsigned)r; }
template <bool INT> struct EpiRelu2Fp8 {
    static constexpr bool PERM = true, AFTER_DRAIN = false;
    unsigned char* O; int ldc; const float* rs; const float* as; const float* wsc; float us;
    __device__ __forceinline__ void operator()(const f32x4 (&acc)[2][2][4][2], const Unit& u, int wr, int wc, int fr, int fq) const {
        asm volatile("" : "+v"(fr), "+v"(fq));
        const int row0 = u.pm * BM + wr * 64 + fr, col0 = u.pn * BM + wc * 32 + 8 * fq;
        const float winv = INT ? wsc[0] : 1.f;
#pragma unroll
        for (int ai = 0; ai < 2; ++ai)
#pragma unroll
            for (int m = 0; m < 4; ++m) { const int row = row0 + ai * HALF + m * 16; const float s = INT ? rs[row] * (as[row] * winv) : rs[row]; unsigned char* rowp = O + (size_t)row * ldc + col0;
#pragma unroll
                for (int bj = 0; bj < 2; ++bj) { f32x4 v0, v1;
#pragma unroll
                    for (int j = 0; j < 4; ++j) { const float x0 = INT ? (float)__float_as_int(acc[ai][bj][m][0][j]) : acc[ai][bj][m][0][j], x1 = INT ? (float)__float_as_int(acc[ai][bj][m][1][j]) : acc[ai][bj][m][1][j];
                        const float a = fmaxf(x0 * s, 0.f), b = fmaxf(x1 * s, 0.f); v0[j] = fminf(a * a * us, 448.f); v1[j] = fminf(b * b * us, 448.f); }
                    u32x2 w; w.x = pk4_fp8(v0[0], v0[1], v0[2], v0[3]); w.y = pk4_fp8(v1[0], v1[1], v1[2], v1[3]);
                    *(u32x2*)(rowp + bj * HALF) = w; } }
    }
};


struct EpiProjI8 {
    static constexpr bool PERM = true, AFTER_DRAIN = false;
    bf16_t* O; int ldc; const float* rs; const float* as; const float* wsc; PG8_LAS float* T; const float* qn; const float* kn; const float* rope; int seq;
    __device__ __forceinline__ void operator()(const f32x4 (&acc)[2][2][4][2], const Unit& u, int wr, int wc, int fr, int fq) const {
        asm volatile("" : "+v"(fr), "+v"(fq));
        const int row0 = u.pm * BM + wr * 64 + fr, col0 = u.pn * BM + wc * 32 + 8 * fq;
        const float winv = wsc[0];
        const bool bt = (u.pn >= 12 && u.pn <= 16);
        if (bt) {
#pragma unroll
            for (int ai = 0; ai < 2; ++ai)
#pragma unroll
                for (int m = 0; m < 4; ++m) { const int lr = ai * HALF + wr * 64 + m * 16 + fr; const float s = rs[row0 + ai * HALF + m * 16] * (as[row0 + ai * HALF + m * 16] * winv);
#pragma unroll
                    for (int bj = 0; bj < 2; ++bj) { float ss = 0.f;
#pragma unroll
                        for (int j = 0; j < 4; ++j) { const float a = (float)__float_as_int(acc[ai][bj][m][0][j]) * s, b = (float)__float_as_int(acc[ai][bj][m][1][j]) * s; ss += a * a + b * b; }
                        ss += xsw<16>(ss); ss = xsum32(ss);
                        if (fq == 0) T[(lr * 2 + bj) * 4 + wc] = ss; } }
            asm volatile("s_waitcnt lgkmcnt(0)" ::: "memory"); __builtin_amdgcn_s_barrier(); asm volatile("" ::: "memory");
        }
        const float* gn = (u.pn == 16) ? kn : qn; f32x4 g0 = {1.f, 1.f, 1.f, 1.f}, g1 = {1.f, 1.f, 1.f, 1.f};
        if (bt) { g0 = *(const f32x4*)(gn + wc * 32 + 8 * fq); g1 = *(const f32x4*)(gn + wc * 32 + 8 * fq + 4); }
#pragma unroll
        for (int ai = 0; ai < 2; ++ai)
#pragma unroll
            for (int m = 0; m < 4; ++m) { const int row = row0 + ai * HALF + m * 16; const float s = rs[row] * (as[row] * winv); bf16_t* rowp = O + (size_t)row * ldc + col0;
                f32x4 c0 = {1.f, 0.f, 1.f, 0.f}, c1 = {1.f, 0.f, 1.f, 0.f};
                if (bt) { const float* cs = rope + ((size_t)(row & (seq - 1)) * 64 + wc * 16 + fq * 4) * 2; c0 = *(const f32x4*)cs; c1 = *(const f32x4*)(cs + 4); }
#pragma unroll
                for (int bj = 0; bj < 2; ++bj) { f32x4 v0, v1;
#pragma unroll
                    for (int j = 0; j < 4; ++j) { v0[j] = (float)__float_as_int(acc[ai][bj][m][0][j]) * s; v1[j] = (float)__float_as_int(acc[ai][bj][m][1][j]) * s; }
                    if (bt) { const int lr = ai * HALF + wr * 64 + m * 16 + fr; const f32x4 t = *(const PG8_LAS f32x4*)(T + (lr * 2 + bj) * 4);
                        const float r = 1.0f / sqrtf(((t[0] + t[1]) + (t[2] + t[3])) * (1.0f / 128.0f) + 1e-6f);
                        v0 = v0 * r * g0; v1 = v1 * r * g1;
                        f32x4 w0, w1;
                        w0[0] = v0[0] * c0[0] - v0[1] * c0[1]; w0[1] = v0[0] * c0[1] + v0[1] * c0[0]; w0[2] = v0[2] * c0[2] - v0[3] * c0[3]; w0[3] = v0[2] * c0[3] + v0[3] * c0[2];
                        w1[0] = v1[0] * c1[0] - v1[1] * c1[1]; w1[1] = v1[0] * c1[1] + v1[1] * c1[0]; w1[2] = v1[2] * c1[2] - v1[3] * c1[3]; w1[3] = v1[2] * c1[3] + v1[3] * c1[2];
                        v0 = w0; v1 = w1; }
                    u32x4 w; w.x = cvt_pk_bf16(v0[0], v0[1]); w.y = cvt_pk_bf16(v0[2], v0[3]); w.z = cvt_pk_bf16(v1[0], v1[1]); w.w = cvt_pk_bf16(v1[2], v1[3]);
                    *(u32x4*)(rowp + bj * HALF) = w; } }
    }
};
template <class Epi, class Sched, bool ALIGN_EPI = false, bool SP2 = false, int DT = 0>
__device__ __forceinline__ void gemm_phase(PG8_LAS unsigned char* lds, const Gemm g, const Sched& S, const Epi& E, int tid_in) {
    int tid_o = tid_in; asm volatile("" : "+v"(tid_o));
    const int tid = tid_o, wid = __builtin_amdgcn_readfirstlane(tid >> 6), lane = tid & 63, wr = wid >> 2, wc = wid & 3, fr = lane & 15, fq = lane >> 4;
    const int K = g.K, nt = K / BK;
    unsigned voffA[2], voffB[2];
#pragma unroll
    for (int i = 0; i < 2; ++i) { int R, C; stage_rc(tid * 16 + i * 8192, R, C); const int Rb = Epi::PERM ? ((R & ~31) + perm32(R & 31)) : R;
        voffA[i] = (unsigned)(R * K + C) * 2u; voffB[i] = (unsigned)(Rb * K + C) * 2u; }
    const size_t kstep = (size_t)(BK * 2);
    const size_t hstep = (size_t)HALF * K * 2;
    const size_t tstep = 2 * hstep;
    const unsigned ldsw = (unsigned)wid * 1024u;
    const int aoff = lds_byte(wr * 64 + fr, fq * 8), boff = lds_byte(wc * 32 + fr, fq * 8);
    const PG8_LAS unsigned char* abase = lds + aoff; const PG8_LAS unsigned char* bbase = lds + 65536 + boff; asm volatile("" : "+v"(abase), "+v"(bbase));
#define PG8_SA(b, h) (((b) * 2 + (h)) * HTB)
#define PG8_SB(b, h) ((4 + (b) * 2 + (h)) * HTB)
#define PG8_STAGE(bufoff, gbase, voff) do { _Pragma("unroll") for (int _i = 0; _i < 2; ++_i) \
        __builtin_amdgcn_global_load_lds((const unsigned*)((const char*)(gbase) + (voff)[_i]), (PG8_LAS unsigned*)(lds + (bufoff) + ldsw + _i * 8192), 16, 0, 0); } while (0)
#define PG8_LDA(dst, b, h) do { _Pragma("unroll") for (int m = 0; m < 4; ++m) dst[m] = __builtin_shufflevector(*(const PG8_LAS i32x4*)(abase + (PG8_SA(b, h) + m * 2048)), *(const PG8_LAS i32x4*)(abase + (PG8_SA(b, h) + m * 2048 + 1024)), 0, 1, 2, 3, 4, 5, 6, 7); } while (0)
#define PG8_LDB(dst, b, h) do { _Pragma("unroll") for (int n = 0; n < 2; ++n) dst[n] = __builtin_shufflevector(*(const PG8_LAS i32x4*)(bbase + (PG8_SB(b, h) - 65536 + n * 2048)), *(const PG8_LAS i32x4*)(bbase + (PG8_SB(b, h) - 65536 + n * 2048 + 1024)), 0, 1, 2, 3, 4, 5, 6, 7); } while (0)
#define PG8_LO(x) __builtin_bit_cast(bf16x8, __builtin_shufflevector(x, x, 0, 1, 2, 3))
#define PG8_HI(x) __builtin_bit_cast(bf16x8, __builtin_shufflevector(x, x, 4, 5, 6, 7))
#define PG8_LOI(x) __builtin_shufflevector(x, x, 0, 1, 2, 3)
#define PG8_HII(x) __builtin_shufflevector(x, x, 4, 5, 6, 7)
#define PG8_MMA(ai, bj, At, Bt) do { __builtin_amdgcn_s_setprio(1); if constexpr (DT == 1) { _Pragma("unroll") for (int m = 0; m < 4; ++m) _Pragma("unroll") for (int n = 0; n < 2; ++n) \
        asm volatile("v_mfma_scale_f32_16x16x128_f8f6f4 %0, %1, %2, %0, %3, %3 op_sel_hi:[0,0,0]" : "+v"(acc[ai][bj][m][n]) : "v"(Bt[n]), "v"(At[m]), "v"(one_scale)); } \
    else if constexpr (DT == 2) { _Pragma("unroll") for (int m = 0; m < 4; ++m) _Pragma("unroll") for (int n = 0; n < 2; ++n) { \
        i32x4 c_ = __builtin_bit_cast(i32x4, acc[ai][bj][m][n]); c_ = __builtin_amdgcn_mfma_i32_16x16x64_i8(PG8_LOI(Bt[n]), PG8_LOI(At[m]), c_, 0, 0, 0); \
        c_ = __builtin_amdgcn_mfma_i32_16x16x64_i8(PG8_HII(Bt[n]), PG8_HII(At[m]), c_, 0, 0, 0); acc[ai][bj][m][n] = __builtin_bit_cast(f32x4, c_); } } \
    else { _Pragma("unroll") for (int m = 0; m < 4; ++m) _Pragma("unroll") for (int n = 0; n < 2; ++n) { \
        acc[ai][bj][m][n] = __builtin_amdgcn_mfma_f32_16x16x32_bf16(PG8_LO(Bt[n]), PG8_LO(At[m]), acc[ai][bj][m][n], 0, 0, 0); \
        acc[ai][bj][m][n] = __builtin_amdgcn_mfma_f32_16x16x32_bf16(PG8_HI(Bt[n]), PG8_HI(At[m]), acc[ai][bj][m][n], 0, 0, 0); } } __builtin_amdgcn_s_setprio(0); } while (0)
#define PG8_WAIT_V(n) asm volatile("s_waitcnt vmcnt(" #n ")" ::: "memory")
#define PG8_WAIT_L(n) asm volatile("s_waitcnt lgkmcnt(" #n ")" ::: "memory")
#define PG8_BAR __builtin_amdgcn_s_barrier()
#define PG8_SCHED __builtin_amdgcn_sched_barrier(0)
    Unit cur, nxt; int ui = 0;
    if (!S.next(0, cur)) return;
    int one_scale = 0x7F7F7F7F; asm volatile("" : "+v"(one_scale));
    f32x4 acc[2][2][4][2];
#pragma unroll
    for (int a = 0; a < 2; ++a)
#pragma unroll
        for (int b = 0; b < 2; ++b)
#pragma unroll
            for (int m = 0; m < 4; ++m)
#pragma unroll
                for (int n = 0; n < 2; ++n) acc[a][b][m][n] = (f32x4){0.f, 0.f, 0.f, 0.f};
    i32x8 At[4], B0[2], B1[2];
    const char* cA = (const char*)g.A + (size_t)cur.pm * tstep; const char* cB = (const char*)g.Bt + (size_t)cur.pn * tstep;
    S.a_ready(cur);
    if constexpr (SP2) {
        PG8_STAGE(PG8_SB(0, 0), cB, voffB); PG8_STAGE(PG8_SB(0, 1), cB + hstep, voffB); PG8_STAGE(PG8_SA(0, 0), cA, voffA); PG8_STAGE(PG8_SA(0, 1), cA + hstep, voffA);
        if (wr == 1) PG8_BAR;
        PG8_WAIT_V(2); PG8_BAR;
        PG8_STAGE(PG8_SB(1, 0), cB + kstep, voffB); PG8_STAGE(PG8_SA(1, 0), cA + kstep, voffA); PG8_STAGE(PG8_SB(1, 1), cB + hstep + kstep, voffB);
        PG8_WAIT_V(6); PG8_BAR;
    } else {
        PG8_STAGE(PG8_SB(0, 0), cB, voffB); PG8_STAGE(PG8_SA(0, 0), cA, voffA); PG8_STAGE(PG8_SB(0, 1), cB + hstep, voffB); PG8_STAGE(PG8_SA(0, 1), cA + hstep, voffA);
        if (wr == 1) PG8_BAR;
        PG8_WAIT_V(4); PG8_BAR;
        PG8_STAGE(PG8_SB(1, 0), cB + kstep, voffB); PG8_STAGE(PG8_SA(1, 0), cA + kstep, voffA); PG8_STAGE(PG8_SB(1, 1), cB + hstep + kstep, voffB);
        PG8_WAIT_V(6); PG8_BAR;
    }
    for (;;) {
        const bool has_next = S.next(ui + 1, nxt);
        const char* nA = has_next ? (const char*)g.A + (size_t)nxt.pm * tstep : cA; const char* nB = has_next ? (const char*)g.Bt + (size_t)nxt.pn * tstep : cB;
        for (int t = 0; t < nt; t += 2) {
            const bool last = (t == nt - 2);
            const char* a1 = cA + (size_t)(t + 1) * kstep;
            const char* a2 = last ? nA : cA + (size_t)(t + 2) * kstep; const char* b2 = last ? nB : cB + (size_t)(t + 2) * kstep;
            const char* a3 = a2 + kstep; const char* b3 = b2 + kstep;
            if (last && has_next) S.a_ready(nxt);
            if constexpr (SP2) {
            PG8_LDB(B0, 0, 0); PG8_LDB(B1, 0, 1); PG8_SCHED; PG8_LDA(At, 0, 0); PG8_STAGE(PG8_SA(1, 1), a1 + hstep, voffA);
            PG8_WAIT_V(8); PG8_WAIT_L(0); PG8_BAR; PG8_MMA(0, 0, At, B0); PG8_MMA(0, 1, At, B1); PG8_BAR; PG8_SCHED;
            PG8_LDA(At, 0, 1); PG8_STAGE(PG8_SB(0, 0), b2, voffB); PG8_STAGE(PG8_SB(0, 1), b2 + hstep, voffB); PG8_STAGE(PG8_SA(0, 0), a2, voffA);
            PG8_WAIT_V(8); PG8_WAIT_L(0); PG8_BAR; PG8_MMA(1, 0, At, B0); PG8_MMA(1, 1, At, B1); PG8_BAR; PG8_SCHED;
            PG8_LDB(B0, 1, 0); PG8_LDB(B1, 1, 1); PG8_SCHED; PG8_LDA(At, 1, 0); PG8_STAGE(PG8_SA(0, 1), a2 + hstep, voffA);
            PG8_WAIT_V(8); PG8_WAIT_L(0); PG8_BAR; PG8_MMA(0, 0, At, B0); PG8_MMA(0, 1, At, B1); PG8_BAR; PG8_SCHED;
            PG8_LDA(At, 1, 1); PG8_STAGE(PG8_SB(1, 0), b3, voffB); PG8_STAGE(PG8_SB(1, 1), b3 + hstep, voffB); PG8_STAGE(PG8_SA(1, 0), a3, voffA);
            PG8_WAIT_V(8); PG8_WAIT_L(0); PG8_BAR; PG8_MMA(1, 0, At, B0); PG8_MMA(1, 1, At, B1); PG8_BAR; PG8_SCHED;
            } else {
            PG8_LDB(B0, 0, 0); PG8_SCHED; PG8_LDA(At, 0, 0); PG8_STAGE(PG8_SA(1, 1), a1 + hstep, voffA);
            PG8_WAIT_L(8); PG8_BAR; PG8_WAIT_L(0); PG8_MMA(0, 0, At, B0); PG8_BAR; PG8_SCHED;
            PG8_LDB(B1, 0, 1); PG8_STAGE(PG8_SB(0, 0), b2, voffB);
            PG8_BAR; PG8_WAIT_L(0); PG8_MMA(0, 1, At, B1); PG8_BAR;
            PG8_LDA(At, 0, 1); PG8_STAGE(PG8_SA(0, 0), a2, voffA);
            PG8_BAR; PG8_WAIT_L(0); PG8_MMA(1, 0, At, B0); PG8_BAR; PG8_SCHED;
            PG8_STAGE(PG8_SB(0, 1), b2 + hstep, voffB);
            PG8_WAIT_V(6); PG8_BAR; PG8_MMA(1, 1, At, B1); PG8_BAR;
            PG8_LDB(B0, 1, 0); PG8_SCHED; PG8_LDA(At, 1, 0); PG8_STAGE(PG8_SA(0, 1), a2 + hstep, voffA);
            PG8_WAIT_L(8); PG8_BAR; PG8_WAIT_L(0); PG8_MMA(0, 0, At, B0); PG8_BAR; PG8_SCHED;
            PG8_LDB(B1, 1, 1); PG8_STAGE(PG8_SB(1, 0), b3, voffB);
            PG8_BAR; PG8_WAIT_L(0); PG8_MMA(0, 1, At, B1); PG8_BAR;
            PG8_LDA(At, 1, 1); PG8_STAGE(PG8_SA(1, 0), a3, voffA);
            PG8_BAR; PG8_WAIT_L(0); PG8_MMA(1, 0, At, B0); PG8_BAR; PG8_SCHED;
            PG8_STAGE(PG8_SB(1, 1), b3 + hstep, voffB);
            PG8_WAIT_V(6); PG8_BAR; PG8_MMA(1, 1, At, B1); PG8_BAR;
            }
        }
        if constexpr (DT == 1) asm volatile("s_nop 15\n\ts_nop 15" ::: "memory");
        if constexpr (ALIGN_EPI) { if (wr == 0) PG8_BAR; }
        if constexpr (!Epi::AFTER_DRAIN) { E(acc, cur, wr, wc, fr, fq); S.done(cur); }
        if (!has_next) break;
#pragma unroll
        for (int a = 0; a < 2; ++a)
#pragma unroll
            for (int b = 0; b < 2; ++b)
#pragma unroll
                for (int m = 0; m < 4; ++m)
#pragma unroll
                    for (int n = 0; n < 2; ++n) acc[a][b][m][n] = (f32x4){0.f, 0.f, 0.f, 0.f};
        cur = nxt; cA = nA; cB = nB; ++ui;
        if constexpr (ALIGN_EPI) { if (wr == 1) PG8_BAR; }
    }
    PG8_WAIT_V(0);
    if constexpr (!ALIGN_EPI) { if (wr == 0) PG8_BAR; }
    PG8_BAR;
    if constexpr (Epi::AFTER_DRAIN) { E.fused(acc, cur, wr, wc, fr, fq, lds, wid, lane); S.done(cur); }
#undef PG8_SA
#undef PG8_SB
#undef PG8_STAGE
#undef PG8_LO
#undef PG8_LOI
#undef PG8_HII
#undef PG8_HI
#undef PG8_LDA
#undef PG8_LDB
#undef PG8_MMA
#undef PG8_WAIT_V
#undef PG8_WAIT_L
#undef PG8_BAR
#undef PG8_SCHED
}
}

namespace att {
#define ALAS __attribute__((address_space(3)))
typedef unsigned short bf16;
using bf16x8 = __attribute__((ext_vector_type(8))) short;
using s16x4  = __attribute__((ext_vector_type(4))) short;
using f32x16 = __attribute__((ext_vector_type(16))) float;
using u32x4  = __attribute__((ext_vector_type(4))) unsigned;
typedef ALAS char* lptr;
constexpr int   D = 128, NW = 8, QBLK = 32, KVBLK = 64;
constexpr float SCALE = 0.088388347648318440f, INV_SCALE = 11.313708498984761f, LOG2E = 1.4426950408889634f;
constexpr float THR = 8.f;
constexpr float MASKV = -1e30f, MINIT = -1e10f;
constexpr int SHM_V = KVBLK * D * 2, SHM_K = KVBLK * D * 2;
constexpr int OFF_K = 2 * SHM_V, OFF_WS = 2 * SHM_V + 2 * SHM_K, OFF_TAB = OFF_WS + NW * 64 * 4, TAB_BYTES = 8192, OFF_STG = OFF_TAB + TAB_BYTES, ATT_LDS = OFF_STG + NW * 4096;
constexpr int TREL = 384;
enum { MODE_B = 0, MODE_C = 1, MODE_D = 2, MODE_A = 3 };
#define KSWZ(row, colB) ((row) * 256 + ((colB) ^ ((((row) & 7) | ((((row) >> 4) & 1) << 3)) << 4)))
#define SBAR() __builtin_amdgcn_sched_barrier(0)
__device__ __forceinline__ int crow(int r, int hi) { return (r & 3) + 8 * (r >> 2) + 4 * hi; }
__device__ __forceinline__ unsigned cvtpk(float lo, float hi) { unsigned r; asm volatile("v_cvt_pk_bf16_f32 %0, %1, %2" : "=v"(r) : "v"(lo), "v"(hi)); return r; }

__device__ __forceinline__ void partialSM(f32x16& p0, f32x16& p1, float& m_reg, float& mn, float& alpha) {
  constexpr float C = SCALE * LOG2E;
  float pmax = p0[0];
#pragma unroll
  for (int r = 1; r < 16; ++r) pmax = fmaxf(pmax, p0[r]);
#pragma unroll
  for (int r = 0; r < 16; ++r) pmax = fmaxf(pmax, p1[r]);
  { auto rr = __builtin_amdgcn_permlane32_swap(__float_as_uint(pmax), __float_as_uint(pmax), false, false);
    pmax = fmaxf(__uint_as_float(rr[0]), __uint_as_float(rr[1])); }
  if (__builtin_expect(__all(pmax - m_reg <= THR / SCALE), 1)) { mn = m_reg; alpha = 1.f; }
  else { mn = fmaxf(m_reg, pmax); alpha = __builtin_amdgcn_exp2f((m_reg - mn) * C); m_reg = mn; }
  float mnC = -mn * C;
#pragma unroll
  for (int r = 0; r < 16; ++r) p0[r] = fmaf(p0[r], C, mnC);
#pragma unroll
  for (int r = 0; r < 16; ++r) p1[r] = fmaf(p1[r], C, mnC);
#pragma unroll
  for (int r = 0; r < 16; ++r) p0[r] = __builtin_amdgcn_exp2f(p0[r]);
}
__device__ __forceinline__ void finishSM(f32x16& p0, f32x16& p1, float alpha, float& l_reg, bf16x8& pa0, bf16x8& pa1, bf16x8& pa2, bf16x8& pa3) {
#pragma unroll
  for (int r = 0; r < 16; ++r) p1[r] = __builtin_amdgcn_exp2f(p1[r]);
  float ps = 0;
#pragma unroll
  for (int r = 0; r < 16; ++r) ps += p0[r];
#pragma unroll
  for (int r = 0; r < 16; ++r) ps += p1[r];
  { auto rr = __builtin_amdgcn_permlane32_swap(__float_as_uint(ps), __float_as_uint(ps), false, false);
    ps = __uint_as_float(rr[0]) + __uint_as_float(rr[1]); }
  l_reg = l_reg * alpha + ps;
#define PK4(P, BASE, OUT) do { unsigned a0 = cvtpk(P[BASE + 0], P[BASE + 1]), a1 = cvtpk(P[BASE + 2], P[BASE + 3]);   \
    unsigned b0 = cvtpk(P[BASE + 4], P[BASE + 5]), b1 = cvtpk(P[BASE + 6], P[BASE + 7]);                              \
    auto r0 = __builtin_amdgcn_permlane32_swap(a0, b0, false, false); auto r1 = __builtin_amdgcn_permlane32_swap(a1, b1, false, false); \
    u32x4 w = {r0[0], r1[0], r0[1], r1[1]}; OUT = __builtin_bit_cast(bf16x8, w); } while (0)
  PK4(p0, 0, pa0); PK4(p0, 8, pa1); PK4(p1, 0, pa2); PK4(p1, 8, pa3);
#undef PK4
}
__device__ __forceinline__ void qkt(f32x16& p0, f32x16& p1, lptr Ks, const bf16x8* qr, int r32, int hi) {
#pragma unroll
  for (int d0 = 0; d0 < 8; ++d0) { int cb = (d0 * 16 + hi * 8) * 2;
    bf16x8 b0 = *(const ALAS bf16x8*)(Ks + KSWZ(r32, cb));
    bf16x8 b1 = *(const ALAS bf16x8*)(Ks + KSWZ(32 + r32, cb));
    p0 = __builtin_amdgcn_mfma_f32_32x32x16_bf16(b0, qr[d0], p0, 0, 0, 0);
    p1 = __builtin_amdgcn_mfma_f32_32x32x16_bf16(b1, qr[d0], p1, 0, 0, 0); }
}
__device__ __forceinline__ int v_st(int k, int c) { const int kk = (k & ~0xC) | ((k & 4) << 1) | ((k & 8) >> 1); return ((kk >> 3) * 4 + (c >> 5)) * 512 + ((kk & 7) * 32 + (c & 31)) * 2; }
__device__ __forceinline__ int v_rd_base(int lane) { return ((lane & 3) << 3) | (((lane >> 2) & 3) << 6) | (((lane >> 4) & 1) << 5) | (((lane >> 5) & 1) << 8); }
constexpr int v_rd_off(int d0, int ks, int half) { return d0 * 512 + ks * 4096 + half * 2048; }
template <int OFF> __device__ __forceinline__ s16x4 tr_read(int vb) {
  s16x4 r; asm volatile("ds_read_b64_tr_b16 %0, %1 offset:%2" : "=&v"(r) : "v"(vb), "i"(OFF) : "memory"); return r;
}
template <int D0> __device__ __forceinline__ void pv_one(f32x16& od, int vb, bf16x8 pa0, bf16x8 pa1, bf16x8 pa2, bf16x8 pa3) {
  const s16x4 l0 = tr_read<v_rd_off(D0, 0, 0)>(vb), h0 = tr_read<v_rd_off(D0, 0, 1)>(vb), l1 = tr_read<v_rd_off(D0, 1, 0)>(vb), h1 = tr_read<v_rd_off(D0, 1, 1)>(vb);
  const s16x4 l2 = tr_read<v_rd_off(D0, 2, 0)>(vb), h2 = tr_read<v_rd_off(D0, 2, 1)>(vb), l3 = tr_read<v_rd_off(D0, 3, 0)>(vb), h3 = tr_read<v_rd_off(D0, 3, 1)>(vb);
  asm volatile("s_waitcnt lgkmcnt(0)" ::: "memory"); SBAR();
#define PK(L, H) (bf16x8){L[0], L[1], L[2], L[3], H[0], H[1], H[2], H[3]}
  od = __builtin_amdgcn_mfma_f32_32x32x16_bf16(pa0, PK(l0, h0), od, 0, 0, 0);
  od = __builtin_amdgcn_mfma_f32_32x32x16_bf16(pa1, PK(l1, h1), od, 0, 0, 0);
  od = __builtin_amdgcn_mfma_f32_32x32x16_bf16(pa2, PK(l2, h2), od, 0, 0, 0);
  od = __builtin_amdgcn_mfma_f32_32x32x16_bf16(pa3, PK(l3, h3), od, 0, 0, 0);
#undef PK
}
__device__ __forceinline__ void pv_d0(f32x16* o, int vb, bf16x8 pa0, bf16x8 pa1, bf16x8 pa2, bf16x8 pa3) {
  pv_one<0>(o[0], vb, pa0, pa1, pa2, pa3); pv_one<1>(o[1], vb, pa0, pa1, pa2, pa3); pv_one<2>(o[2], vb, pa0, pa1, pa2, pa3); pv_one<3>(o[3], vb, pa0, pa1, pa2, pa3);
}

typedef short v4i16_t __attribute__((ext_vector_type(4)));
#define PIN(x) asm volatile("" : "+v"(x))
#define MF(a, b, c) __builtin_amdgcn_mfma_f32_32x32x16_bf16(a, b, c, 0, 0, 0)
#define EX2(x) __builtin_amdgcn_exp2f(x)
#define MX3(a, b, c) __builtin_fmaxf(__builtin_fmaxf((a), (b)), (c))
__device__ __forceinline__ unsigned cvtpk_s(float lo, float hi) { unsigned r; asm("v_cvt_pk_bf16_f32 %0, %1, %2" : "=v"(r) : "v"(lo), "v"(hi)); return r; }
#define KRD2(Ks, D0, K0, K1) do { const int cb_ = ((D0) * 16 + hi * 8) * 2; K0 = *(const ALAS bf16x8*)((Ks) + KSWZ(r32, cb_)); K1 = *(const ALAS bf16x8*)((Ks) + KSWZ(32 + r32, cb_)); } while (0)
#define VTR(vp, OFF) __builtin_bit_cast(s16x4, __builtin_amdgcn_ds_read_tr16_b64_v4i16((ALAS v4i16_t*)((vp) + (OFF))))
#define PKV(L, H) (bf16x8){L[0], L[1], L[2], L[3], H[0], H[1], H[2], H[3]}
#define VRDG(vp, GI, L0, H0, L1, H1) do { L0 = VTR(vp, v_rd_off(2 * ((GI) >> 2), (GI) & 3, 0)); H0 = VTR(vp, v_rd_off(2 * ((GI) >> 2), (GI) & 3, 1)); \
    L1 = VTR(vp, v_rd_off(2 * ((GI) >> 2) + 1, (GI) & 3, 0)); H1 = VTR(vp, v_rd_off(2 * ((GI) >> 2) + 1, (GI) & 3, 1)); } while (0)
#define SWP(a, b, r) auto r = __builtin_amdgcn_permlane32_swap(a, b, false, false)

__device__ __forceinline__ void bias_init(f32x16& p0, f32x16& p1, int mode, int k0, int qw, int r32, int hi, const ALAS float* tab) {
  if (mode == MODE_B) { p0 = f32x16{}; p1 = f32x16{}; return; }
  if (mode == MODE_A) {
    const int kr = k0 >> 6, rq = qw >> 6, rs = min(max(rq - 4, 0), 24);
    if (kr < rs || kr >= rs + 8) {
#pragma unroll
      for (int r = 0; r < 16; ++r) { p0[r] = MASKV; p1[r] = MASKV; } }
    else { const int cq = (qw & 63) + r32, cs = min(max(cq - 8, 0), 48), d = 4 * hi - cs; const ALAS float* rt = tab + ((kr - rq + 7) * 128 + 48 + 15 + 4 * hi - cq); asm volatile("" : "+v"(rt));
#pragma unroll
      for (int r = 0; r < 16; ++r) { const int c0 = (r & 3) + 8 * (r >> 2), c1 = c0 + 32; const bool ok0 = (unsigned)(c0 + d) < 16u, ok1 = (unsigned)(c1 + d) < 16u;
        const float t0 = rt[c0], t1 = rt[c1]; p0[r] = ok0 ? t0 : MASKV; p1[r] = ok1 ? t1 : MASKV; if ((r & 3) == 3) asm volatile("" ::: "memory"); } }
  } else {
    const int dq = k0 - qw;
    if (mode == MODE_D && (dq >= 128 || dq <= -160)) { const float c = tab[dq > 0 ? TREL + 300 : TREL - 300];
#pragma unroll
      for (int r = 0; r < 16; ++r) { p0[r] = c; p1[r] = c; } }
    else { const ALAS float* tl = tab + (dq + 4 * hi - r32 + TREL); asm volatile("" : "+v"(tl));
#pragma unroll
      for (int r = 0; r < 16; ++r) { const int c0 = (r & 3) + 8 * (r >> 2); p0[r] = tl[c0]; p1[r] = tl[c0 + 32]; if ((r & 3) == 3) asm volatile("" ::: "memory"); } }
  }
}

template <int LD>
__device__ __forceinline__ void attn_unit(const bf16* __restrict__ Qb, const bf16* __restrict__ Kh, int vdelta, int nkeys,
                                          int mode, int kbeg, int qbase, const ALAS float* tab, float sink, void* __restrict__ Op, lptr lds, int tid_in) {
  int tid_o = tid_in; asm volatile("" : "+v"(tid_o));
  const int tid = tid_o, wid = __builtin_amdgcn_readfirstlane(tid >> 6), lane = tid & 63, r32 = lane & 31, hi = lane >> 5;
  lptr V_lds = lds; lptr K_lds = lds + OFF_K;
  ALAS float* ws = (ALAS float*)(lds + OFF_WS) + wid * 64; ALAS float* li_l = ws; ALAS float* al_l = ws + 32;
  float m_reg = MINIT, l_reg = 0; f32x16 o[4] = {}; bf16x8 qr[8];
  const bf16* Qw = Qb + (unsigned)((wid * QBLK + r32) * LD + hi * 8);
#pragma unroll
  for (int d0 = 0; d0 < 8; ++d0) qr[d0] = *(const bf16x8*)(Qw + d0 * 16);
  const int sr = tid >> 4, sc = (tid & 15) * 8; const unsigned vo = (unsigned)(sr * LD + sc); const int vst0 = v_st(sr, sc), vst1 = v_st(32 + sr, sc);
  const int vb0 = (int)(unsigned)(size_t)V_lds + v_rd_base(lane);
  const int qw = qbase + wid * QBLK;
  struct { bf16x8 vs0, vs1, ks0, ks1; } sr_[2];
#define SLOAD(i, k0) do { const bf16* Kt = Kh + (size_t)(k0) * LD; const bf16* Vt = Kt + vdelta; \
    sr_[i].vs0 = *(const bf16x8*)(Vt + vo); sr_[i].vs1 = *(const bf16x8*)(Vt + 32 * LD + vo); \
    sr_[i].ks0 = *(const bf16x8*)(Kt + vo); sr_[i].ks1 = *(const bf16x8*)(Kt + 32 * LD + vo); } while (0)
#define SWRITE_K(b, i) do { int kc = sc * 2; *(ALAS bf16x8*)(K_lds + (b) * SHM_K + KSWZ(sr, kc)) = sr_[i].ks0; *(ALAS bf16x8*)(K_lds + (b) * SHM_K + KSWZ(32 + sr, kc)) = sr_[i].ks1; } while (0)
#define SWRITE_V(b, i) do { *(ALAS bf16x8*)(V_lds + (b) * SHM_V + vst0) = sr_[i].vs0; *(ALAS bf16x8*)(V_lds + (b) * SHM_V + vst1) = sr_[i].vs1; } while (0)
#define SWAIT() asm volatile("s_waitcnt vmcnt(4)" ::: "memory")
#define RESC(a) do { if (__any((a) < 1.f)) { if (hi == 0) al_l[r32] = (a); asm volatile("s_waitcnt lgkmcnt(0)" ::: "memory"); \
    _Pragma("unroll") for (int d = 0; d < 4; ++d) _Pragma("unroll") for (int r = 0; r < 16; ++r) o[d][r] *= al_l[crow(r, hi)]; } } while (0)
  f32x16 pA0, pA1, pB0, pB1; float mnA, mnB, alA, alB; bf16x8 pa0, pa1, pa2, pa3; const int NT = nkeys / KVBLK;
  constexpr int SE = 0, SO = 1;
  SLOAD(SE, 0); asm volatile("s_waitcnt vmcnt(0)" ::: "memory"); SWRITE_K(0, SE); SWRITE_V(0, SE);
  SLOAD(SO, KVBLK); if (2 < NT) SLOAD(SE, 2 * KVBLK);
  __syncthreads();
  bias_init(pA0, pA1, mode, kbeg, qw, r32, hi, tab); qkt(pA0, pA1, K_lds, qr, r32, hi); partialSM(pA0, pA1, m_reg, mnA, alA);
  SWAIT(); SWRITE_K(1, SO); __syncthreads();
  constexpr float C = SCALE * LOG2E;
  lptr vbp = V_lds + v_rd_base(lane);
  bf16x8 kA0, kA1, kB0, kB1; s16x4 vAl0, vAh0, vAl1, vAh1, vBl0, vBh0, vBl1, vBh1; float ps; unsigned ca0, ca1, cb0, cb1;
#define GA(C0, C1, Ks, D0, KC0, KC1, KN0, KN1, FILL) do { if ((D0) < 7) KRD2(Ks, ((D0) + 1) & 7, KN0, KN1); \
    C0 = MF(KC0, qr[D0], C0); C1 = MF(KC1, qr[D0], C1); FILL; SBAR(); } while (0)
#define E3(P, i) do { P[i] = EX2(P[i]); P[(i) + 1] = EX2(P[(i) + 1]); P[(i) + 2] = EX2(P[(i) + 2]); } while (0)
#define E2(P, i) do { P[i] = EX2(P[i]); P[(i) + 1] = EX2(P[(i) + 1]); } while (0)
#define S4(P, i) do { ps += P[i]; ps += P[(i) + 1]; ps += P[(i) + 2]; ps += P[(i) + 3]; } while (0)
#define CA(P, i) do { ca0 = cvtpk_s(P[i], P[(i) + 1]); ca1 = cvtpk_s(P[(i) + 2], P[(i) + 3]); } while (0)
#define CB(P, i, OUT) do { cb0 = cvtpk_s(P[i], P[(i) + 1]); cb1 = cvtpk_s(P[(i) + 2], P[(i) + 3]); SWP(ca0, cb0, r0_); SWP(ca1, cb1, r1_); \
    u32x4 w_ = {r0_[0], r1_[0], r0_[1], r1_[1]}; OUT = __builtin_bit_cast(bf16x8, w_); PIN(OUT); } while (0)
#define GB(vp, GI, CL0, CH0, CL1, CH1, NL0, NH0, NL1, NH1, PAK, FILL) do { if ((GI) < 7) VRDG(vp, ((GI) + 1) & 7, NL0, NH0, NL1, NH1); \
    o[2 * ((GI) >> 2)] = MF(PAK, PKV(CL0, CH0), o[2 * ((GI) >> 2)]); o[2 * ((GI) >> 2) + 1] = MF(PAK, PKV(CL1, CH1), o[2 * ((GI) >> 2) + 1]); FILL; SBAR(); } while (0)
#define FE(C0, C1, i) do { C0[i] = EX2(__builtin_fmaf(C0[i], C, mnC_)); C1[i] = __builtin_fmaf(C1[i], C, mnC_); } while (0)
#define FE3(C0, C1, i) do { FE(C0, C1, i); FE(C0, C1, (i) + 1); FE(C0, C1, (i) + 2); PIN(C0); PIN(C1); } while (0)
#define FE2(C0, C1, i) do { FE(C0, C1, i); FE(C0, C1, (i) + 1); PIN(C0); PIN(C1); } while (0)
#define STEP(C0, C1, ALC, P0, P1, ALP, T, KB_, DOLOAD, DOWK) do { \
    lptr Ks_ = K_lds + (KB_) * SHM_K; lptr vp_ = vbp + (1 - (KB_)) * SHM_V; \
    KRD2(Ks_, 0, kA0, kA1); \
    SWRITE_V(KB_, KB_); SBAR(); \
    bias_init(C0, C1, mode, kbeg + (T) * KVBLK, qw, r32, hi, tab); SBAR(); \
    GA(C0, C1, Ks_, 0, kA0, kA1, kB0, kB1, E3(P1, 0); ps = P0[0] + P0[1]; ps += P0[2]; ps += P0[3]; CA(P0, 0); PIN(P1); PIN(ps); PIN(ca0); PIN(ca1)); \
    GA(C0, C1, Ks_, 1, kB0, kB1, kA0, kA1, E3(P1, 3); S4(P0, 4); CB(P0, 4, pa0); PIN(P1); PIN(ps)); \
    GA(C0, C1, Ks_, 2, kA0, kA1, kB0, kB1, E3(P1, 6); S4(P0, 8); CA(P0, 8); PIN(P1); PIN(ps); PIN(ca0); PIN(ca1)); \
    GA(C0, C1, Ks_, 3, kB0, kB1, kA0, kA1, E3(P1, 9); S4(P0, 12); CB(P0, 12, pa1); PIN(P1); PIN(ps)); \
    GA(C0, C1, Ks_, 4, kA0, kA1, kB0, kB1, E2(P1, 12); S4(P1, 0); CA(P1, 0); PIN(P1); PIN(ps); PIN(ca0); PIN(ca1)); \
    GA(C0, C1, Ks_, 5, kB0, kB1, kA0, kA1, E2(P1, 14); S4(P1, 4); CB(P1, 4, pa2); PIN(P1); PIN(ps)); \
    GA(C0, C1, Ks_, 6, kA0, kA1, kB0, kB1, S4(P1, 8); CA(P1, 8); PIN(ps); PIN(ca0); PIN(ca1)); \
    GA(C0, C1, Ks_, 7, kB0, kB1, kA0, kA1, VRDG(vp_, 0, vAl0, vAh0, vAl1, vAh1); S4(P1, 12); CB(P1, 12, pa3); \
       { SWP(__float_as_uint(ps), __float_as_uint(ps), rr_); ps = __uint_as_float(rr_[0]) + __uint_as_float(rr_[1]); } l_reg = l_reg * (ALP) + ps; PIN(l_reg)); \
    if (DOLOAD) SLOAD(KB_, ((T) + 2) * KVBLK); \
    float mxa_, mxb_, mnC_; \
    GB(vp_, 0, vAl0, vAh0, vAl1, vAh1, vBl0, vBh0, vBl1, vBh1, pa0, \
       mxa_ = MX3(C0[0], C0[1], C1[0]); mxb_ = MX3(C0[2], C0[3], C1[1]); mxa_ = MX3(mxa_, C1[2], C1[3]); mxa_ = MX3(mxa_, C0[4], C0[5]); mxb_ = MX3(mxb_, C0[6], C0[7]); \
       mxa_ = MX3(mxa_, C1[4], C1[5]); mxb_ = MX3(mxb_, C1[6], C1[7]); PIN(mxa_); PIN(mxb_)); \
    GB(vp_, 1, vBl0, vBh0, vBl1, vBh1, vAl0, vAh0, vAl1, vAh1, pa1, \
       mxa_ = MX3(mxa_, C0[8], C0[9]); mxb_ = MX3(mxb_, C0[10], C0[11]); mxa_ = MX3(mxa_, C1[8], C1[9]); mxb_ = MX3(mxb_, C1[10], C1[11]); \
       mxa_ = MX3(mxa_, C0[12], C0[13]); mxb_ = MX3(mxb_, C0[14], C0[15]); mxa_ = MX3(mxa_, C1[12], C1[13]); mxb_ = MX3(mxb_, C1[14], C1[15]); \
       { float pm_ = __builtin_fmaxf(mxa_, mxb_); SWP(__float_as_uint(pm_), __float_as_uint(pm_), rr_); pm_ = __builtin_fmaxf(__uint_as_float(rr_[0]), __uint_as_float(rr_[1])); float mn_; \
         if (__builtin_expect(__all(pm_ - m_reg <= THR / SCALE), 1)) { mn_ = m_reg; ALC = 1.f; } \
         else { mn_ = __builtin_fmaxf(m_reg, pm_); ALC = EX2((m_reg - mn_) * C); m_reg = mn_; } \
         mnC_ = -mn_ * C; } PIN(mnC_); PIN(ALC)); \
    GB(vp_, 2, vAl0, vAh0, vAl1, vAh1, vBl0, vBh0, vBl1, vBh1, pa2, FE3(C0, C1, 0)); \
    GB(vp_, 3, vBl0, vBh0, vBl1, vBh1, vAl0, vAh0, vAl1, vAh1, pa3, FE3(C0, C1, 3)); \
    GB(vp_, 4, vAl0, vAh0, vAl1, vAh1, vBl0, vBh0, vBl1, vBh1, pa0, FE3(C0, C1, 6)); \
    GB(vp_, 5, vBl0, vBh0, vBl1, vBh1, vAl0, vAh0, vAl1, vAh1, pa1, FE3(C0, C1, 9)); \
    GB(vp_, 6, vAl0, vAh0, vAl1, vAh1, vBl0, vBh0, vBl1, vBh1, pa2, FE2(C0, C1, 12)); \
    GB(vp_, 7, vBl0, vBh0, vBl1, vBh1, vAl0, vAh0, vAl1, vAh1, pa3, FE2(C0, C1, 14)); \
    if (DOWK) { SWAIT(); SWRITE_K(1 - (KB_), 1 - (KB_)); } \
    RESC(ALC); __syncthreads(); } while (0)
  for (int j = 1; j + 1 < NT; j += 2) {
    STEP(pB0, pB1, alB, pA0, pA1, alA, j, 1, true, true);
    STEP(pA0, pA1, alA, pB0, pB1, alB, j + 1, 0, (j + 3 < NT), true);
  }
  STEP(pB0, pB1, alB, pA0, pA1, alA, NT - 1, 1, false, false);
  finishSM(pB0, pB1, alB, l_reg, pa0, pa1, pa2, pa3); SBAR();
  pv_d0(o, vb0 + SHM_V, pa0, pa1, pa2, pa3);
  __syncthreads();
  if (mode == MODE_C) l_reg += __builtin_amdgcn_exp2f(sink * LOG2E - m_reg * (SCALE * LOG2E));
  if (hi == 0) li_l[r32] = l_reg; asm volatile("s_waitcnt lgkmcnt(0)" ::: "memory");
  float rli[16];
#pragma unroll
  for (int r = 0; r < 16; ++r) rli[r] = __builtin_amdgcn_rcpf(li_l[crow(r, hi)]);
  { lptr stg = lds + OFF_STG + wid * 4096; const int psh = (mode == MODE_D) ? 10 : 12;
    bf16* Ob = (bf16*)Op + ((unsigned)(wid * QBLK) << psh);
#pragma unroll
    for (int p = 0; p < 2; ++p) {
#pragma unroll
      for (int r = 0; r < 16; ++r) { const unsigned w = cvtpk(o[2 * p][r] * rli[r], o[2 * p + 1][r] * rli[r]); ALAS unsigned short* sp = (ALAS unsigned short*)(stg + crow(r, hi) * 128 + r32 * 2);
        sp[0] = (unsigned short)w; sp[32] = (unsigned short)(w >> 16); }
      asm volatile("s_waitcnt lgkmcnt(0)" ::: "memory");
#pragma unroll
      for (int i = 0; i < 4; ++i) { const int row = i * 8 + (lane >> 3), ch = lane & 7; const u32x4 v = *(const ALAS u32x4*)(stg + row * 128 + ch * 16);
        st_wt16(Ob + (((unsigned)row << psh) + p * 64 + ch * 8), v); }
      asm volatile("s_waitcnt lgkmcnt(0)" ::: "memory"); } }
#undef SLOAD
#undef SWRITE_K
#undef SWRITE_V
#undef SWAIT
#undef RESC
}
}

constexpr int NWAVES = 8;
constexpr int BATCH = 4, SEQ = 2048, DM = 4096, DIN = 9216, DFF = 16384, MTOK = BATCH * SEQ, DEPTH = 2;
constexpr float EPS = 1e-6f;
constexpr float U_SCALE = 8.0f, WMO_SCALE = 2048.0f;
constexpr int C_AQ = 0, C_AK = 1024, C_AV = 2048, C_BQ = 3072, C_BK = 4096, C_BV = 4352, C_CQ = 4608, C_CK = 5632, C_CV = 5888, C_DQ = 6144, C_DK = 7168, C_DV = 8192;
constexpr size_t MiB = 1u << 20;
constexpr size_t WS_CTL = 0, CTL_ZERO_BYTES = 1 * MiB;
constexpr size_t WS_RS = 1 * MiB;
constexpr size_t WS_ROPE = 2 * MiB;
constexpr size_t WS_PART = 4 * MiB;
constexpr size_t WS_W = 8 * MiB;
constexpr size_t W_IN_B = (size_t)DIN * DM * 2, W_OUT_B = (size_t)DM * DM * 2, W_MI_B = (size_t)DFF * DM * 2, W_MO_B = (size_t)DM * DFF * 2, W_LAYER_B = W_IN_B + W_OUT_B + W_MI_B + W_MO_B;
constexpr size_t WS_XB = WS_W + DEPTH * W_LAYER_B;
constexpr size_t WS_PROJ = WS_XB + (size_t)MTOK * DM * 2;
constexpr size_t WS_MIX = WS_PROJ + (size_t)MTOK * DIN * 2;
constexpr size_t WS_Y = WS_MIX + (size_t)MTOK * DM * 2;
constexpr size_t WS_U = WS_Y + (size_t)MTOK * DM * 2;
constexpr size_t WS_DT = WS_U + (size_t)MTOK * DFF * 2;
constexpr size_t WS_XQ = WS_DT + (size_t)2 * MTOK * 1024 * 4;
constexpr size_t WS_END = WS_XQ + (size_t)MTOK * DM;
constexpr size_t WS_AS = WS_RS + 65536;
constexpr size_t WS_MAS = WS_RS + 196608;
constexpr size_t WS_WQS = WS_RS + 131072;
constexpr int CW_BAR = 4096;
constexpr int RING_BYTES = 131072, LDSCTL_OFF = RING_BYTES, MISC_OFF = LDSCTL_OFF + 320, LDS_BYTES = 147456;
static_assert(att::ATT_LDS <= RING_BYTES, "attention LDS fits the ring region");

#define GAS __attribute__((address_space(1)))
#define LAS __attribute__((address_space(3)))
typedef unsigned short bf16;
typedef unsigned v4u __attribute__((ext_vector_type(4)));
typedef unsigned v2u __attribute__((ext_vector_type(2)));
typedef float f32x4 __attribute__((ext_vector_type(4)));
typedef GAS unsigned gu32;
#define RLX_AGENT __ATOMIC_RELAXED, __HIP_MEMORY_SCOPE_AGENT
#define LDS_WAIT() asm volatile("s_waitcnt lgkmcnt(0)" ::: "memory")
__device__ __forceinline__ unsigned pk2(float lo, float hi) { return pg8::cvt_pk_bf16(lo, hi); }
__device__ __forceinline__ float bf_lo(unsigned w) { return __uint_as_float(w << 16); }
__device__ __forceinline__ float bf_hi(unsigned w) { return __uint_as_float(w & 0xffff0000u); }
__device__ __forceinline__ float wave_sum(float v) {
    v += xsw<1>(v); v += xsw<2>(v); v += xsw<4>(v); v += xsw<8>(v); v += xsw<16>(v);
    return xsum32(v);
}

__device__ __forceinline__ int lane_id() { int l; asm volatile("v_mbcnt_lo_u32_b32 %0, -1, 0\n\tv_mbcnt_hi_u32_b32 %0, -1, %0" : "=v"(l)); return l; }
#define XB_TMO      128
#define XB_XCNT(j)  (256  + 64 * (j))
#define XB_XSUB(j)  (1280 + 64 * (j))
#define XB_XGEN(j)  (2304 + 64 * (j))
#define XB_TOP      3328
#define XB_TOPGEN   3392
#define XCD_BAR_WORDS 3456
#define XB_SPIN_CAP (1u << 18)

__device__ __forceinline__ unsigned xb_ld(unsigned* p)              { return __hip_atomic_load(p, __ATOMIC_RELAXED, __HIP_MEMORY_SCOPE_AGENT); }
__device__ __forceinline__ unsigned xb_add(unsigned* p, unsigned v) { return __hip_atomic_fetch_add(p, v, __ATOMIC_RELAXED, __HIP_MEMORY_SCOPE_AGENT); }
__device__ __forceinline__ unsigned xb_xcc_id() { return (unsigned)__builtin_amdgcn_s_getreg((3 << 11) | 20) & 0xFu; }
#define XB_SPIN(cond, bar) do { unsigned _sp = 0; while (cond) { __builtin_amdgcn_s_sleep(1); \
    if ((++_sp & 255u) == 0u) { if (xb_ld(&(bar)[XB_TMO])) break; if (_sp > XB_SPIN_CAP) { atomicAdd(&(bar)[XB_TMO], 1u); break; } } } } while (0)

struct XcdBarrier {
    unsigned* bar; unsigned x; int w0;
    volatile LAS unsigned* st;
};

__device__ __forceinline__ XcdBarrier xcd_barrier_post(unsigned* bar, volatile LAS unsigned* st) {
    XcdBarrier b; b.bar = bar; b.x = xb_xcc_id(); b.st = st; b.w0 = __builtin_amdgcn_readfirstlane((int)threadIdx.x >> 6);
    if (threadIdx.x == 0) (void)xb_add(&bar[XB_XCNT(b.x)], 1u);
    return b;
}
__device__ __forceinline__ void xcd_barrier_complete(unsigned* bar, unsigned x, unsigned& nloc, unsigned& nx) {
    const unsigned G = gridDim.x * gridDim.y * gridDim.z;
    unsigned sum, cnt, mine, sp = 0u;
    for (;;) {
        sum = 0u; cnt = 0u; mine = 0u;
#pragma unroll
        for (unsigned j = 0; j < 16; ++j) { const unsigned c = xb_ld(&bar[XB_XCNT(j)]); sum += c; cnt += (c > 0u) ? 1u : 0u; mine = (j == x) ? c : mine; }
        if (sum == G) break;
        __builtin_amdgcn_s_sleep(1);
        if ((++sp & 255u) == 0u) { if (xb_ld(&bar[XB_TMO])) break; if (sp > XB_SPIN_CAP) { atomicAdd(&bar[XB_TMO], 1u); break; } }
    }
    nloc = mine > 0u ? mine : 1u; nx = cnt > 0u ? cnt : 1u;
}

__device__ __forceinline__ void xcd_barrier(const XcdBarrier& b) {
    asm volatile("s_waitcnt vmcnt(0)" ::: "memory");
    __syncthreads();
    if (b.w0 == 0 && lane_id() == 0) {
        unsigned* bar = b.bar;
        __builtin_amdgcn_s_waitcnt(0);
        unsigned nloc = b.st[0], nx = b.st[1];
        if (nloc == 0u) { xcd_barrier_complete(bar, b.x, nloc, nx); b.st[0] = nloc; b.st[1] = nx; }
        const unsigned old = xb_add(&bar[XB_XSUB(b.x)], 1u);
        const unsigned gen = old / nloc;
        if (old + 1u == (gen + 1u) * nloc) {
            __builtin_amdgcn_fence(__ATOMIC_RELEASE, "agent");
            asm volatile("s_waitcnt vmcnt(0)" ::: "memory");
            const unsigned og = xb_add(&bar[XB_TOP], 1u);
            const unsigned tg = og / nx;
            if (og + 1u == (tg + 1u) * nx) xb_add(&bar[XB_TOPGEN], 1u);
            else XB_SPIN(xb_ld(&bar[XB_TOPGEN]) == tg, bar);
            __builtin_amdgcn_fence(__ATOMIC_ACQUIRE, "agent");
            xb_add(&bar[XB_XGEN(b.x)], 1u);
            asm volatile("s_waitcnt vmcnt(0)" ::: "memory");
        } else {
            XB_SPIN(xb_ld(&bar[XB_XGEN(b.x)]) == gen, bar);
            __builtin_amdgcn_fence(__ATOMIC_ACQUIRE, "agent");
            asm volatile("s_waitcnt vmcnt(0)" ::: "memory");
        }
    }
    __syncthreads();
}

__device__ __forceinline__ void tr_item(const float* __restrict__ W, int K, int N, const float* __restrict__ gain, bf16* __restrict__ WT, LAS float* scr, int item, int lane) {
    const int nblk = N / 32, kb = item / nblk, nb = item - kb * nblk, k0 = 64 * kb, n0 = 32 * nb;
    f32x4 v[8];
#pragma unroll
    for (int i = 0; i < 8; ++i) { const int kk = 8 * i + (lane >> 3); v[i] = *(const f32x4*)(W + (size_t)(k0 + kk) * N + n0 + (lane & 7) * 4); }
#pragma unroll
    for (int i = 0; i < 8; ++i) { const int kk = 8 * i + (lane >> 3); const float g = gain ? gain[k0 + kk] : 1.f; LAS float* s = scr + kk * 33 + (lane & 7) * 4;
        s[0] = v[i].x * g; s[1] = v[i].y * g; s[2] = v[i].z * g; s[3] = v[i].w * g; }
    LDS_WAIT(); asm volatile("" ::: "memory");
    const int c = lane & 7;
#pragma unroll
    for (int j = 0; j < 4; ++j) { const int n = (lane >> 3) + 8 * j; const LAS float* s = scr + (8 * c) * 33 + n;
        v4u o; o.x = pk2(s[0 * 33], s[1 * 33]); o.y = pk2(s[2 * 33], s[3 * 33]); o.z = pk2(s[4 * 33], s[5 * 33]); o.w = pk2(s[6 * 33], s[7 * 33]);
        *(v4u*)(WT + (size_t)(n0 + n) * K + k0 + 8 * c) = o; }
    LDS_WAIT(); asm volatile("" ::: "memory");
}
template <bool I8>
__device__ __forceinline__ void tr_item8(const float* __restrict__ W, int K, int N, const float* __restrict__ gain, float scale, unsigned char* __restrict__ WT, LAS float* scr, int item, int lane) {
    const int nblk = N / 32, kb = item / nblk, nb = item - kb * nblk, k0 = 64 * kb, n0 = 32 * nb;
    f32x4 v[8];
#pragma unroll
    for (int i = 0; i < 8; ++i) { const int kk = 8 * i + (lane >> 3); v[i] = *(const f32x4*)(W + (size_t)(k0 + kk) * N + n0 + (lane & 7) * 4); }
#pragma unroll
    for (int i = 0; i < 8; ++i) { const int kk = 8 * i + (lane >> 3); const float g = (gain ? gain[k0 + kk] : 1.f) * scale; LAS float* s = scr + kk * 33 + (lane & 7) * 4;
        s[0] = v[i].x * g; s[1] = v[i].y * g; s[2] = v[i].z * g; s[3] = v[i].w * g; }
    LDS_WAIT(); asm volatile("" ::: "memory");
    const int c = lane & 7;
#pragma unroll
    for (int j = 0; j < 4; ++j) { const int n = (lane >> 3) + 8 * j; const LAS float* s = scr + (8 * c) * 33 + n;
        float f[8]; v2u o;
        if (I8) {
#pragma unroll
            for (int q = 0; q < 8; ++q) f[q] = rintf(fminf(fmaxf(s[q * 33], -127.f), 127.f));
            o.x = ((unsigned)(int)f[0] & 255u) | (((unsigned)(int)f[1] & 255u) << 8) | (((unsigned)(int)f[2] & 255u) << 16) | ((unsigned)(int)f[3] << 24);
            o.y = ((unsigned)(int)f[4] & 255u) | (((unsigned)(int)f[5] & 255u) << 8) | (((unsigned)(int)f[6] & 255u) << 16) | ((unsigned)(int)f[7] << 24);
        } else {
#pragma unroll
            for (int q = 0; q < 8; ++q) f[q] = fminf(fmaxf(s[q * 33], -448.f), 448.f);
            o.x = pg8::pk4_fp8(f[0], f[1], f[2], f[3]); o.y = pg8::pk4_fp8(f[4], f[5], f[6], f[7]); }
        *(v2u*)(WT + (size_t)(n0 + n) * K + k0 + 8 * c) = o; }
    LDS_WAIT(); asm volatile("" ::: "memory");
}
__device__ __forceinline__ float wave_max(float v) {
    v = fmaxf(v, xsw<1>(v)); v = fmaxf(v, xsw<2>(v)); v = fmaxf(v, xsw<4>(v)); v = fmaxf(v, xsw<8>(v)); v = fmaxf(v, xsw<16>(v));
    return xmax32(v);
}
__device__ __forceinline__ void row_load(const float* __restrict__ xrow, int lane, f32x4 (&ov)[16]) {
#pragma unroll
    for (int j = 0; j < 16; ++j) ov[j] = *(const f32x4*)(xrow + (lane + 64 * j) * 4);
}
__device__ __forceinline__ void row_to_bf16(const f32x4 (&ov)[16], bf16* __restrict__ orow, float* rs_out, unsigned* __restrict__ xq, float* as_out, int lane) {
    float ss = 0.f, am = 0.f;
#pragma unroll
    for (int j = 0; j < 16; ++j) { const int c = (lane + 64 * j) * 4; const f32x4 v = ov[j];
        ss += (v.x * v.x + v.y * v.y) + (v.z * v.z + v.w * v.w); am = fmaxf(fmaxf(am, fmaxf(fabsf(v.x), fabsf(v.y))), fmaxf(fabsf(v.z), fabsf(v.w)));
        v2u o; o.x = pk2(v.x, v.y); o.y = pk2(v.z, v.w); st_wt8(orow + c, o); }
    ss = wave_sum(ss); am = fmaxf(wave_max(am), 1e-20f); const float qs = 127.0f / am;
#pragma unroll
    for (int j = 0; j < 16; ++j) { const int q0 = (int)rintf(ov[j].x * qs), q1 = (int)rintf(ov[j].y * qs), q2 = (int)rintf(ov[j].z * qs), q3 = (int)rintf(ov[j].w * qs);
        st_wt4(xq + lane + 64 * j, ((unsigned)q0 & 255u) | (((unsigned)q1 & 255u) << 8) | (((unsigned)q2 & 255u) << 16) | ((unsigned)q3 << 24)); }
    if (lane == 0) { *rs_out = 1.0f / sqrtf(ss * (1.0f / DM) + EPS); *as_out = am * (1.0f / 127.0f); }
}
__device__ __forceinline__ void resid_rows(bf16* __restrict__ XB, const bf16* __restrict__ Y, const float* __restrict__ PART, const float* __restrict__ g, float* __restrict__ RS,
                                           float* __restrict__ outf, unsigned* __restrict__ XQ, float* __restrict__ AS, int gw, int NGW, int lane) {
    f32x4 gv[16];
#pragma unroll
    for (int j = 0; j < 16; ++j) gv[j] = *(const f32x4*)(g + (lane + 64 * j) * 4);
    for (int m = gw; m < MTOK; m += NGW) {
        const float pv = PART[(size_t)m * 64 + lane];
        bf16* xrow = XB + (size_t)m * DM; const bf16* yrow = Y + (size_t)m * DM;
        v2u xr[16], yr[16];
#pragma unroll
        for (int j = 0; j < 16; ++j) { xr[j] = *(const v2u*)(xrow + (lane + 64 * j) * 4); yr[j] = *(const v2u*)(yrow + (lane + 64 * j) * 4); }
        const float ry = 1.0f / sqrtf(wave_sum(pv) * (1.0f / DM) + EPS);
        float ss = 0.f, am = 0.f; f32x4 ov[16];
#pragma unroll
        for (int j = 0; j < 16; ++j) { const int c = (lane + 64 * j) * 4;
            f32x4 o; o.x = bf_lo(xr[j].x) + bf_lo(yr[j].x) * ry * gv[j].x; o.y = bf_hi(xr[j].x) + bf_hi(yr[j].x) * ry * gv[j].y; o.z = bf_lo(xr[j].y) + bf_lo(yr[j].y) * ry * gv[j].z; o.w = bf_hi(xr[j].y) + bf_hi(yr[j].y) * ry * gv[j].w;
            ss += (o.x * o.x + o.y * o.y) + (o.z * o.z + o.w * o.w); ov[j] = o; am = fmaxf(fmaxf(am, fmaxf(fabsf(o.x), fabsf(o.y))), fmaxf(fabsf(o.z), fabsf(o.w)));
            if (outf) st_wt16(outf + (size_t)m * DM + c, o); else { v2u ob; ob.x = pk2(o.x, o.y); ob.y = pk2(o.z, o.w); st_wt8(xrow + c, ob); } }
        if (XQ) {
            am = fmaxf(wave_max(am), 1e-20f); const float qs = 127.0f / am;
#pragma unroll
            for (int j = 0; j < 16; ++j) { const int q0 = (int)rintf(ov[j].x * qs), q1 = (int)rintf(ov[j].y * qs), q2 = (int)rintf(ov[j].z * qs), q3 = (int)rintf(ov[j].w * qs);
                st_wt4(XQ + (size_t)m * (DM / 4) + lane + 64 * j, ((unsigned)q0 & 255u) | (((unsigned)q1 & 255u) << 8) | (((unsigned)q2 & 255u) << 16) | ((unsigned)q3 << 24)); }
            if (lane == 0) AS[m] = am * (1.0f / 127.0f); }
        ss = wave_sum(ss);
        if (lane == 0) RS[m] = 1.0f / sqrtf(ss * (1.0f / DM) + EPS);
    }
}
__device__ __forceinline__ void mixpost_load(const bf16* __restrict__ MIX, const bf16* __restrict__ DT, int tok, int lane, v4u (&mx)[6], v2u (&ab)[4], v2u (&cb)[4]) {
#pragma unroll
    for (int j = 0; j < 6; ++j) mx[j] = *(const v4u*)(MIX + (size_t)tok * DM + (lane + 64 * j) * 8);
#pragma unroll
    for (int h = 0; h < 4; ++h) { const size_t off = (size_t)tok * 1024 + h * 256 + lane * 4; ab[h] = *(const v2u*)(DT + off); cb[h] = *(const v2u*)(DT + (size_t)MTOK * 1024 + off); }
}
__device__ __forceinline__ void mixpost_row(int tok, int lane, const v4u (&mx)[6], const v2u (&ab)[4], const v2u (&cb)[4], float lam, float oscale, f32x4 sg, unsigned char* __restrict__ MQ, float* __restrict__ MAS) {
    f32x4 yd[4]; float am = 0.f;
#pragma unroll
    for (int h = 0; h < 4; ++h) {
        f32x4 a, c; a.x = bf_lo(ab[h].x); a.y = bf_hi(ab[h].x); a.z = bf_lo(ab[h].y); a.w = bf_hi(ab[h].y); c.x = bf_lo(cb[h].x); c.y = bf_hi(cb[h].x); c.z = bf_lo(cb[h].y); c.w = bf_hi(cb[h].y);
        f32x4 d; d.x = a.x - lam * c.x; d.y = a.y - lam * c.y; d.z = a.z - lam * c.z; d.w = a.w - lam * c.w;
        const float ss = wave_sum((d.x * d.x + d.y * d.y) + (d.z * d.z + d.w * d.w)); const float r = oscale / sqrtf(ss * (1.0f / 256.0f) + EPS);
        yd[h].x = d.x * r * sg.x; yd[h].y = d.y * r * sg.y; yd[h].z = d.z * r * sg.z; yd[h].w = d.w * r * sg.w;
        am = fmaxf(fmaxf(am, fmaxf(fabsf(yd[h].x), fabsf(yd[h].y))), fmaxf(fabsf(yd[h].z), fabsf(yd[h].w))); }
    float mv[6][8];
#pragma unroll
    for (int j = 0; j < 6; ++j) { const unsigned w4[4] = {mx[j].x, mx[j].y, mx[j].z, mx[j].w};
#pragma unroll
        for (int e = 0; e < 4; ++e) { mv[j][2 * e] = bf_lo(w4[e]); mv[j][2 * e + 1] = bf_hi(w4[e]); am = fmaxf(am, fmaxf(fabsf(mv[j][2 * e]), fabsf(mv[j][2 * e + 1]))); } }
    am = fmaxf(wave_max(am), 1e-20f); const float qs = 127.0f / am;
    unsigned char* qrow = MQ + (size_t)tok * DM;
#pragma unroll
    for (int j = 0; j < 6; ++j) { int q[8];
#pragma unroll
        for (int e = 0; e < 8; ++e) q[e] = (int)rintf(mv[j][e] * qs);
        v2u o; o.x = ((unsigned)q[0] & 255u) | (((unsigned)q[1] & 255u) << 8) | (((unsigned)q[2] & 255u) << 16) | ((unsigned)q[3] << 24);
        o.y = ((unsigned)q[4] & 255u) | (((unsigned)q[5] & 255u) << 8) | (((unsigned)q[6] & 255u) << 16) | ((unsigned)q[7] << 24);
        st_wt8(qrow + (lane + 64 * j) * 8, o); }
#pragma unroll
    for (int h = 0; h < 4; ++h) { const int q0 = (int)rintf(yd[h].x * qs), q1 = (int)rintf(yd[h].y * qs), q2 = (int)rintf(yd[h].z * qs), q3 = (int)rintf(yd[h].w * qs);
        st_wt4(qrow + 3072 + h * 256 + lane * 4, ((unsigned)q0 & 255u) | (((unsigned)q1 & 255u) << 8) | (((unsigned)q2 & 255u) << 16) | ((unsigned)q3 << 24)); }
    if (lane == 0) MAS[tok] = am * (1.0f / 127.0f);
}
__device__ __forceinline__ int t5_bucket(int rel) {
    const int n = rel < 0 ? -rel : rel; int b;
    if (n < 8) b = n; else { const int l2 = 31 - __builtin_clz((unsigned)(n * n)); b = 8 + (l2 - 6); if (b > 15) b = 15; }
    return b + (rel > 0 ? 16 : 0);
}

constexpr int I_IN = (DM / 128) * (DIN / 32), I_OUT = (DM / 128) * (DM / 32), I_MI = (DM / 128) * (DFF / 32), I_MO = (DFF / 128) * (DM / 32);
struct ItemD { const float* W; const float* gain; unsigned char* WT; float scale; int K, N, r, kind; };
__device__ __forceinline__ void conv_load(const ItemD& d, int lane, f32x4 (&v)[16]) {
    const int nblk = d.N / 32, kb = d.r / nblk, nb = d.r - kb * nblk, k0 = 128 * kb + 16 * (lane >> 3), n0 = 32 * nb + 4 * (lane & 7);
#pragma unroll
    for (int i = 0; i < 16; ++i) v[i] = *(const f32x4*)(d.W + (size_t)(k0 + i) * d.N + n0);
}
template <int KIND>
__device__ __forceinline__ void conv_finish(const ItemD& d, int lane, const f32x4 (&v)[16]) {
    const int nblk = d.N / 32, kb = d.r / nblk, nb = d.r - kb * nblk, k0 = 128 * kb + 16 * (lane >> 3), n0 = 32 * nb + 4 * (lane & 7);
    float gs[16];
    if (d.gain) {
#pragma unroll
        for (int i = 0; i < 4; ++i) { const f32x4 g4 = *(const f32x4*)(d.gain + k0 + 4 * i); gs[4 * i] = g4.x * d.scale; gs[4 * i + 1] = g4.y * d.scale; gs[4 * i + 2] = g4.z * d.scale; gs[4 * i + 3] = g4.w * d.scale; }
    } else {
#pragma unroll
        for (int i = 0; i < 16; ++i) gs[i] = d.scale; }
#pragma unroll
    for (int j = 0; j < 4; ++j) {
        if (KIND == 0) { v4u o0, o1;
            o0.x = pk2(v[0][j] * gs[0], v[1][j] * gs[1]); o0.y = pk2(v[2][j] * gs[2], v[3][j] * gs[3]); o0.z = pk2(v[4][j] * gs[4], v[5][j] * gs[5]); o0.w = pk2(v[6][j] * gs[6], v[7][j] * gs[7]);
            o1.x = pk2(v[8][j] * gs[8], v[9][j] * gs[9]); o1.y = pk2(v[10][j] * gs[10], v[11][j] * gs[11]); o1.z = pk2(v[12][j] * gs[12], v[13][j] * gs[13]); o1.w = pk2(v[14][j] * gs[14], v[15][j] * gs[15]);
            bf16* dst = (bf16*)d.WT + (size_t)(n0 + j) * d.K + k0; *(v4u*)dst = o0; *(v4u*)(dst + 8) = o1;
        } else { unsigned w[4];
#pragma unroll
            for (int t = 0; t < 4; ++t) {
                if (KIND == 1) { int b[4];
#pragma unroll
                    for (int e = 0; e < 4; ++e) { const int bits = __float_as_int(fmaf(v[4 * t + e][j], gs[4 * t + e], 12582912.0f)); b[e] = min(max(bits, 0x4B400000 - 127), 0x4B400000 + 127); }
                    w[t] = __builtin_amdgcn_perm((unsigned)b[1], (unsigned)b[0], 0x0c0c0400u) | __builtin_amdgcn_perm((unsigned)b[3], (unsigned)b[2], 0x04000c0cu);
                } else { float f[4];
#pragma unroll
                    for (int e = 0; e < 4; ++e) f[e] = __builtin_amdgcn_fmed3f(v[4 * t + e][j] * gs[4 * t + e], -448.f, 448.f);
                    w[t] = pg8::pk4_fp8(f[0], f[1], f[2], f[3]); } }
            v4u o; o.x = w[0]; o.y = w[1]; o.z = w[2]; o.w = w[3];
            st_wt16(d.WT + (size_t)(n0 + j) * d.K + k0, o); } }
}
constexpr int CONV_TAIL_ITEMS = 8192;
struct ConvSrc { const float *w_in, *w_out, *w_mlp_in, *w_mlp_out, *ln_attn_pre, *ln_mlp_pre; };
__device__ __forceinline__ int conv_cnt(int t0, int t1, int t) { return (t0 <= t && t < t1) ? (t == 0 ? I_IN : t == 1 ? I_OUT : t == 2 ? I_MI : I_MO) : 0; }
__device__ __forceinline__ void conv_decode(const ConvSrc& cs, unsigned char* ws, float sa_in, float sa_mi, float sa_out, float sb_in, int la, int a0, int a1, int lb, int b0, int b1, int na, int it, ItemD& d) {
    const bool inA = it < na; const int l = inA ? la : lb, t0 = inA ? a0 : b0, t1 = inA ? a1 : b1; int r = inA ? it : it - na; unsigned char* wl = ws + WS_W + (size_t)l * W_LAYER_B;
    const int n0 = conv_cnt(t0, t1, 0), n1 = conv_cnt(t0, t1, 1), n2 = conv_cnt(t0, t1, 2);
    if (r < n0) { d = ItemD{cs.w_in + (size_t)l * DM * DIN, cs.ln_attn_pre + l * DM, wl, inA ? sa_in : sb_in, DM, DIN, r, 1}; return; } r -= n0;
    if (r < n1) { d = ItemD{cs.w_out + (size_t)l * DM * DM, nullptr, wl + W_IN_B, sa_out, DM, DM, r, 1}; return; } r -= n1;
    if (r < n2) { d = ItemD{cs.w_mlp_in + (size_t)l * DM * DFF, cs.ln_mlp_pre + l * DM, wl + W_IN_B + W_OUT_B, sa_mi, DM, DFF, r, 1}; return; } r -= n2;
    d = ItemD{cs.w_mlp_out + (size_t)l * DFF * DM, nullptr, wl + W_IN_B + W_OUT_B + W_MI_B, WMO_SCALE, DFF, DM, r, 2};
}
__device__ __forceinline__ void conv_stream(const ConvSrc& cs, unsigned char* ws, float sa_in, float sa_mi, float sa_out, float sb_in, int la, int a0, int a1, int lb, int b0, int b1, int it0, int it1, int gw, int NGW, int lane) {
    const int na = conv_cnt(a0, a1, 0) + conv_cnt(a0, a1, 1) + conv_cnt(a0, a1, 2) + conv_cnt(a0, a1, 3), nb = conv_cnt(b0, b1, 0) + conv_cnt(b0, b1, 1) + conv_cnt(b0, b1, 2) + conv_cnt(b0, b1, 3), ntot = na + nb;
    const int iend = it1 < ntot ? it1 : ntot;
    for (int it = it0 + gw; it < iend; it += 2 * NGW) { ItemD c0, c1; f32x4 v0[16], v1[16]; const bool two = it + NGW < iend;
        conv_decode(cs, ws, sa_in, sa_mi, sa_out, sb_in, la, a0, a1, lb, b0, b1, na, it, c0); conv_load(c0, lane, v0);
        if (two) { conv_decode(cs, ws, sa_in, sa_mi, sa_out, sb_in, la, a0, a1, lb, b0, b1, na, it + NGW, c1); conv_load(c1, lane, v1); }
        if (c0.kind == 1) conv_finish<1>(c0, lane, v0); else if (c0.kind == 2) conv_finish<2>(c0, lane, v0); else conv_finish<0>(c0, lane, v0);
        if (two) { if (c1.kind == 1) conv_finish<1>(c1, lane, v1); else if (c1.kind == 2) conv_finish<2>(c1, lane, v1); else conv_finish<0>(c1, lane, v1); } }
}

struct Args { const float* in[16]; float* out; unsigned char* ws; int ph_lo, ph_hi, li, pad; };
constexpr int NPHASES = 1 + 9 * DEPTH;

typedef __attribute__((address_space(4))) const Args* CArgs;
#define PH_ENTER() CArgs A_ = (CArgs)__builtin_amdgcn_kernarg_segment_ptr(); asm volatile("" : "+s"(A_)); unsigned char* ws = A_->ws; \
    int wave = wave0; asm volatile("" : "+s"(wave)); int lane = lane_id(); asm volatile("" : "+v"(lane)); const int tid = wave * 64 + lane; (void)tid; \
    const int G = gridDim.x, bx = blockIdx.x, vcu = (G % 8 == 0) ? (bx % 8) * (G / 8) + bx / 8 : bx; const int gw = vcu * NWAVES + wave, NGW = G * NWAVES; (void)lane; (void)gw; (void)NGW; (void)ws; (void)bx;
#define IN_(k) (A_->in[k])

__global__ void __launch_bounds__(NWAVES * 64, 2) mk_fwd(Args args) {
    extern __shared__ __attribute__((aligned(16))) unsigned char lds_raw[];
    LAS unsigned char* lds = (LAS unsigned char*)lds_raw;
    XcdBarrier bar; const int wave0 = __builtin_amdgcn_readfirstlane((int)threadIdx.x >> 6);
    { volatile LAS unsigned* MISC = (volatile LAS unsigned*)(lds + MISC_OFF);
      for (int u = threadIdx.x; u < (LDS_BYTES - LDSCTL_OFF) / 4; u += NWAVES * 64) ((LAS unsigned*)(lds + LDSCTL_OFF))[u] = 0u;
      __syncthreads();
      bar = xcd_barrier_post((unsigned*)(args.ws + WS_CTL) + CW_BAR + args.li * XCD_BAR_WORDS, MISC + 8); }
    const int lo = args.ph_lo, hi = args.ph_hi;
#define IN(k) (lo <= (k) && (k) < hi)
#ifndef PROBE_DUP
#define PROBE_DUP 0
#endif
#define DUPN(bit) (((PROBE_DUP >> (bit)) & 1) ? 2 : 1)
#define SEAM(k) do { if (IN(k) && IN((k) + 1)) xcd_barrier(bar); } while (0)

    if (IN(0)) for (int dup_ = 0; dup_ < DUPN(0); ++dup_) {
        PH_ENTER();
        const float* x_in = IN_(0); const float* ln_attn_pre = IN_(1); const float* ln_mlp_pre = IN_(3); const float* w_in = IN_(5); const float* w_out = IN_(6); const float* w_mlp_in = IN_(14); const float* w_mlp_out = IN_(15);
        float* RS = (float*)(ws + WS_RS); float* ROPE = (float*)(ws + WS_ROPE); bf16* XB = (bf16*)(ws + WS_XB);
        LAS float* scr = (LAS float*)(lds + wave * 16384);
        float wqi0 = 0.f;
        { float am[3 * DEPTH], gm[3 * DEPTH];
#pragma unroll
          for (int t = 0; t < 3 * DEPTH; ++t) { const int l = t / 3, kd = t - 3 * l;
            am[t] = 0.f; gm[t] = 0.f; if (t != 0 && (t % G) != bx) continue;
            const float* wsrc = kd == 0 ? w_in + (size_t)l * DM * DIN : kd == 1 ? w_mlp_in + (size_t)l * DM * DFF : w_out + (size_t)l * DM * DM; const float* gs = (kd == 0 ? ln_attn_pre : ln_mlp_pre) + l * DM; float a = 0.f, g = 0.f;
#pragma unroll 8
            for (int i = 0; i < 32; ++i) { const f32x4 v = *(const f32x4*)(wsrc + (size_t)(tid + 512 * i) * 4); a = fmaxf(fmaxf(a, fmaxf(fabsf(v.x), fabsf(v.y))), fmaxf(fabsf(v.z), fabsf(v.w))); }
            if (kd == 2) g = 1.f; else {
#pragma unroll
                for (int i = 0; i < 8; ++i) g = fmaxf(g, fabsf(gs[tid + 512 * i])); }
            am[t] = wave_max(a); gm[t] = wave_max(g); }
          LAS float* red = (LAS float*)(lds + 131072 - 1024);
          __syncthreads();
          if (lane == 0) {
#pragma unroll
            for (int t = 0; t < 3 * DEPTH; ++t) { red[t * 16 + wave] = am[t]; red[t * 16 + 8 + wave] = gm[t]; } }
          __syncthreads();
#pragma unroll
          for (int t = 0; t < 3 * DEPTH; ++t) { float a2 = 0.f, g2 = 0.f;
#pragma unroll
            for (int w = 0; w < 8; ++w) { a2 = fmaxf(a2, red[t * 16 + w]); g2 = fmaxf(g2, red[t * 16 + 8 + w]); }
            const float amax = fmaxf(a2 * g2 * 1.0f, 1e-20f); if (t == 0) wqi0 = 127.0f / amax;
            if ((t % G) == bx && tid == 0) { ((float*)(ws + WS_WQS))[t] = amax * (1.0f / 127.0f); ((float*)(ws + WS_WQS))[8 + t] = 127.0f / amax; } } }
        { const ConvSrc cs{w_in, w_out, w_mlp_in, w_mlp_out, ln_attn_pre, ln_mlp_pre};
          conv_stream(cs, ws, wqi0, 0.f, 0.f, 0.f, 0, 0, 1, 0, 0, 0, 0, 1 << 30, gw, NGW, lane); }
        if (gw < MTOK) {
            const int n = (MTOK - gw + NGW - 1) / NGW, lastm = gw + (n - 1) * NGW; f32x4 rA[16], rB[16];
#define ROW_OUT(m_, r_) row_to_bf16(r_, XB + (size_t)(m_) * DM, RS + (m_), (unsigned*)(ws + WS_XQ) + (size_t)(m_) * (DM / 4), (float*)(ws + WS_AS) + (m_), lane)
            row_load(x_in + (size_t)gw * DM, lane, rA);
            for (int k = 0; k < n; k += 2) { const int m1 = min(gw + (k + 1) * NGW, lastm), m2 = min(gw + (k + 2) * NGW, lastm);
                row_load(x_in + (size_t)m1 * DM, lane, rB); ROW_OUT(gw + k * NGW, rA);
                row_load(x_in + (size_t)m2 * DM, lane, rA); ROW_OUT(m1, rB); }
#undef ROW_OUT
        }
        for (int i = gw * 64 + lane; i < SEQ * 64; i += NGW * 64) { const int pos = i >> 6, pi = i & 63, j = pi & 31; const float p = (float)((pi < 32) ? (pos >> 6) : (pos & 63));
            const float inv = exp2f(-(float)j * (13.287712379549449f / 32.0f)); float t = (p * inv) * 0.15915494309189535f; t -= floorf(t);
            ROPE[2 * i] = __builtin_amdgcn_cosf(t); ROPE[2 * i + 1] = __builtin_amdgcn_sinf(t); }
    }
    SEAM(0);

    for (int l = 0; l < DEPTH; ++l) {
        const int pb = 1 + 9 * l;

        if (IN(pb + 0)) for (int dup_ = 0; dup_ < DUPN(1); ++dup_) {
            PH_ENTER();
            const bf16* Win_t = (const bf16*)(ws + WS_W + (size_t)l * W_LAYER_B);
            pg8::Gemm g{(const bf16*)(ws + WS_XQ), Win_t, MTOK, DIN, DM / 2}; pg8::StaticOrder S; S.init(MTOK, DIN, G, bx);
            pg8::EpiProjI8 E{(bf16*)(ws + WS_PROJ), DIN, (const float*)(ws + WS_RS), (const float*)(ws + WS_AS), (const float*)(ws + WS_WQS) + 3 * l, (LAS float*)(lds + RING_BYTES + 1024), IN_(8) + l * 128, IN_(9) + l * 128, (const float*)(ws + WS_ROPE), SEQ};
            pg8::gemm_phase<pg8::EpiProjI8, pg8::StaticOrder, true, true, 2>(lds, g, S, E, tid);
            { const int nwg = (MTOK / 256) * (DIN / 256), rem = nwg % G;
              if (dup_ == 0 && rem > 0 && bx >= rem) { const float* qsc = (const float*)(ws + WS_WQS) + 8; const ConvSrc cs{IN_(5), IN_(6), IN_(14), IN_(15), IN_(1), IN_(3)};
                  conv_stream(cs, ws, 0.f, qsc[3 * l + 1], qsc[3 * l + 2], (l + 1 < DEPTH) ? qsc[3 * l + 3] : 0.f, l, 1, 4, l + 1, 0, (l + 1 < DEPTH) ? 1 : 0, 0, CONV_TAIL_ITEMS, (bx - rem) * NWAVES + wave, (G - rem) * NWAVES, lane); }
            }
        }
        SEAM(pb + 0);


        if (IN(pb + 2)) for (int dup_ = 0; dup_ < DUPN(3); ++dup_) {
            PH_ENTER();
            const bf16* PROJ = (const bf16*)(ws + WS_PROJ); bf16* MIX = (bf16*)(ws + WS_MIX); bf16* DT = (bf16*)(ws + WS_DT);
            const float* na_rpb = IN_(7); const float* sw_sink = IN_(10); const float* t5_table = IN_(13);
            LAS float* tab = (LAS float*)(lds + att::OFF_TAB);
            const int cslot = vcu % 5; int ui = 0;
            for (int s = vcu; s < 1280; s += G, ++ui) {
                if (ui == cslot) {
                    CArgs A2 = (CArgs)__builtin_amdgcn_kernarg_segment_ptr(); asm volatile("" : "+s"(A2)); unsigned char* ws2 = A2->ws;
                    int wv2 = wave0; asm volatile("" : "+s"(wv2)); int ln2 = lane_id(); asm volatile("" : "+v"(ln2)); const int gw2 = vcu * NWAVES + wv2;
                    const float* qsc = (const float*)(ws2 + WS_WQS) + 8;
                    const ConvSrc cs{A2->in[5], A2->in[6], A2->in[14], A2->in[15], A2->in[1], A2->in[3]};
                    conv_stream(cs, ws2, 0.f, qsc[3 * l + 1], qsc[3 * l + 2], (l + 1 < DEPTH) ? qsc[3 * l + 3] : 0.f, l, 1, 4, l + 1, 0, (l + 1 < DEPTH) ? 1 : 0, (((MTOK / 256) * (DIN / 256)) % G) ? CONV_TAIL_ITEMS : 0, 1 << 30, gw2, NGW, ln2); }
                const int kind = s >> 8, v = s & 255; int t2 = wave * 64 + lane_id(); asm volatile("" : "+v"(t2));
                const bf16 *Qp, *Kp; int vdelta, mode, kbeg = 0, nkeys = SEQ, qt = v & 7; float sink = 0.f; void* Op;
                if (kind == 0) {
                    const int b = v >> 6, hq = (v >> 3) & 7; mode = att::MODE_B;
                    const bf16* base = PROJ + (size_t)(b * SEQ) * DIN;
                    Qp = base + (size_t)(qt * 256) * DIN + C_BQ + hq * 128; Kp = base + C_BK + (hq >> 2) * 128; vdelta = C_BV - C_BK;
                    Op = MIX + (size_t)(b * SEQ + qt * 256) * DM + 1024 + hq * 128;
                } else if (kind <= 2) {
                    const int u = v + 256 * (kind - 1), b = u >> 7, h = (u >> 5) & 3, sm = (u >> 4) & 1, vh = (u >> 3) & 1; mode = att::MODE_D;
                    const bf16* base = PROJ + (size_t)(b * SEQ) * DIN;
                    Qp = base + (size_t)(qt * 256) * DIN + C_DQ + sm * 512 + h * 128; Kp = base + C_DK + sm * 512 + h * 128; vdelta = (C_DV + h * 256 + vh * 128) - (C_DK + sm * 512 + h * 128);
                    Op = DT + (size_t)sm * MTOK * 1024 + (size_t)(b * SEQ + qt * 256) * 1024 + h * 256 + vh * 128;
                    for (int i = t2; i < 768; i += NWAVES * 64) tab[i] = t5_table[t5_bucket(i - att::TREL) * 12 + 8 + h] * att::INV_SCALE;
                } else if (kind == 3) {
                    const int b = v >> 6, h = (v >> 3) & 7; mode = att::MODE_A;
                    int rlo = min(max(4 * qt - 4, 0), 24), rhi = min(max(4 * qt + 3 - 4, 0), 24) + 8;
                    if ((rhi - rlo) & 1) { if (rlo > 0) --rlo; else ++rhi; }
                    kbeg = rlo * 64; nkeys = (rhi - rlo) * 64;
                    const bf16* base = PROJ + (size_t)(b * SEQ) * DIN;
                    Qp = base + (size_t)(qt * 256) * DIN + C_AQ + h * 128; Kp = base + (size_t)kbeg * DIN + C_AK + h * 128; vdelta = C_AV - C_AK;
                    Op = MIX + (size_t)(b * SEQ + qt * 256) * DM + h * 128;
                    const float* rp = na_rpb + ((size_t)l * 8 + h) * 15 * 31;
                    for (int i = t2; i < 15 * 128; i += NWAVES * 64) { const int dr = i >> 7, dc = (i & 127) - 48; tab[i] = (dc >= 0 && dc < 31) ? rp[dr * 31 + dc] * att::INV_SCALE : 0.f; }
                } else {
                    const int b = v >> 6, hq = (v >> 3) & 7; qt = (v + 4) & 7; mode = att::MODE_C;
                    kbeg = max(0, qt * 256 - 128); const int kend = min(SEQ, qt * 256 + 256 + 128); nkeys = kend - kbeg;
                    const bf16* base = PROJ + (size_t)(b * SEQ) * DIN;
                    Qp = base + (size_t)(qt * 256) * DIN + C_CQ + hq * 128; Kp = base + (size_t)kbeg * DIN + C_CK + (hq >> 2) * 128; vdelta = C_CV - C_CK;
                    Op = MIX + (size_t)(b * SEQ + qt * 256) * DM + 2048 + hq * 128;
                    sink = sw_sink[l * 8 + hq];
                    for (int i = t2; i < 768; i += NWAVES * 64) { const int rel = i - att::TREL; tab[i] = (rel >= -128 && rel <= 128) ? t5_table[t5_bucket(rel) * 12 + hq] * att::INV_SCALE : att::MASKV; }
                }
                att::attn_unit<DIN>(Qp, Kp, vdelta, nkeys, mode, kbeg, qt * 256, (const LAS float*)tab, sink, Op, (att::lptr)lds, t2);
            }
            if (ui <= cslot) {
                int ln3 = lane_id(); asm volatile("" : "+v"(ln3)); const float* qsc = (const float*)(ws + WS_WQS) + 8;
                const ConvSrc cs{IN_(5), IN_(6), IN_(14), IN_(15), IN_(1), IN_(3)};
                conv_stream(cs, ws, 0.f, qsc[3 * l + 1], qsc[3 * l + 2], (l + 1 < DEPTH) ? qsc[3 * l + 3] : 0.f, l, 1, 4, l + 1, 0, (l + 1 < DEPTH) ? 1 : 0, (((MTOK / 256) * (DIN / 256)) % G) ? CONV_TAIL_ITEMS : 0, 1 << 30, gw, NGW, ln3); }
        }
        SEAM(pb + 2);

        if (IN(pb + 3)) for (int dup_ = 0; dup_ < DUPN(4); ++dup_) {
            PH_ENTER();
            const bf16* DT = (const bf16*)(ws + WS_DT); const bf16* MIX = (const bf16*)(ws + WS_MIX); unsigned char* MQ = ws + WS_XQ; float* MAS = (float*)(ws + WS_MAS);
            const float lam_init = 0.8f - 0.6f * expf(-0.3f * (float)l);
            const float* lp = IN_(11) + l * 512;
            const float s1 = wave_sum(lp[lane] * lp[128 + lane] + lp[64 + lane] * lp[192 + lane]), s2 = wave_sum(lp[256 + lane] * lp[384 + lane] + lp[320 + lane] * lp[448 + lane]);
            const float lam = expf(s1) - expf(s2) + lam_init, oscale = 1.0f - lam_init;
            const f32x4 sg = *(const f32x4*)(IN_(12) + l * 256 + lane * 4);
            { const int n = (MTOK - gw + NGW - 1) / NGW, lastt = gw + (n - 1) * NGW;
              v4u mxA[6], mxB[6]; v2u abA[4], cbA[4], abB[4], cbB[4];
              mixpost_load(MIX, DT, gw, lane, mxA, abA, cbA);
              for (int k = 0; k < n; k += 2) {
                  mixpost_load(MIX, DT, min(gw + (k + 1) * NGW, lastt), lane, mxB, abB, cbB);
                  mixpost_row(gw + k * NGW, lane, mxA, abA, cbA, lam, oscale, sg, MQ, MAS);
                  mixpost_load(MIX, DT, min(gw + (k + 2) * NGW, lastt), lane, mxA, abA, cbA);
                  mixpost_row(min(gw + (k + 1) * NGW, lastt), lane, mxB, abB, cbB, lam, oscale, sg, MQ, MAS);
              } }
        }
        SEAM(pb + 3);

        if (IN(pb + 4)) for (int dup_ = 0; dup_ < DUPN(5); ++dup_) {
            PH_ENTER();
            const bf16* Wout_t = (const bf16*)(ws + WS_W + (size_t)l * W_LAYER_B + W_IN_B);
            pg8::Gemm g{(const bf16*)(ws + WS_XQ), Wout_t, MTOK, DM, DM / 2}; pg8::StaticOrder S; S.init(MTOK, DM, G, bx);
            pg8::EpiYStats<true> E{(bf16*)(ws + WS_Y), DM, (float*)(ws + WS_PART), 1.0f, (const float*)(ws + WS_MAS), (const float*)(ws + WS_WQS) + 3 * l + 2};
            pg8::gemm_phase<pg8::EpiYStats<true>, pg8::StaticOrder, true, true, 2>(lds, g, S, E, tid);
        }
        SEAM(pb + 4);

        if (IN(pb + 5)) {
            PH_ENTER();
            resid_rows((bf16*)(ws + WS_XB), (const bf16*)(ws + WS_Y), (const float*)(ws + WS_PART), IN_(2) + l * DM, (float*)(ws + WS_RS), nullptr, (unsigned*)(ws + WS_XQ), (float*)(ws + WS_AS), gw, NGW, lane);
        }
        SEAM(pb + 5);

        if (IN(pb + 6)) for (int dup_ = 0; dup_ < DUPN(7); ++dup_) {
            PH_ENTER();
            const bf16* Wmi_t = (const bf16*)(ws + WS_W + (size_t)l * W_LAYER_B + W_IN_B + W_OUT_B);
            pg8::Gemm g{(const bf16*)(ws + WS_XQ), Wmi_t, MTOK, DFF, DM / 2}; pg8::StaticOrder S; S.init(MTOK, DFF, G, bx);
            pg8::EpiRelu2Fp8<true> E{(unsigned char*)(ws + WS_U), DFF, (const float*)(ws + WS_RS), (const float*)(ws + WS_AS), (const float*)(ws + WS_WQS) + 3 * l + 1, U_SCALE};
            pg8::gemm_phase<pg8::EpiRelu2Fp8<true>, pg8::StaticOrder, true, true, 2>(lds, g, S, E, tid);
        }
        SEAM(pb + 6);

        if (IN(pb + 7)) for (int dup_ = 0; dup_ < DUPN(8); ++dup_) {
            PH_ENTER();
            const bf16* Wmo_t = (const bf16*)(ws + WS_W + (size_t)l * W_LAYER_B + W_IN_B + W_OUT_B + W_MI_B);
            pg8::Gemm g{(const bf16*)(ws + WS_U), Wmo_t, MTOK, DM, DFF / 2}; pg8::StaticOrder S; S.init(MTOK, DM, G, bx);
            pg8::EpiYStats<false> E{(bf16*)(ws + WS_Y), DM, (float*)(ws + WS_PART), 1.0f / (U_SCALE * WMO_SCALE), nullptr, nullptr};
            pg8::gemm_phase<pg8::EpiYStats<false>, pg8::StaticOrder, true, true, 1>(lds, g, S, E, tid);
        }
        SEAM(pb + 7);

        if (IN(pb + 8)) {
            PH_ENTER();
            resid_rows((bf16*)(ws + WS_XB), (const bf16*)(ws + WS_Y), (const float*)(ws + WS_PART), IN_(4) + l * DM, (float*)(ws + WS_RS), (l == DEPTH - 1) ? A_->out : nullptr, (l == DEPTH - 1) ? nullptr : (unsigned*)(ws + WS_XQ), (float*)(ws + WS_AS), gw, NGW, lane);
        }
        SEAM(pb + 8);
    }
#undef IN
#undef SEAM
}

#ifndef MK_PER_PHASE
#define MK_PER_PHASE 0
#endif
extern "C" void kernel_launch(void* const* d_in, const int* in_sizes, int n_in, void* d_out, int out_size, void* d_ws, size_t ws_size, hipStream_t stream) {
    static int grid = 0;
    if (grid == 0) {
        if (n_in != 16 || in_sizes[0] != MTOK * DM || out_size != MTOK * DM || ws_size < WS_END) {
            fprintf(stderr, "kernel_launch: shape mismatch: n_in %d in0 %d out %d ws %zu (need %zu); nothing launched\n", n_in, n_in > 0 ? in_sizes[0] : -1, out_size, ws_size, (size_t)WS_END); grid = -1; return; }
        int dev = 0, cus = 0, per_cu = 0;
        if (hipGetDevice(&dev) != hipSuccess || hipDeviceGetAttribute(&cus, hipDeviceAttributeMultiprocessorCount, dev) != hipSuccess) { fprintf(stderr, "kernel_launch: device query failed\n"); grid = -1; return; }
        if (hipFuncSetAttribute((const void*)mk_fwd, hipFuncAttributeMaxDynamicSharedMemorySize, LDS_BYTES) != hipSuccess) { fprintf(stderr, "kernel_launch: hipFuncSetAttribute failed\n"); grid = -1; return; }
        if (hipOccupancyMaxActiveBlocksPerMultiprocessor(&per_cu, (const void*)mk_fwd, NWAVES * 64, LDS_BYTES) != hipSuccess || per_cu < 1)
            fprintf(stderr, "kernel_launch: note: occupancy query reports %d workgroups per CU\n", per_cu);
        (void)hipGetLastError();
        grid = cus;
    }
    if (grid < 0) return;
    if (hipMemsetAsync((char*)d_ws + WS_CTL, 0, CTL_ZERO_BYTES, stream) != hipSuccess) { fprintf(stderr, "kernel_launch: memset failed\n"); return; }
    Args a{};
    for (int i = 0; i < 16; ++i) a.in[i] = (const float*)d_in[i];
    a.out = (float*)d_out; a.ws = (unsigned char*)d_ws; a.pad = 0;
#if MK_PER_PHASE
    for (int p = 0; p < NPHASES; ++p) { a.ph_lo = p; a.ph_hi = p + 1; a.li = p; hipLaunchKernelGGL(mk_fwd, dim3(grid), dim3(NWAVES * 64), LDS_BYTES, stream, a); }
#else
    a.ph_lo = 0; a.ph_hi = NPHASES; a.li = 0;
    hipLaunchKernelGGL(mk_fwd, dim3(grid), dim3(NWAVES * 64), LDS_BYTES, stream, a);
#endif
    const hipError_t le = hipPeekAtLastError();
    if (le != hipSuccess) fprintf(stderr, "kernel_launch: launch failed: %s\n", hipGetErrorName(le));
}
```

```cpp
#include <hip/hip_runtime.h>
#include <cstdio>
#include <cstdint>

template <int O> __device__ __forceinline__ float xsw(float v) { return __int_as_float(__builtin_amdgcn_ds_swizzle(__float_as_int(v), (O << 10) | 0x1f)); }
__device__ __forceinline__ float xsum32(float v) { auto rr = __builtin_amdgcn_permlane32_swap(__float_as_uint(v), __float_as_uint(v), false, false); return __uint_as_float(rr[0]) + __uint_as_float(rr[1]); }
__device__ __forceinline__ float xmax32(float v) { auto rr = __builtin_amdgcn_permlane32_swap(__float_as_uint(v), __float_as_uint(v), false, false); return fmaxf(__uint_as_float(rr[0]), __uint_as_float(rr[1])); }

template <int OFF = 0, class V> __device__ __forceinline__ void st_wt16(void* p, V v) { static_assert(sizeof(V) == 16, ""); asm volatile("global_store_dwordx4 %0, %1, off offset:%2 sc1\n\ts_nop 1" :: "v"(p), "v"(v), "i"(OFF)); }
template <int OFF = 0, class V> __device__ __forceinline__ void st_wt8(void* p, V v) { static_assert(sizeof(V) == 8, ""); asm volatile("global_store_dwordx2 %0, %1, off offset:%2 sc1\n\ts_nop 1" :: "v"(p), "v"(v), "i"(OFF)); }
__device__ __forceinline__ void st_wt4(void* p, unsigned v) { asm volatile("global_store_dword %0, %1, off sc1\n\ts_nop 1" :: "v"(p), "v"(v)); }
namespace pg8 {
#define PG8_LAS __attribute__((address_space(3)))
typedef unsigned short bf16_t;
typedef short bf16x8 __attribute__((ext_vector_type(8)));
typedef float f32x4 __attribute__((ext_vector_type(4)));
typedef unsigned u32x4 __attribute__((ext_vector_type(4)));
typedef int i32x4 __attribute__((ext_vector_type(4)));
typedef int i32x8 __attribute__((ext_vector_type(8)));
typedef unsigned u32x2 __attribute__((ext_vector_type(2)));
constexpr int BM = 256, BK = 64, HALF = 128, HTB = HALF * BK * 2  , STAGE_BYTES = 8 * HTB, NXCD = 8, WGM = 4;

__host__ __device__ __forceinline__ int lds_byte(int r, int c) { const int st = (r >> 4) * 2 + (c >> 5), rr = r & 15, cc = c & 31, ob = rr * 64 + cc * 2; return st * 1024 + (ob ^ (((ob >> 9) & 1) << 5)); }
__host__ __device__ __forceinline__ void stage_rc(int b, int& R, int& C) { const int st = b / 1024, sb = b % 1024, swz = sb ^ (((sb >> 9) & 1) << 5); R = (st >> 1) * 16 + swz / 64; C = (st & 1) * 32 + (swz % 64) / 2; }
__host__ __device__ __forceinline__ int perm32(int rho) { const int n = rho >> 4, i = rho & 15; return 8 * (i >> 2) + 4 * n + (i & 3); }

struct Unit { int pm, pn; };
struct Gemm { const bf16_t* A; const bf16_t* Bt; int M, N, K; };

struct StaticOrder {
    int nM, nN, nwg, G, c;
    __host__ __device__ void init(int M, int N, int G_, int c_) { nM = M / BM; nN = N / BM; nwg = nM * nN; G = G_; c = c_; }
    __host__ __device__ bool next(int i, Unit& u) const {
        const long L = (long)i * G + c; if (L >= nwg) return false;
        int wgid = (int)L; { const int q = nwg / NXCD, r = nwg % NXCD, xcd = wgid % NXCD, off = wgid / NXCD; wgid = (xcd < r ? xcd * (q + 1) : r * (q + 1) + (xcd - r) * q) + off; }
        const int nig = WGM * nN, gid = wgid / nig, fm = gid * WGM, gsz = (nM - fm) < WGM ? (nM - fm) : WGM;
        u.pm = fm + ((wgid % nig) % gsz); u.pn = (wgid % nig) / gsz; return true;
    }
    __device__ __forceinline__ void a_ready(const Unit&) const {}
    __device__ __forceinline__ void done(const Unit&) const {}
};


__device__ __forceinline__ unsigned cvt_pk_bf16(float lo, float hi) { unsigned r; asm volatile("v_cvt_pk_bf16_f32 %0, %1, %2" : "=v"(r) : "v"(lo), "v"(hi)); return r; }

template <int ACT> struct EpiRowScale {
    static constexpr bool PERM = true, AFTER_DRAIN = false;
    bf16_t* O; int ldc; const float* rs;
    __device__ __forceinline__ void operator()(const f32x4 (&acc)[2][2][4][2], const Unit& u, int wr, int wc, int fr, int fq) const {
        asm volatile("" : "+v"(fr), "+v"(fq));
        const int row0 = u.pm * BM + wr * 64 + fr, col0 = u.pn * BM + wc * 32 + 8 * fq;
#pragma unroll
        for (int ai = 0; ai < 2; ++ai)
#pragma unroll
            for (int m = 0; m < 4; ++m) { const int row = row0 + ai * HALF + m * 16; const float s = rs[row]; bf16_t* rowp = O + (size_t)row * ldc + col0;
#pragma unroll
                for (int bj = 0; bj < 2; ++bj) { f32x4 v0 = acc[ai][bj][m][0] * s, v1 = acc[ai][bj][m][1] * s;
                    if (ACT == 1) {
#pragma unroll
                        for (int j = 0; j < 4; ++j) { const float a = fmaxf(v0[j], 0.f), b = fmaxf(v1[j], 0.f); v0[j] = a * a; v1[j] = b * b; } }
                    u32x4 w; w.x = cvt_pk_bf16(v0[0], v0[1]); w.y = cvt_pk_bf16(v0[2], v0[3]); w.z = cvt_pk_bf16(v1[0], v1[1]); w.w = cvt_pk_bf16(v1[2], v1[3]);
                    *(u32x4*)(rowp + bj * HALF) = w; } }
    }
};
template <bool INT> struct EpiYStats {
    static constexpr bool PERM = true, AFTER_DRAIN = false;
    bf16_t* O; int ldc; float* part; float sc; const float* as; const float* wsc;
    __device__ __forceinline__ void operator()(const f32x4 (&acc)[2][2][4][2], const Unit& u, int wr, int wc, int fr, int fq) const {
        asm volatile("" : "+v"(fr), "+v"(fq));
        const int row0 = u.pm * BM + wr * 64 + fr, col0 = u.pn * BM + wc * 32 + 8 * fq;
#pragma unroll
        for (int ai = 0; ai < 2; ++ai)
#pragma unroll
            for (int m = 0; m < 4; ++m) { const int row = row0 + ai * HALF + m * 16; bf16_t* rowp = O + (size_t)row * ldc + col0; float ss = 0.f; const float s = INT ? as[row] * wsc[0] : sc;
#pragma unroll
                for (int bj = 0; bj < 2; ++bj) { f32x4 v0, v1;
#pragma unroll
                    for (int j = 0; j < 4; ++j) { v0[j] = (INT ? (float)__float_as_int(acc[ai][bj][m][0][j]) : acc[ai][bj][m][0][j]) * s; v1[j] = (INT ? (float)__float_as_int(acc[ai][bj][m][1][j]) : acc[ai][bj][m][1][j]) * s; }
                    ss += (v0[0] * v0[0] + v0[1] * v0[1]) + (v0[2] * v0[2] + v0[3] * v0[3]) + (v1[0] * v1[0] + v1[1] * v1[1]) + (v1[2] * v1[2] + v1[3] * v1[3]);
                    u32x4 w; w.x = cvt_pk_bf16(v0[0], v0[1]); w.y = cvt_pk_bf16(v0[2], v0[3]); w.z = cvt_pk_bf16(v1[0], v1[1]); w.w = cvt_pk_bf16(v1[2], v1[3]);
                    *(u32x4*)(rowp + bj * HALF) = w; }
                ss += xsw<16>(ss); ss = xsum32(ss);
                if (fq == 0) part[(size_t)row * 64 + u.pn * 4 + wc] = ss; }
    }
};


__device__ __forceinline__ unsigned pk4_fp8(float a, float b, float c, float d) { int r = __builtin_amdgcn_cvt_pk_fp8_f32(a, b, 0, false); r = __builtin_amdgcn_cvt_pk_fp8_f32(c, d, r, true); return (unsigned)r; }
template <bool INT> struct EpiRelu2Fp8 {
    static constexpr bool PERM = true, AFTER_DRAIN = false;
    unsigned char* O; int ldc; const float* rs; const float* as; const float* wsc; float us;
    __device__ __forceinline__ void operator()(const f32x4 (&acc)[2][2][4][2], const Unit& u, int wr, int wc, int fr, int fq) const {
        asm volatile("" : "+v"(fr), "+v"(fq));
        const int row0 = u.pm * BM + wr * 64 + fr, col0 = u.pn * BM + wc * 32 + 8 * fq;
        const float winv = INT ? wsc[0] : 1.f;
#pragma unroll
        for (int ai = 0; ai < 2; ++ai)
#pragma unroll
            for (int m = 0; m < 4; ++m) { const int row = row0 + ai * HALF + m * 16; const float s = INT ? rs[row] * (as[row] * winv) : rs[row]; unsigned char* rowp = O + (size_t)row * ldc + col0;
#pragma unroll
                for (int bj = 0; bj < 2; ++bj) { f32x4 v0, v1;
#pragma unroll
                    for (int j = 0; j < 4; ++j) { const float x0 = INT ? (float)__float_as_int(acc[ai][bj][m][0][j]) : acc[ai][bj][m][0][j], x1 = INT ? (float)__float_as_int(acc[ai][bj][m][1][j]) : acc[ai][bj][m][1][j];
                        const float a = fmaxf(x0 * s, 0.f), b = fmaxf(x1 * s, 0.f); v0[j] = fminf(a * a * us, 448.f); v1[j] = fminf(b * b * us, 448.f); }
                    u32x2 w; w.x = pk4_fp8(v0[0], v0[1], v0[2], v0[3]); w.y = pk4_fp8(v1[0], v1[1], v1[2], v1[3]);
                    *(u32x2*)(rowp + bj * HALF) = w; } }
    }
};


struct EpiProjI8 {
    static constexpr bool PERM = true, AFTER_DRAIN = false;
    bf16_t* O; int ldc; const float* rs; const float* as; const float* wsc; PG8_LAS float* T; const float* qn; const float* kn; const float* rope; int seq;
    __device__ __forceinline__ void operator()(const f32x4 (&acc)[2][2][4][2], const Unit& u, int wr, int wc, int fr, int fq) const {
        asm volatile("" : "+v"(fr), "+v"(fq));
        const int row0 = u.pm * BM + wr * 64 + fr, col0 = u.pn * BM + wc * 32 + 8 * fq;
        const float winv = wsc[0];
        const bool bt = (u.pn >= 12 && u.pn <= 16);
        if (bt) {
#pragma unroll
            for (int ai = 0; ai < 2; ++ai)
#pragma unroll
                for (int m = 0; m < 4; ++m) { const int lr = ai * HALF + wr * 64 + m * 16 + fr; const float s = rs[row0 + ai * HALF + m * 16] * (as[row0 + ai * HALF + m * 16] * winv);
#pragma unroll
                    for (int bj = 0; bj < 2; ++bj) { float ss = 0.f;
#pragma unroll
                        for (int j = 0; j < 4; ++j) { const float a = (float)__float_as_int(acc[ai][bj][m][0][j]) * s, b = (float)__float_as_int(acc[ai][bj][m][1][j]) * s; ss += a * a + b * b; }
                        ss += xsw<16>(ss); ss = xsum32(ss);
                        if (fq == 0) T[(lr * 2 + bj) * 4 + wc] = ss; } }
            asm volatile("s_waitcnt lgkmcnt(0)" ::: "memory"); __builtin_amdgcn_s_barrier(); asm volatile("" ::: "memory");
        }
        const float* gn = (u.pn == 16) ? kn : qn; f32x4 g0 = {1.f, 1.f, 1.f, 1.f}, g1 = {1.f, 1.f, 1.f, 1.f};
        if (bt) { g0 = *(const f32x4*)(gn + wc * 32 + 8 * fq); g1 = *(const f32x4*)(gn + wc * 32 + 8 * fq + 4); }
#pragma unroll
        for (int ai = 0; ai < 2; ++ai)
#pragma unroll
            for (int m = 0; m < 4; ++m) { const int row = row0 + ai * HALF + m * 16; const float s = rs[row] * (as[row] * winv); bf16_t* rowp = O + (size_t)row * ldc + col0;
                f32x4 c0 = {1.f, 0.f, 1.f, 0.f}, c1 = {1.f, 0.f, 1.f, 0.f};
                if (bt) { const float* cs = rope + ((size_t)(row & (seq - 1)) * 64 + wc * 16 + fq * 4) * 2; c0 = *(const f32x4*)cs; c1 = *(const f32x4*)(cs + 4); }
#pragma unroll
                for (int bj = 0; bj < 2; ++bj) { f32x4 v0, v1;
#pragma unroll
                    for (int j = 0; j < 4; ++j) { v0[j] = (float)__float_as_int(acc[ai][bj][m][0][j]) * s; v1[j] = (float)__float_as_int(acc[ai][bj][m][1][j]) * s; }
                    if (bt) { const int lr = ai * HALF + wr * 64 + m * 16 + fr; const f32x4 t = *(const PG8_LAS f32x4*)(T + (lr * 2 + bj) * 4);
                        const float r = 1.0f / sqrtf(((t[0] + t[1]) + (t[2] + t[3])) * (1.0f / 128.0f) + 1e-6f);
                        v0 = v0 * r * g0; v1 = v1 * r * g1;
                        f32x4 w0, w1;
                        w0[0] = v0[0] * c0[0] - v0[1] * c0[1]; w0[1] = v0[0] * c0[1] + v0[1] * c0[0]; w0[2] = v0[2] * c0[2] - v0[3] * c0[3]; w0[3] = v0[2] * c0[3] + v0[3] * c0[2];
                        w1[0] = v1[0] * c1[0] - v1[1] * c1[1]; w1[1] = v1[0] * c1[1] + v1[1] * c1[0]; w1[2] = v1[2] * c1[2] - v1[3] * c1[3]; w1[3] = v1[2] * c1[3] + v1[3] * c1[2];
                        v0 = w0; v1 = w1; }
                    u32x4 w; w.x = cvt_pk_bf16(v0[0], v0[1]); w.y = cvt_pk_bf16(v0[2], v0[3]); w.z = cvt_pk_bf16(v1[0], v1[1]); w.w = cvt_pk_bf16(v1[2], v1[3]);
                    *(u32x4*)(rowp + bj * HALF) = w; } }
    }
};
template <class Epi, class Sched, bool ALIGN_EPI = false, bool SP2 = false, int DT = 0>
__device__ __forceinline__ void gemm_phase(PG8_LAS unsigned char* lds, const Gemm g, const Sched& S, const Epi& E, int tid_in) {
    int tid_o = tid_in; asm volatile("" : "+v"(tid_o));
    const int tid = tid_o, wid = __builtin_amdgcn_readfirstlane(tid >> 6), lane = tid & 63, wr = wid >> 2, wc = wid & 3, fr = lane & 15, fq = lane >> 4;
    const int K = g.K, nt = K / BK;
    unsigned voffA[2], voffB[2];
#pragma unroll
    for (int i = 0; i < 2; ++i) { int R, C; stage_rc(tid * 16 + i * 8192, R, C); const int Rb = Epi::PERM ? ((R & ~31) + perm32(R & 31)) : R;
        voffA[i] = (unsigned)(R * K + C) * 2u; voffB[i] = (unsigned)(Rb * K + C) * 2u; }
    const size_t kstep = (size_t)(BK * 2);
    const size_t hstep = (size_t)HALF * K * 2;
    const size_t tstep = 2 * hstep;
    const unsigned ldsw = (unsigned)wid * 1024u;
    const int aoff = lds_byte(wr * 64 + fr, fq * 8), boff = lds_byte(wc * 32 + fr, fq * 8);
    const PG8_LAS unsigned char* abase = lds + aoff; const PG8_LAS unsigned char* bbase = lds + 65536 + boff; asm volatile("" : "+v"(abase), "+v"(bbase));
#define PG8_SA(b, h) (((b) * 2 + (h)) * HTB)
#define PG8_SB(b, h) ((4 + (b) * 2 + (h)) * HTB)
#define PG8_STAGE(bufoff, gbase, voff) do { _Pragma("unroll") for (int _i = 0; _i < 2; ++_i) \
        __builtin_amdgcn_global_load_lds((const unsigned*)((const char*)(gbase) + (voff)[_i]), (PG8_LAS unsigned*)(lds + (bufoff) + ldsw + _i * 8192), 16, 0, 0); } while (0)
#define PG8_LDA(dst, b, h) do { _Pragma("unroll") for (int m = 0; m < 4; ++m) dst[m] = __builtin_shufflevector(*(const PG8_LAS i32x4*)(abase + (PG8_SA(b, h) + m * 2048)), *(const PG8_LAS i32x4*)(abase + (PG8_SA(b, h) + m * 2048 + 1024)), 0, 1, 2, 3, 4, 5, 6, 7); } while (0)
#define PG8_LDB(dst, b, h) do { _Pragma("unroll") for (int n = 0; n < 2; ++n) dst[n] = __builtin_shufflevector(*(const PG8_LAS i32x4*)(bbase + (PG8_SB(b, h) - 65536 + n * 2048)), *(const PG8_LAS i32x4*)(bbase + (PG8_SB(b, h) - 65536 + n * 2048 + 1024)), 0, 1, 2, 3, 4, 5, 6, 7); } while (0)
#define PG8_LO(x) __builtin_bit_cast(bf16x8, __builtin_shufflevector(x, x, 0, 1, 2, 3))
#define PG8_HI(x) __builtin_bit_cast(bf16x8, __builtin_shufflevector(x, x, 4, 5, 6, 7))
#define PG8_LOI(x) __builtin_shufflevector(x, x, 0, 1, 2, 3)
#define PG8_HII(x) __builtin_shufflevector(x, x, 4, 5, 6, 7)
#define PG8_MMA(ai, bj, At, Bt) do { __builtin_amdgcn_s_setprio(1); if constexpr (DT == 1) { _Pragma("unroll") for (int m = 0; m < 4; ++m) _Pragma("unroll") for (int n = 0; n < 2; ++n) \
        asm volatile("v_mfma_scale_f32_16x16x128_f8f6f4 %0, %1, %2, %0, %3, %3 op_sel_hi:[0,0,0]" : "+v"(acc[ai][bj][m][n]) : "v"(Bt[n]), "v"(At[m]), "v"(one_scale)); } \
    else if constexpr (DT == 2) { _Pragma("unroll") for (int m = 0; m < 4; ++m) _Pragma("unroll") for (int n = 0; n < 2; ++n) { \
        i32x4 c_ = __builtin_bit_cast(i32x4, acc[ai][bj][m][n]); c_ = __builtin_amdgcn_mfma_i32_16x16x64_i8(PG8_LOI(Bt[n]), PG8_LOI(At[m]), c_, 0, 0, 0); \
        c_ = __builtin_amdgcn_mfma_i32_16x16x64_i8(PG8_HII(Bt[n]), PG8_HII(At[m]), c_, 0, 0, 0); acc[ai][bj][m][n] = __builtin_bit_cast(f32x4, c_); } } \
    else { _Pragma("unroll") for (int m = 0; m < 4; ++m) _Pragma("unroll") for (int n = 0; n < 2; ++n) { \
        acc[ai][bj][m][n] = __builtin_amdgcn_mfma_f32_16x16x32_bf16(PG8_LO(Bt[n]), PG8_LO(At[m]), acc[ai][bj][m][n], 0, 0, 0); \
        acc[ai][bj][m][n] = __builtin_amdgcn_mfma_f32_16x16x32_bf16(PG8_HI(Bt[n]), PG8_HI(At[m]), acc[ai][bj][m][n], 0, 0, 0); } } __builtin_amdgcn_s_setprio(0); } while (0)
#define PG8_WAIT_V(n) asm volatile("s_waitcnt vmcnt(" #n ")" ::: "memory")
#define PG8_WAIT_L(n) asm volatile("s_waitcnt lgkmcnt(" #n ")" ::: "memory")
#define PG8_BAR __builtin_amdgcn_s_barrier()
#define PG8_SCHED __builtin_amdgcn_sched_barrier(0)
    Unit cur, nxt; int ui = 0;
    if (!S.next(0, cur)) return;
    int one_scale = 0x7F7F7F7F; asm volatile("" : "+v"(one_scale));
    f32x4 acc[2][2][4][2];
#pragma unroll
    for (int a = 0; a < 2; ++a)
#pragma unroll
        for (int b = 0; b < 2; ++b)
#pragma unroll
            for (int m = 0; m < 4; ++m)
#pragma unroll
                for (int n = 0; n < 2; ++n) acc[a][b][m][n] = (f32x4){0.f, 0.f, 0.f, 0.f};
    i32x8 At[4], B0[2], B1[2];
    const char* cA = (const char*)g.A + (size_t)cur.pm * tstep; const char* cB = (const char*)g.Bt + (size_t)cur.pn * tstep;
    S.a_ready(cur);
    if constexpr (SP2) {
        PG8_STAGE(PG8_SB(0, 0), cB, voffB); PG8_STAGE(PG8_SB(0, 1), cB + hstep, voffB); PG8_STAGE(PG8_SA(0, 0), cA, voffA); PG8_STAGE(PG8_SA(0, 1), cA + hstep, voffA);
        if (wr == 1) PG8_BAR;
        PG8_WAIT_V(2); PG8_BAR;
        PG8_STAGE(PG8_SB(1, 0), cB + kstep, voffB); PG8_STAGE(PG8_SA(1, 0), cA + kstep, voffA); PG8_STAGE(PG8_SB(1, 1), cB + hstep + kstep, voffB);
        PG8_WAIT_V(6); PG8_BAR;
    } else {
        PG8_STAGE(PG8_SB(0, 0), cB, voffB); PG8_STAGE(PG8_SA(0, 0), cA, voffA); PG8_STAGE(PG8_SB(0, 1), cB + hstep, voffB); PG8_STAGE(PG8_SA(0, 1), cA + hstep, voffA);
        if (wr == 1) PG8_BAR;
        PG8_WAIT_V(4); PG8_BAR;
        PG8_STAGE(PG8_SB(1, 0), cB + kstep, voffB); PG8_STAGE(PG8_SA(1, 0), cA + kstep, voffA); PG8_STAGE(PG8_SB(1, 1), cB + hstep + kstep, voffB);
        PG8_WAIT_V(6); PG8_BAR;
    }
    for (;;) {
        const bool has_next = S.next(ui + 1, nxt);
        const char* nA = has_next ? (const char*)g.A + (size_t)nxt.pm * tstep : cA; const char* nB = has_next ? (const char*)g.Bt + (size_t)nxt.pn * tstep : cB;
        for (int t = 0; t < nt; t += 2) {
            const bool last = (t == nt - 2);
            const char* a1 = cA + (size_t)(t + 1) * kstep;
            const char* a2 = last ? nA : cA + (size_t)(t + 2) * kstep; const char* b2 = last ? nB : cB + (size_t)(t + 2) * kstep;
            const char* a3 = a2 + kstep; const char* b3 = b2 + kstep;
            if (last && has_next) S.a_ready(nxt);
            if constexpr (SP2) {
            PG8_LDB(B0, 0, 0); PG8_LDB(B1, 0, 1); PG8_SCHED; PG8_LDA(At, 0, 0); PG8_STAGE(PG8_SA(1, 1), a1 + hstep, voffA);
            PG8_WAIT_V(8); PG8_WAIT_L(0); PG8_BAR; PG8_MMA(0, 0, At, B0); PG8_MMA(0, 1, At, B1); PG8_BAR; PG8_SCHED;
            PG8_LDA(At, 0, 1); PG8_STAGE(PG8_SB(0, 0), b2, voffB); PG8_STAGE(PG8_SB(0, 1), b2 + hstep, voffB); PG8_STAGE(PG8_SA(0, 0), a2, voffA);
            PG8_WAIT_V(8); PG8_WAIT_L(0); PG8_BAR; PG8_MMA(1, 0, At, B0); PG8_MMA(1, 1, At, B1); PG8_BAR; PG8_SCHED;
            PG8_LDB(B0, 1, 0); PG8_LDB(B1, 1, 1); PG8_SCHED; PG8_LDA(At, 1, 0); PG8_STAGE(PG8_SA(0, 1), a2 + hstep, voffA);
            PG8_WAIT_V(8); PG8_WAIT_L(0); PG8_BAR; PG8_MMA(0, 0, At, B0); PG8_MMA(0, 1, At, B1); PG8_BAR; PG8_SCHED;
            PG8_LDA(At, 1, 1); PG8_STAGE(PG8_SB(1, 0), b3, voffB); PG8_STAGE(PG8_SB(1, 1), b3 + hstep, voffB); PG8_STAGE(PG8_SA(1, 0), a3, voffA);
            PG8_WAIT_V(8); PG8_WAIT_L(0); PG8_BAR; PG8_MMA(1, 0, At, B0); PG8_MMA(1, 1, At, B1); PG8_BAR; PG8_SCHED;
            } else {
            PG8_LDB(B0, 0, 0); PG8_SCHED; PG8_LDA(At, 0, 0); PG8_STAGE(PG8_SA(1, 1), a1 + hstep, voffA);
            PG8_WAIT_L(8); PG8_BAR; PG8_WAIT_L(0); PG8_MMA(0, 0, At, B0); PG8_BAR; PG8_SCHED;
            PG8_LDB(B1, 0, 1); PG8_STAGE(PG8_SB(0, 0), b2, voffB);
            PG8_BAR; PG8_WAIT_L(0); PG8_MMA(0, 1, At, B1); PG8_BAR;
            PG8_LDA(At, 0, 1); PG8_STAGE(PG8_SA(0, 0), a2, voffA);
            PG8_BAR; PG8_WAIT_L(0); PG8_MMA(1, 0, At, B0); PG8_BAR; PG8_SCHED;
            PG8_STAGE(PG8_SB(0, 1), b2 + hstep, voffB);
            PG8_WAIT_V(6); PG8_BAR; PG8_MMA(1, 1, At, B1); PG8_BAR;
            PG8_LDB(B0, 1, 0); PG8_SCHED; PG8_LDA(At, 1, 0); PG8_STAGE(PG8_SA(0, 1), a2 + hstep, voffA);
            PG8_WAIT_L(8); PG8_BAR; PG8_WAIT_L(0); PG8_MMA(0, 0, At, B0); PG8_BAR; PG8_SCHED;
            PG8_LDB(B1, 1, 1); PG8_STAGE(PG8_SB(1, 0), b3, voffB);
            PG8_BAR; PG8_WAIT_L(0); PG8_MMA(0, 1, At, B1); PG8_BAR;
            PG8_LDA(At, 1, 1); PG8_STAGE(PG8_SA(1, 0), a3, voffA);
            PG8_BAR; PG8_WAIT_L(0); PG8_MMA(1, 0, At, B0); PG8_BAR; PG8_SCHED;
            PG8_STAGE(PG8_SB(1, 1), b3 + hstep, voffB);
            PG8_WAIT_V(6); PG8_BAR; PG8_MMA(1, 1, At, B1); PG8_BAR;
            }
        }
        if constexpr (DT == 1) asm volatile("s_nop 15\n\ts_nop 15" ::: "memory");
        if constexpr (ALIGN_EPI) { if (wr == 0) PG8_BAR; }
        if constexpr (!Epi::AFTER_DRAIN) { E(acc, cur, wr, wc, fr, fq); S.done(cur); }
        if (!has_next) break;
#pragma unroll
        for (int a = 0; a < 2; ++a)
#pragma unroll
            for (int b = 0; b < 2; ++b)
#pragma unroll
                for (int m = 0; m < 4; ++m)
#pragma unroll
                    for (int n = 0; n < 2; ++n) acc[a][b][m][n] = (f32x4){0.f, 0.f, 0.f, 0.f};
        cur = nxt; cA = nA; cB = nB; ++ui;
        if constexpr (ALIGN_EPI) { if (wr == 1) PG8_BAR; }
    }
    PG8_WAIT_V(0);
    if constexpr (!ALIGN_EPI) { if (wr == 0) PG8_BAR; }
    PG8_BAR;
    if constexpr (Epi::AFTER_DRAIN) { E.fused(acc, cur, wr, wc, fr, fq, lds, wid, lane); S.done(cur); }
#undef PG8_SA
#undef PG8_SB
#undef PG8_STAGE
#undef PG8_LO
#undef PG8_LOI
#undef PG8_HII
#undef PG8_HI
#undef PG8_LDA
#undef PG8_LDB
#undef PG8_MMA
#undef PG8_WAIT_V
#undef PG8_WAIT_L
#undef PG8_BAR
#undef PG8_SCHED
}
}

namespace att {
#define ALAS __attribute__((address_space(3)))
typedef unsigned short bf16;
using bf16x8 = __attribute__((ext_vector_type(8))) short;
using s16x4  = __attribute__((ext_vector_type(4))) short;
using f32x16 = __attribute__((ext_vector_type(16))) float;
using u32x4  = __attribute__((ext_vector_type(4))) unsigned;
typedef ALAS char* lptr;
constexpr int   D = 128, NW = 8, QBLK = 32, KVBLK = 64;
constexpr float SCALE = 0.088388347648318440f, INV_SCALE = 11.313708498984761f, LOG2E = 1.4426950408889634f;
constexpr float THR = 8.f;
constexpr float MASKV = -1e30f, MINIT = -1e10f;
constexpr int SHM_V = KVBLK * D * 2, SHM_K = KVBLK * D * 2;
constexpr int OFF_K = 2 * SHM_V, OFF_WS = 2 * SHM_V + 2 * SHM_K, OFF_TAB = OFF_WS + NW * 64 * 4, TAB_BYTES = 8192, OFF_STG = OFF_TAB + TAB_BYTES, ATT_LDS = OFF_STG + NW * 4096;
constexpr int TREL = 384;
enum { MODE_B = 0, MODE_C = 1, MODE_D = 2, MODE_A = 3 };
#define KSWZ(row, colB) ((row) * 256 + ((colB) ^ ((((row) & 7) | ((((row) >> 4) & 1) << 3)) << 4)))
#define SBAR() __builtin_amdgcn_sched_barrier(0)
__device__ __forceinline__ int crow(int r, int hi) { return (r & 3) + 8 * (r >> 2) + 4 * hi; }
__device__ __forceinline__ unsigned cvtpk(float lo, float hi) { unsigned r; asm volatile("v_cvt_pk_bf16_f32 %0, %1, %2" : "=v"(r) : "v"(lo), "v"(hi)); return r; }

__device__ __forceinline__ void partialSM(f32x16& p0, f32x16& p1, float& m_reg, float& mn, float& alpha) {
  constexpr float C = SCALE * LOG2E;
  float pmax = p0[0];
#pragma unroll
  for (int r = 1; r < 16; ++r) pmax = fmaxf(pmax, p0[r]);
#pragma unroll
  for (int r = 0; r < 16; ++r) pmax = fmaxf(pmax, p1[r]);
  { auto rr = __builtin_amdgcn_permlane32_swap(__float_as_uint(pmax), __float_as_uint(pmax), false, false);
    pmax = fmaxf(__uint_as_float(rr[0]), __uint_as_float(rr[1])); }
  if (__builtin_expect(__all(pmax - m_reg <= THR / SCALE), 1)) { mn = m_reg; alpha = 1.f; }
  else { mn = fmaxf(m_reg, pmax); alpha = __builtin_amdgcn_exp2f((m_reg - mn) * C); m_reg = mn; }
  float mnC = -mn * C;
#pragma unroll
  for (int r = 0; r < 16; ++r) p0[r] = fmaf(p0[r], C, mnC);
#pragma unroll
  for (int r = 0; r < 16; ++r) p1[r] = fmaf(p1[r], C, mnC);
#pragma unroll
  for (int r = 0; r < 16; ++r) p0[r] = __builtin_amdgcn_exp2f(p0[r]);
}
__device__ __forceinline__ void finishSM(f32x16& p0, f32x16& p1, float alpha, float& l_reg, bf16x8& pa0, bf16x8& pa1, bf16x8& pa2, bf16x8& pa3) {
#pragma unroll
  for (int r = 0; r < 16; ++r) p1[r] = __builtin_amdgcn_exp2f(p1[r]);
  float ps = 0;
#pragma unroll
  for (int r = 0; r < 16; ++r) ps += p0[r];
#pragma unroll
  for (int r = 0; r < 16; ++r) ps += p1[r];
  { auto rr = __builtin_amdgcn_permlane32_swap(__float_as_uint(ps), __float_as_uint(ps), false, false);
    ps = __uint_as_float(rr[0]) + __uint_as_float(rr[1]); }
  l_reg = l_reg * alpha + ps;
#define PK4(P, BASE, OUT) do { unsigned a0 = cvtpk(P[BASE + 0], P[BASE + 1]), a1 = cvtpk(P[BASE + 2], P[BASE + 3]);   \
    unsigned b0 = cvtpk(P[BASE + 4], P[BASE + 5]), b1 = cvtpk(P[BASE + 6], P[BASE + 7]);                              \
    auto r0 = __builtin_amdgcn_permlane32_swap(a0, b0, false, false); auto r1 = __builtin_amdgcn_permlane32_swap(a1, b1, false, false); \
    u32x4 w = {r0[0], r1[0], r0[1], r1[1]}; OUT = __builtin_bit_cast(bf16x8, w); } while (0)
  PK4(p0, 0, pa0); PK4(p0, 8, pa1); PK4(p1, 0, pa2); PK4(p1, 8, pa3);
#undef PK4
}
__device__ __forceinline__ void qkt(f32x16& p0, f32x16& p1, lptr Ks, const bf16x8* qr, int r32, int hi) {
#pragma unroll
  for (int d0 = 0; d0 < 8; ++d0) { int cb = (d0 * 16 + hi * 8) * 2;
    bf16x8 b0 = *(const ALAS bf16x8*)(Ks + KSWZ(r32, cb));
    bf16x8 b1 = *(const ALAS bf16x8*)(Ks + KSWZ(32 + r32, cb));
    p0 = __builtin_amdgcn_mfma_f32_32x32x16_bf16(b0, qr[d0], p0, 0, 0, 0);
    p1 = __builtin_amdgcn_mfma_f32_32x32x16_bf16(b1, qr[d0], p1, 0, 0, 0); }
}
__device__ __forceinline__ int v_st(int k, int c) { const int kk = (k & ~0xC) | ((k & 4) << 1) | ((k & 8) >> 1); return ((kk >> 3) * 4 + (c >> 5)) * 512 + ((kk & 7) * 32 + (c & 31)) * 2; }
__device__ __forceinline__ int v_rd_base(int lane) { return ((lane & 3) << 3) | (((lane >> 2) & 3) << 6) | (((lane >> 4) & 1) << 5) | (((lane >> 5) & 1) << 8); }
constexpr int v_rd_off(int d0, int ks, int half) { return d0 * 512 + ks * 4096 + half * 2048; }
template <int OFF> __device__ __forceinline__ s16x4 tr_read(int vb) {
  s16x4 r; asm volatile("ds_read_b64_tr_b16 %0, %1 offset:%2" : "=&v"(r) : "v"(vb), "i"(OFF) : "memory"); return r;
}
template <int D0> __device__ __forceinline__ void pv_one(f32x16& od, int vb, bf16x8 pa0, bf16x8 pa1, bf16x8 pa2, bf16x8 pa3) {
  const s16x4 l0 = tr_read<v_rd_off(D0, 0, 0)>(vb), h0 = tr_read<v_rd_off(D0, 0, 1)>(vb), l1 = tr_read<v_rd_off(D0, 1, 0)>(vb), h1 = tr_read<v_rd_off(D0, 1, 1)>(vb);
  const s16x4 l2 = tr_read<v_rd_off(D0, 2, 0)>(vb), h2 = tr_read<v_rd_off(D0, 2, 1)>(vb), l3 = tr_read<v_rd_off(D0, 3, 0)>(vb), h3 = tr_read<v_rd_off(D0, 3, 1)>(vb);
  asm volatile("s_waitcnt lgkmcnt(0)" ::: "memory"); SBAR();
#define PK(L, H) (bf16x8){L[0], L[1], L[2], L[3], H[0], H[1], H[2], H[3]}
  od = __builtin_amdgcn_mfma_f32_32x32x16_bf16(pa0, PK(l0, h0), od, 0, 0, 0);
  od = __builtin_amdgcn_mfma_f32_32x32x16_bf16(pa1, PK(l1, h1), od, 0, 0, 0);
  od = __builtin_amdgcn_mfma_f32_32x32x16_bf16(pa2, PK(l2, h2), od, 0, 0, 0);
  od = __builtin_amdgcn_mfma_f32_32x32x16_bf16(pa3, PK(l3, h3), od, 0, 0, 0);
#undef PK
}
__device__ __forceinline__ void pv_d0(f32x16* o, int vb, bf16x8 pa0, bf16x8 pa1, bf16x8 pa2, bf16x8 pa3) {
  pv_one<0>(o[0], vb, pa0, pa1, pa2, pa3); pv_one<1>(o[1], vb, pa0, pa1, pa2, pa3); pv_one<2>(o[2], vb, pa0, pa1, pa2, pa3); pv_one<3>(o[3], vb, pa0, pa1, pa2, pa3);
}

typedef short v4i16_t __attribute__((ext_vector_type(4)));
#define PIN(x) asm volatile("" : "+v"(x))
#define MF(a, b, c) __builtin_amdgcn_mfma_f32_32x32x16_bf16(a, b, c, 0, 0, 0)
#define EX2(x) __builtin_amdgcn_exp2f(x)
#define MX3(a, b, c) __builtin_fmaxf(__builtin_fmaxf((a), (b)), (c))
__device__ __forceinline__ unsigned cvtpk_s(float lo, float hi) { unsigned r; asm("v_cvt_pk_bf16_f32 %0, %1, %2" : "=v"(r) : "v"(lo), "v"(hi)); return r; }
#define KRD2(Ks, D0, K0, K1) do { const int cb_ = ((D0) * 16 + hi * 8) * 2; K0 = *(const ALAS bf16x8*)((Ks) + KSWZ(r32, cb_)); K1 = *(const ALAS bf16x8*)((Ks) + KSWZ(32 + r32, cb_)); } while (0)
#define VTR(vp, OFF) __builtin_bit_cast(s16x4, __builtin_amdgcn_ds_read_tr16_b64_v4i16((ALAS v4i16_t*)((vp) + (OFF))))
#define PKV(L, H) (bf16x8){L[0], L[1], L[2], L[3], H[0], H[1], H[2], H[3]}
#define VRDG(vp, GI, L0, H0, L1, H1) do { L0 = VTR(vp, v_rd_off(2 * ((GI) >> 2), (GI) & 3, 0)); H0 = VTR(vp, v_rd_off(2 * ((GI) >> 2), (GI) & 3, 1)); \
    L1 = VTR(vp, v_rd_off(2 * ((GI) >> 2) + 1, (GI) & 3, 0)); H1 = VTR(vp, v_rd_off(2 * ((GI) >> 2) + 1, (GI) & 3, 1)); } while (0)
#define SWP(a, b, r) auto r = __builtin_amdgcn_permlane32_swap(a, b, false, false)

__device__ __forceinline__ void bias_init(f32x16& p0, f32x16& p1, int mode, int k0, int qw, int r32, int hi, const ALAS float* tab) {
  if (mode == MODE_B) { p0 = f32x16{}; p1 = f32x16{}; return; }
  if (mode == MODE_A) {
    const int kr = k0 >> 6, rq = qw >> 6, rs = min(max(rq - 4, 0), 24);
    if (kr < rs || kr >= rs + 8) {
#pragma unroll
      for (int r = 0; r < 16; ++r) { p0[r] = MASKV; p1[r] = MASKV; } }
    else { const int cq = (qw & 63) + r32, cs = min(max(cq - 8, 0), 48), d = 4 * hi - cs; const ALAS float* rt = tab + ((kr - rq + 7) * 128 + 48 + 15 + 4 * hi - cq); asm volatile("" : "+v"(rt));
#pragma unroll
      for (int r = 0; r < 16; ++r) { const int c0 = (r & 3) + 8 * (r >> 2), c1 = c0 + 32; const bool ok0 = (unsigned)(c0 + d) < 16u, ok1 = (unsigned)(c1 + d) < 16u;
        const float t0 = rt[c0], t1 = rt[c1]; p0[r] = ok0 ? t0 : MASKV; p1[r] = ok1 ? t1 : MASKV; if ((r & 3) == 3) asm volatile("" ::: "memory"); } }
  } else {
    const int dq = k0 - qw;
    if (mode == MODE_D && (dq >= 128 || dq <= -160)) { const float c = tab[dq > 0 ? TREL + 300 : TREL - 300];
#pragma unroll
      for (int r = 0; r < 16; ++r) { p0[r] = c; p1[r] = c; } }
    else { const ALAS float* tl = tab + (dq + 4 * hi - r32 + TREL); asm volatile("" : "+v"(tl));
#pragma unroll
      for (int r = 0; r < 16; ++r) { const int c0 = (r & 3) + 8 * (r >> 2); p0[r] = tl[c0]; p1[r] = tl[c0 + 32]; if ((r & 3) == 3) asm volatile("" ::: "memory"); } }
  }
}

template <int LD, class FillFn>
__device__ __forceinline__ void attn_unit(const bf16* __restrict__ Qb, const bf16* __restrict__ Kh, int vdelta, int nkeys,
                                          int mode, int kbeg, int qbase, const ALAS float* tab, float sink, void* __restrict__ Op, lptr lds, int tid_in, const FillFn& fill) {
  int tid_o = tid_in; asm volatile("" : "+v"(tid_o));
  const int tid = tid_o, wid = __builtin_amdgcn_readfirstlane(tid >> 6), lane = tid & 63, r32 = lane & 31, hi = lane >> 5;
  lptr V_lds = lds; lptr K_lds = lds + OFF_K;
  ALAS float* ws = (ALAS float*)(lds + OFF_WS) + wid * 64; ALAS float* li_l = ws; ALAS float* al_l = ws + 32;
  float m_reg = MINIT, l_reg = 0; f32x16 o[4] = {}; bf16x8 qr[8];
  const bf16* Qw = Qb + (unsigned)((wid * QBLK + r32) * LD + hi * 8);
#pragma unroll
  for (int d0 = 0; d0 < 8; ++d0) qr[d0] = *(const bf16x8*)(Qw + d0 * 16);
  const int sr = tid >> 4, sc = (tid & 15) * 8; const unsigned vo = (unsigned)(sr * LD + sc); const int vst0 = v_st(sr, sc), vst1 = v_st(32 + sr, sc);
  const int vb0 = (int)(unsigned)(size_t)V_lds + v_rd_base(lane);
  const int qw = qbase + wid * QBLK;
  struct { bf16x8 vs0, vs1, ks0, ks1; } sr_[2];
#define SLOAD(i, k0) do { const bf16* Kt = Kh + (size_t)(k0) * LD; const bf16* Vt = Kt + vdelta; \
    sr_[i].vs0 = *(const bf16x8*)(Vt + vo); sr_[i].vs1 = *(const bf16x8*)(Vt + 32 * LD + vo); \
    sr_[i].ks0 = *(const bf16x8*)(Kt + vo); sr_[i].ks1 = *(const bf16x8*)(Kt + 32 * LD + vo); } while (0)
#define SWRITE_K(b, i) do { int kc = sc * 2; *(ALAS bf16x8*)(K_lds + (b) * SHM_K + KSWZ(sr, kc)) = sr_[i].ks0; *(ALAS bf16x8*)(K_lds + (b) * SHM_K + KSWZ(32 + sr, kc)) = sr_[i].ks1; } while (0)
#define SWRITE_V(b, i) do { *(ALAS bf16x8*)(V_lds + (b) * SHM_V + vst0) = sr_[i].vs0; *(ALAS bf16x8*)(V_lds + (b) * SHM_V + vst1) = sr_[i].vs1; } while (0)
#define SWAIT() asm volatile("s_waitcnt vmcnt(4)" ::: "memory")
#define RESC(a) do { if (__any((a) < 1.f)) { if (hi == 0) al_l[r32] = (a); asm volatile("s_waitcnt lgkmcnt(0)" ::: "memory"); \
    _Pragma("unroll") for (int d = 0; d < 4; ++d) _Pragma("unroll") for (int r = 0; r < 16; ++r) o[d][r] *= al_l[crow(r, hi)]; } } while (0)
  f32x16 pA0, pA1, pB0, pB1; float mnA, mnB, alA, alB; bf16x8 pa0, pa1, pa2, pa3; const int NT = nkeys / KVBLK;
  constexpr int SE = 0, SO = 1;
  SLOAD(SE, 0); fill(); asm volatile("s_waitcnt vmcnt(0)" ::: "memory"); SWRITE_K(0, SE); SWRITE_V(0, SE);
  SLOAD(SO, KVBLK); if (2 < NT) SLOAD(SE, 2 * KVBLK);
  __syncthreads();
  bias_init(pA0, pA1, mode, kbeg, qw, r32, hi, tab); qkt(pA0, pA1, K_lds, qr, r32, hi); partialSM(pA0, pA1, m_reg, mnA, alA);
  SWAIT(); SWRITE_K(1, SO); __syncthreads();
  constexpr float C = SCALE * LOG2E;
  lptr vbp = V_lds + v_rd_base(lane);
  bf16x8 kA0, kA1, kB0, kB1; s16x4 vAl0, vAh0, vAl1, vAh1, vBl0, vBh0, vBl1, vBh1; float ps; unsigned ca0, ca1, cb0, cb1;
#define GA(C0, C1, Ks, D0, KC0, KC1, KN0, KN1, FILL) do { if ((D0) < 7) KRD2(Ks, ((D0) + 1) & 7, KN0, KN1); \
    C0 = MF(KC0, qr[D0], C0); C1 = MF(KC1, qr[D0], C1); FILL; SBAR(); } while (0)
#define E3(P, i) do { P[i] = EX2(P[i]); P[(i) + 1] = EX2(P[(i) + 1]); P[(i) + 2] = EX2(P[(i) + 2]); } while (0)
#define E2(P, i) do { P[i] = EX2(P[i]); P[(i) + 1] = EX2(P[(i) + 1]); } while (0)
#define S4(P, i) do { ps += P[i]; ps += P[(i) + 1]; ps += P[(i) + 2]; ps += P[(i) + 3]; } while (0)
#define CA(P, i) do { ca0 = cvtpk_s(P[i], P[(i) + 1]); ca1 = cvtpk_s(P[(i) + 2], P[(i) + 3]); } while (0)
#define CB(P, i, OUT) do { cb0 = cvtpk_s(P[i], P[(i) + 1]); cb1 = cvtpk_s(P[(i) + 2], P[(i) + 3]); SWP(ca0, cb0, r0_); SWP(ca1, cb1, r1_); \
    u32x4 w_ = {r0_[0], r1_[0], r0_[1], r1_[1]}; OUT = __builtin_bit_cast(bf16x8, w_); PIN(OUT); } while (0)
#define GB(vp, GI, CL0, CH0, CL1, CH1, NL0, NH0, NL1, NH1, PAK, FILL) do { if ((GI) < 7) VRDG(vp, ((GI) + 1) & 7, NL0, NH0, NL1, NH1); \
    o[2 * ((GI) >> 2)] = MF(PAK, PKV(CL0, CH0), o[2 * ((GI) >> 2)]); o[2 * ((GI) >> 2) + 1] = MF(PAK, PKV(CL1, CH1), o[2 * ((GI) >> 2) + 1]); FILL; SBAR(); } while (0)
#define FE(C0, C1, i) do { C0[i] = EX2(__builtin_fmaf(C0[i], C, mnC_)); C1[i] = __builtin_fmaf(C1[i], C, mnC_); } while (0)
#define FE3(C0, C1, i) do { FE(C0, C1, i); FE(C0, C1, (i) + 1); FE(C0, C1, (i) + 2); PIN(C0); PIN(C1); } while (0)
#define FE2(C0, C1, i) do { FE(C0, C1, i); FE(C0, C1, (i) + 1); PIN(C0); PIN(C1); } while (0)
#define STEP(C0, C1, ALC, P0, P1, ALP, T, KB_, DOLOAD, DOWK) do { \
    lptr Ks_ = K_lds + (KB_) * SHM_K; lptr vp_ = vbp + (1 - (KB_)) * SHM_V; \
    KRD2(Ks_, 0, kA0, kA1); \
    SWRITE_V(KB_, KB_); SBAR(); \
    bias_init(C0, C1, mode, kbeg + (T) * KVBLK, qw, r32, hi, tab); SBAR(); \
    GA(C0, C1, Ks_, 0, kA0, kA1, kB0, kB1, E3(P1, 0); ps = P0[0] + P0[1]; ps += P0[2]; ps += P0[3]; CA(P0, 0); PIN(P1); PIN(ps); PIN(ca0); PIN(ca1)); \
    GA(C0, C1, Ks_, 1, kB0, kB1, kA0, kA1, E3(P1, 3); S4(P0, 4); CB(P0, 4, pa0); PIN(P1); PIN(ps)); \
    GA(C0, C1, Ks_, 2, kA0, kA1, kB0, kB1, E3(P1, 6); S4(P0, 8); CA(P0, 8); PIN(P1); PIN(ps); PIN(ca0); PIN(ca1)); \
    GA(C0, C1, Ks_, 3, kB0, kB1, kA0, kA1, E3(P1, 9); S4(P0, 12); CB(P0, 12, pa1); PIN(P1); PIN(ps)); \
    GA(C0, C1, Ks_, 4, kA0, kA1, kB0, kB1, E2(P1, 12); S4(P1, 0); CA(P1, 0); PIN(P1); PIN(ps); PIN(ca0); PIN(ca1)); \
    GA(C0, C1, Ks_, 5, kB0, kB1, kA0, kA1, E2(P1, 14); S4(P1, 4); CB(P1, 4, pa2); PIN(P1); PIN(ps)); \
    GA(C0, C1, Ks_, 6, kA0, kA1, kB0, kB1, S4(P1, 8); CA(P1, 8); PIN(ps); PIN(ca0); PIN(ca1)); \
    GA(C0, C1, Ks_, 7, kB0, kB1, kA0, kA1, VRDG(vp_, 0, vAl0, vAh0, vAl1, vAh1); S4(P1, 12); CB(P1, 12, pa3); \
       { SWP(__float_as_uint(ps), __float_as_uint(ps), rr_); ps = __uint_as_float(rr_[0]) + __uint_as_float(rr_[1]); } l_reg = l_reg * (ALP) + ps; PIN(l_reg)); \
    if (DOLOAD) SLOAD(KB_, ((T) + 2) * KVBLK); \
    float mxa_, mxb_, mnC_; \
    GB(vp_, 0, vAl0, vAh0, vAl1, vAh1, vBl0, vBh0, vBl1, vBh1, pa0, \
       mxa_ = MX3(C0[0], C0[1], C1[0]); mxb_ = MX3(C0[2], C0[3], C1[1]); mxa_ = MX3(mxa_, C1[2], C1[3]); mxa_ = MX3(mxa_, C0[4], C0[5]); mxb_ = MX3(mxb_, C0[6], C0[7]); \
       mxa_ = MX3(mxa_, C1[4], C1[5]); mxb_ = MX3(mxb_, C1[6], C1[7]); PIN(mxa_); PIN(mxb_)); \
    GB(vp_, 1, vBl0, vBh0, vBl1, vBh1, vAl0, vAh0, vAl1, vAh1, pa1, \
       mxa_ = MX3(mxa_, C0[8], C0[9]); mxb_ = MX3(mxb_, C0[10], C0[11]); mxa_ = MX3(mxa_, C1[8], C1[9]); mxb_ = MX3(mxb_, C1[10], C1[11]); \
       mxa_ = MX3(mxa_, C0[12], C0[13]); mxb_ = MX3(mxb_, C0[14], C0[15]); mxa_ = MX3(mxa_, C1[12], C1[13]); mxb_ = MX3(mxb_, C1[14], C1[15]); \
       { float pm_ = __builtin_fmaxf(mxa_, mxb_); SWP(__float_as_uint(pm_), __float_as_uint(pm_), rr_); pm_ = __builtin_fmaxf(__uint_as_float(rr_[0]), __uint_as_float(rr_[1])); float mn_; \
         if (__builtin_expect(__all(pm_ - m_reg <= THR / SCALE), 1)) { mn_ = m_reg; ALC = 1.f; } \
         else { mn_ = __builtin_fmaxf(m_reg, pm_); ALC = EX2((m_reg - mn_) * C); m_reg = mn_; } \
         mnC_ = -mn_ * C; } PIN(mnC_); PIN(ALC)); \
    GB(vp_, 2, vAl0, vAh0, vAl1, vAh1, vBl0, vBh0, vBl1, vBh1, pa2, FE3(C0, C1, 0)); \
    GB(vp_, 3, vBl0, vBh0, vBl1, vBh1, vAl0, vAh0, vAl1, vAh1, pa3, FE3(C0, C1, 3)); \
    GB(vp_, 4, vAl0, vAh0, vAl1, vAh1, vBl0, vBh0, vBl1, vBh1, pa0, FE3(C0, C1, 6)); \
    GB(vp_, 5, vBl0, vBh0, vBl1, vBh1, vAl0, vAh0, vAl1, vAh1, pa1, FE3(C0, C1, 9)); \
    GB(vp_, 6, vAl0, vAh0, vAl1, vAh1, vBl0, vBh0, vBl1, vBh1, pa2, FE2(C0, C1, 12)); \
    GB(vp_, 7, vBl0, vBh0, vBl1, vBh1, vAl0, vAh0, vAl1, vAh1, pa3, FE2(C0, C1, 14)); \
    if (DOWK) { SWAIT(); SWRITE_K(1 - (KB_), 1 - (KB_)); } \
    RESC(ALC); __syncthreads(); } while (0)
  for (int j = 1; j + 1 < NT; j += 2) {
    STEP(pB0, pB1, alB, pA0, pA1, alA, j, 1, true, true);
    STEP(pA0, pA1, alA, pB0, pB1, alB, j + 1, 0, (j + 3 < NT), true);
  }
  STEP(pB0, pB1, alB, pA0, pA1, alA, NT - 1, 1, false, false);
  finishSM(pB0, pB1, alB, l_reg, pa0, pa1, pa2, pa3); SBAR();
  pv_d0(o, vb0 + SHM_V, pa0, pa1, pa2, pa3);
  __syncthreads();
  if (mode == MODE_C) { float sk = sink; asm volatile("" : "+s"(sk)); l_reg += __builtin_amdgcn_exp2f(sk * LOG2E - m_reg * (SCALE * LOG2E)); }
  if (hi == 0) li_l[r32] = l_reg; asm volatile("s_waitcnt lgkmcnt(0)" ::: "memory");
  float rli[16];
#pragma unroll
  for (int r = 0; r < 16; ++r) rli[r] = __builtin_amdgcn_rcpf(li_l[crow(r, hi)]);
  { lptr stg = lds + OFF_STG + wid * 4096; const int psh = (mode == MODE_D) ? 10 : 12;
    bf16* Ob = (bf16*)Op + ((unsigned)(wid * QBLK) << psh);
#pragma unroll
    for (int p = 0; p < 2; ++p) {
#pragma unroll
      for (int r = 0; r < 16; ++r) { const unsigned w = cvtpk(o[2 * p][r] * rli[r], o[2 * p + 1][r] * rli[r]); ALAS unsigned short* sp = (ALAS unsigned short*)(stg + crow(r, hi) * 128 + r32 * 2);
        sp[0] = (unsigned short)w; sp[32] = (unsigned short)(w >> 16); }
      asm volatile("s_waitcnt lgkmcnt(0)" ::: "memory");
#pragma unroll
      for (int i = 0; i < 4; ++i) { const int row = i * 8 + (lane >> 3), ch = lane & 7; const u32x4 v = *(const ALAS u32x4*)(stg + row * 128 + ch * 16);
        st_wt16(Ob + (((unsigned)row << psh) + p * 64 + ch * 8), v); }
      asm volatile("s_waitcnt lgkmcnt(0)" ::: "memory"); } }
#undef SLOAD
#undef SWRITE_K
#undef SWRITE_V
#undef SWAIT
#undef RESC
}
}

constexpr int NWAVES = 8;
constexpr int BATCH = 4, SEQ = 2048, DM = 4096, DIN = 9216, DFF = 16384, MTOK = BATCH * SEQ, DEPTH = 2;
constexpr float EPS = 1e-6f;
constexpr float U_SCALE = 8.0f, WMO_SCALE = 2048.0f;
constexpr int C_AQ = 0, C_AK = 1024, C_AV = 2048, C_BQ = 3072, C_BK = 4096, C_BV = 4352, C_CQ = 4608, C_CK = 5632, C_CV = 5888, C_DQ = 6144, C_DK = 7168, C_DV = 8192;
constexpr size_t MiB = 1u << 20;
constexpr size_t WS_CTL = 0, CTL_ZERO_BYTES = 1 * MiB;
constexpr size_t WS_RS = 1 * MiB;
constexpr size_t WS_ROPE = 2 * MiB;
constexpr size_t WS_PART = 4 * MiB;
constexpr size_t WS_W = 8 * MiB;
constexpr size_t W_IN_B = (size_t)DIN * DM * 2, W_OUT_B = (size_t)DM * DM * 2, W_MI_B = (size_t)DFF * DM * 2, W_MO_B = (size_t)DM * DFF * 2, W_LAYER_B = W_IN_B + W_OUT_B + W_MI_B + W_MO_B;
constexpr size_t WS_XB = WS_W + DEPTH * W_LAYER_B;
constexpr size_t WS_PROJ = WS_XB + (size_t)MTOK * DM * 2;
constexpr size_t WS_MIX = WS_PROJ + (size_t)MTOK * DIN * 2;
constexpr size_t WS_Y = WS_MIX + (size_t)MTOK * DM * 2;
constexpr size_t WS_U = WS_Y + (size_t)MTOK * DM * 2;
constexpr size_t WS_DT = WS_U + (size_t)MTOK * DFF * 2;
constexpr size_t WS_XQ = WS_DT + (size_t)2 * MTOK * 1024 * 4;
constexpr size_t WS_END = WS_XQ + (size_t)MTOK * DM;
constexpr size_t WS_AS = WS_RS + 65536;
constexpr size_t WS_MAS = WS_RS + 196608;
constexpr size_t WS_WQS = WS_RS + 131072;
constexpr int CW_BAR = 4096;
constexpr int RING_BYTES = 131072, LDSCTL_OFF = RING_BYTES, MISC_OFF = LDSCTL_OFF + 320, LDS_BYTES = 147456;
static_assert(att::ATT_LDS <= RING_BYTES, "attention LDS fits the ring region");

#define GAS __attribute__((address_space(1)))
#define LAS __attribute__((address_space(3)))
typedef unsigned short bf16;
typedef unsigned v4u __attribute__((ext_vector_type(4)));
typedef unsigned v2u __attribute__((ext_vector_type(2)));
typedef float f32x4 __attribute__((ext_vector_type(4)));
typedef GAS unsigned gu32;
#define RLX_AGENT __ATOMIC_RELAXED, __HIP_MEMORY_SCOPE_AGENT
#define LDS_WAIT() asm volatile("s_waitcnt lgkmcnt(0)" ::: "memory")
__device__ __forceinline__ unsigned pk2(float lo, float hi) { return pg8::cvt_pk_bf16(lo, hi); }
__device__ __forceinline__ float bf_lo(unsigned w) { return __uint_as_float(w << 16); }
__device__ __forceinline__ float bf_hi(unsigned w) { return __uint_as_float(w & 0xffff0000u); }
__device__ __forceinline__ float wave_sum(float v) {
    v += xsw<1>(v); v += xsw<2>(v); v += xsw<4>(v); v += xsw<8>(v); v += xsw<16>(v);
    return xsum32(v);
}

__device__ __forceinline__ int lane_id() { int l; asm volatile("v_mbcnt_lo_u32_b32 %0, -1, 0\n\tv_mbcnt_hi_u32_b32 %0, -1, %0" : "=v"(l)); return l; }
#define XB_TMO      128
#define XB_XCNT(j)  (256  + 64 * (j))
#define XB_XSUB(j)  (1280 + 64 * (j))
#define XB_XGEN(j)  (2304 + 64 * (j))
#define XB_TOP      3328
#define XB_TOPGEN   3392
#define XCD_BAR_WORDS 3456
#define XB_SPIN_CAP (1u << 18)

__device__ __forceinline__ unsigned xb_ld(unsigned* p)              { return __hip_atomic_load(p, __ATOMIC_RELAXED, __HIP_MEMORY_SCOPE_AGENT); }
__device__ __forceinline__ unsigned xb_add(unsigned* p, unsigned v) { return __hip_atomic_fetch_add(p, v, __ATOMIC_RELAXED, __HIP_MEMORY_SCOPE_AGENT); }
__device__ __forceinline__ unsigned xb_xcc_id() { return (unsigned)__builtin_amdgcn_s_getreg((3 << 11) | 20) & 0xFu; }
#define XB_SPIN(cond, bar) do { unsigned _sp = 0; while (cond) { __builtin_amdgcn_s_sleep(1); \
    if ((++_sp & 255u) == 0u) { if (xb_ld(&(bar)[XB_TMO])) break; if (_sp > XB_SPIN_CAP) { atomicAdd(&(bar)[XB_TMO], 1u); break; } } } } while (0)

struct XcdBarrier {
    unsigned* bar; unsigned x; int w0;
    volatile LAS unsigned* st;
};

__device__ __forceinline__ XcdBarrier xcd_barrier_post(unsigned* bar, volatile LAS unsigned* st) {
    XcdBarrier b; b.bar = bar; b.x = xb_xcc_id(); b.st = st; b.w0 = __builtin_amdgcn_readfirstlane((int)threadIdx.x >> 6);
    if (threadIdx.x == 0) (void)xb_add(&bar[XB_XCNT(b.x)], 1u);
    return b;
}
__device__ __forceinline__ void xcd_barrier_complete(unsigned* bar, unsigned x, unsigned& nloc, unsigned& nx) {
    const unsigned G = gridDim.x * gridDim.y * gridDim.z;
    unsigned sum, cnt, mine, sp = 0u;
    for (;;) {
        sum = 0u; cnt = 0u; mine = 0u;
#pragma unroll
        for (unsigned j = 0; j < 16; ++j) { const unsigned c = xb_ld(&bar[XB_XCNT(j)]); sum += c; cnt += (c > 0u) ? 1u : 0u; mine = (j == x) ? c : mine; }
        if (sum == G) break;
        __builtin_amdgcn_s_sleep(1);
        if ((++sp & 255u) == 0u) { if (xb_ld(&bar[XB_TMO])) break; if (sp > XB_SPIN_CAP) { atomicAdd(&bar[XB_TMO], 1u); break; } }
    }
    nloc = mine > 0u ? mine : 1u; nx = cnt > 0u ? cnt : 1u;
}

__device__ __forceinline__ void xcd_barrier(const XcdBarrier& b) {
    asm volatile("s_waitcnt vmcnt(0)" ::: "memory");
    __syncthreads();
    if (b.w0 == 0 && lane_id() == 0) {
        unsigned* bar = b.bar;
        __builtin_amdgcn_s_waitcnt(0);
        unsigned nloc = b.st[0], nx = b.st[1];
        if (nloc == 0u) { xcd_barrier_complete(bar, b.x, nloc, nx); b.st[0] = nloc; b.st[1] = nx; }
        const unsigned old = xb_add(&bar[XB_XSUB(b.x)], 1u);
        const unsigned gen = old / nloc;
        if (old + 1u == (gen + 1u) * nloc) {
            __builtin_amdgcn_fence(__ATOMIC_RELEASE, "agent");
            asm volatile("s_waitcnt vmcnt(0)" ::: "memory");
            const unsigned og = xb_add(&bar[XB_TOP], 1u);
            const unsigned tg = og / nx;
            if (og + 1u == (tg + 1u) * nx) xb_add(&bar[XB_TOPGEN], 1u);
            else XB_SPIN(xb_ld(&bar[XB_TOPGEN]) == tg, bar);
            __builtin_amdgcn_fence(__ATOMIC_ACQUIRE, "agent");
            xb_add(&bar[XB_XGEN(b.x)], 1u);
            asm volatile("s_waitcnt vmcnt(0)" ::: "memory");
        } else {
            XB_SPIN(xb_ld(&bar[XB_XGEN(b.x)]) == gen, bar);
            __builtin_amdgcn_fence(__ATOMIC_ACQUIRE, "agent");
            asm volatile("s_waitcnt vmcnt(0)" ::: "memory");
        }
    }
    __syncthreads();
}

__device__ __forceinline__ void tr_item(const float* __restrict__ W, int K, int N, const float* __restrict__ gain, bf16* __restrict__ WT, LAS float* scr, int item, int lane) {
    const int nblk = N / 32, kb = item / nblk, nb = item - kb * nblk, k0 = 64 * kb, n0 = 32 * nb;
    f32x4 v[8];
#pragma unroll
    for (int i = 0; i < 8; ++i) { const int kk = 8 * i + (lane >> 3); v[i] = *(const f32x4*)(W + (size_t)(k0 + kk) * N + n0 + (lane & 7) * 4); }
#pragma unroll
    for (int i = 0; i < 8; ++i) { const int kk = 8 * i + (lane >> 3); const float g = gain ? gain[k0 + kk] : 1.f; LAS float* s = scr + kk * 33 + (lane & 7) * 4;
        s[0] = v[i].x * g; s[1] = v[i].y * g; s[2] = v[i].z * g; s[3] = v[i].w * g; }
    LDS_WAIT(); asm volatile("" ::: "memory");
    const int c = lane & 7;
#pragma unroll
    for (int j = 0; j < 4; ++j) { const int n = (lane >> 3) + 8 * j; const LAS float* s = scr + (8 * c) * 33 + n;
        v4u o; o.x = pk2(s[0 * 33], s[1 * 33]); o.y = pk2(s[2 * 33], s[3 * 33]); o.z = pk2(s[4 * 33], s[5 * 33]); o.w = pk2(s[6 * 33], s[7 * 33]);
        *(v4u*)(WT + (size_t)(n0 + n) * K + k0 + 8 * c) = o; }
    LDS_WAIT(); asm volatile("" ::: "memory");
}
template <bool I8>
__device__ __forceinline__ void tr_item8(const float* __restrict__ W, int K, int N, const float* __restrict__ gain, float scale, unsigned char* __restrict__ WT, LAS float* scr, int item, int lane) {
    const int nblk = N / 32, kb = item / nblk, nb = item - kb * nblk, k0 = 64 * kb, n0 = 32 * nb;
    f32x4 v[8];
#pragma unroll
    for (int i = 0; i < 8; ++i) { const int kk = 8 * i + (lane >> 3); v[i] = *(const f32x4*)(W + (size_t)(k0 + kk) * N + n0 + (lane & 7) * 4); }
#pragma unroll
    for (int i = 0; i < 8; ++i) { const int kk = 8 * i + (lane >> 3); const float g = (gain ? gain[k0 + kk] : 1.f) * scale; LAS float* s = scr + kk * 33 + (lane & 7) * 4;
        s[0] = v[i].x * g; s[1] = v[i].y * g; s[2] = v[i].z * g; s[3] = v[i].w * g; }
    LDS_WAIT(); asm volatile("" ::: "memory");
    const int c = lane & 7;
#pragma unroll
    for (int j = 0; j < 4; ++j) { const int n = (lane >> 3) + 8 * j; const LAS float* s = scr + (8 * c) * 33 + n;
        float f[8]; v2u o;
        if (I8) {
#pragma unroll
            for (int q = 0; q < 8; ++q) f[q] = rintf(fminf(fmaxf(s[q * 33], -127.f), 127.f));
            o.x = ((unsigned)(int)f[0] & 255u) | (((unsigned)(int)f[1] & 255u) << 8) | (((unsigned)(int)f[2] & 255u) << 16) | ((unsigned)(int)f[3] << 24);
            o.y = ((unsigned)(int)f[4] & 255u) | (((unsigned)(int)f[5] & 255u) << 8) | (((unsigned)(int)f[6] & 255u) << 16) | ((unsigned)(int)f[7] << 24);
        } else {
#pragma unroll
            for (int q = 0; q < 8; ++q) f[q] = fminf(fmaxf(s[q * 33], -448.f), 448.f);
            o.x = pg8::pk4_fp8(f[0], f[1], f[2], f[3]); o.y = pg8::pk4_fp8(f[4], f[5], f[6], f[7]); }
        *(v2u*)(WT + (size_t)(n0 + n) * K + k0 + 8 * c) = o; }
    LDS_WAIT(); asm volatile("" ::: "memory");
}
__device__ __forceinline__ float wave_max(float v) {
    v = fmaxf(v, xsw<1>(v)); v = fmaxf(v, xsw<2>(v)); v = fmaxf(v, xsw<4>(v)); v = fmaxf(v, xsw<8>(v)); v = fmaxf(v, xsw<16>(v));
    return xmax32(v);
}
__device__ __forceinline__ void row_load(const float* __restrict__ xrow, int lane, f32x4 (&ov)[16]) {
#pragma unroll
    for (int j = 0; j < 16; ++j) ov[j] = *(const f32x4*)(xrow + (lane + 64 * j) * 4);
}
__device__ __forceinline__ void row_to_bf16(const f32x4 (&ov)[16], bf16* __restrict__ orow, float* rs_out, unsigned* __restrict__ xq, float* as_out, int lane) {
    float ss = 0.f, am = 0.f;
#pragma unroll
    for (int j = 0; j < 16; ++j) { const int c = (lane + 64 * j) * 4; const f32x4 v = ov[j];
        ss += (v.x * v.x + v.y * v.y) + (v.z * v.z + v.w * v.w); am = fmaxf(fmaxf(am, fmaxf(fabsf(v.x), fabsf(v.y))), fmaxf(fabsf(v.z), fabsf(v.w)));
        v2u o; o.x = pk2(v.x, v.y); o.y = pk2(v.z, v.w); st_wt8(orow + c, o); }
    ss = wave_sum(ss); am = fmaxf(wave_max(am), 1e-20f); const float qs = 127.0f / am;
#pragma unroll
    for (int j = 0; j < 16; ++j) { const int q0 = (int)rintf(ov[j].x * qs), q1 = (int)rintf(ov[j].y * qs), q2 = (int)rintf(ov[j].z * qs), q3 = (int)rintf(ov[j].w * qs);
        st_wt4(xq + lane + 64 * j, ((unsigned)q0 & 255u) | (((unsigned)q1 & 255u) << 8) | (((unsigned)q2 & 255u) << 16) | ((unsigned)q3 << 24)); }
    if (lane == 0) { *rs_out = 1.0f / sqrtf(ss * (1.0f / DM) + EPS); *as_out = am * (1.0f / 127.0f); }
}
__device__ __forceinline__ void resid_rows(bf16* __restrict__ XB, const bf16* __restrict__ Y, const float* __restrict__ PART, const float* __restrict__ g, float* __restrict__ RS,
                                           float* __restrict__ outf, unsigned* __restrict__ XQ, float* __restrict__ AS, int gw, int NGW, int lane) {
    f32x4 gv[16];
#pragma unroll
    for (int j = 0; j < 16; ++j) gv[j] = *(const f32x4*)(g + (lane + 64 * j) * 4);
    for (int m = gw; m < MTOK; m += NGW) {
        const float pv = PART[(size_t)m * 64 + lane];
        bf16* xrow = XB + (size_t)m * DM; const bf16* yrow = Y + (size_t)m * DM;
        v2u xr[16], yr[16];
#pragma unroll
        for (int j = 0; j < 16; ++j) { xr[j] = *(const v2u*)(xrow + (lane + 64 * j) * 4); yr[j] = *(const v2u*)(yrow + (lane + 64 * j) * 4); }
        const float ry = 1.0f / sqrtf(wave_sum(pv) * (1.0f / DM) + EPS);
        float ss = 0.f, am = 0.f; f32x4 ov[16];
#pragma unroll
        for (int j = 0; j < 16; ++j) { const int c = (lane + 64 * j) * 4;
            f32x4 o; o.x = bf_lo(xr[j].x) + bf_lo(yr[j].x) * ry * gv[j].x; o.y = bf_hi(xr[j].x) + bf_hi(yr[j].x) * ry * gv[j].y; o.z = bf_lo(xr[j].y) + bf_lo(yr[j].y) * ry * gv[j].z; o.w = bf_hi(xr[j].y) + bf_hi(yr[j].y) * ry * gv[j].w;
            ss += (o.x * o.x + o.y * o.y) + (o.z * o.z + o.w * o.w); ov[j] = o; am = fmaxf(fmaxf(am, fmaxf(fabsf(o.x), fabsf(o.y))), fmaxf(fabsf(o.z), fabsf(o.w)));
            if (outf) st_wt16(outf + (size_t)m * DM + c, o); else { v2u ob; ob.x = pk2(o.x, o.y); ob.y = pk2(o.z, o.w); st_wt8(xrow + c, ob); } }
        if (XQ) {
            am = fmaxf(wave_max(am), 1e-20f); const float qs = 127.0f / am;
#pragma unroll
            for (int j = 0; j < 16; ++j) { const int q0 = (int)rintf(ov[j].x * qs), q1 = (int)rintf(ov[j].y * qs), q2 = (int)rintf(ov[j].z * qs), q3 = (int)rintf(ov[j].w * qs);
                st_wt4(XQ + (size_t)m * (DM / 4) + lane + 64 * j, ((unsigned)q0 & 255u) | (((unsigned)q1 & 255u) << 8) | (((unsigned)q2 & 255u) << 16) | ((unsigned)q3 << 24)); }
            if (lane == 0) AS[m] = am * (1.0f / 127.0f); }
        ss = wave_sum(ss);
        if (lane == 0) RS[m] = 1.0f / sqrtf(ss * (1.0f / DM) + EPS);
    }
}
__device__ __forceinline__ void mixpost_load(const bf16* __restrict__ MIX, const bf16* __restrict__ DT, int tok, int lane, v4u (&mx)[6], v2u (&ab)[4], v2u (&cb)[4]) {
#pragma unroll
    for (int j = 0; j < 6; ++j) mx[j] = *(const v4u*)(MIX + (size_t)tok * DM + (lane + 64 * j) * 8);
#pragma unroll
    for (int h = 0; h < 4; ++h) { const size_t off = (size_t)tok * 1024 + h * 256 + lane * 4; ab[h] = *(const v2u*)(DT + off); cb[h] = *(const v2u*)(DT + (size_t)MTOK * 1024 + off); }
}
__device__ __forceinline__ void mixpost_row(int tok, int lane, const v4u (&mx)[6], const v2u (&ab)[4], const v2u (&cb)[4], float lam, float oscale, f32x4 sg, unsigned char* __restrict__ MQ, float* __restrict__ MAS) {
    f32x4 yd[4]; float am = 0.f;
#pragma unroll
    for (int h = 0; h < 4; ++h) {
        f32x4 a, c; a.x = bf_lo(ab[h].x); a.y = bf_hi(ab[h].x); a.z = bf_lo(ab[h].y); a.w = bf_hi(ab[h].y); c.x = bf_lo(cb[h].x); c.y = bf_hi(cb[h].x); c.z = bf_lo(cb[h].y); c.w = bf_hi(cb[h].y);
        f32x4 d; d.x = a.x - lam * c.x; d.y = a.y - lam * c.y; d.z = a.z - lam * c.z; d.w = a.w - lam * c.w;
        const float ss = wave_sum((d.x * d.x + d.y * d.y) + (d.z * d.z + d.w * d.w)); const float r = oscale / sqrtf(ss * (1.0f / 256.0f) + EPS);
        yd[h].x = d.x * r * sg.x; yd[h].y = d.y * r * sg.y; yd[h].z = d.z * r * sg.z; yd[h].w = d.w * r * sg.w;
        am = fmaxf(fmaxf(am, fmaxf(fabsf(yd[h].x), fabsf(yd[h].y))), fmaxf(fabsf(yd[h].z), fabsf(yd[h].w))); }
    float mv[6][8];
#pragma unroll
    for (int j = 0; j < 6; ++j) { const unsigned w4[4] = {mx[j].x, mx[j].y, mx[j].z, mx[j].w};
#pragma unroll
        for (int e = 0; e < 4; ++e) { mv[j][2 * e] = bf_lo(w4[e]); mv[j][2 * e + 1] = bf_hi(w4[e]); am = fmaxf(am, fmaxf(fabsf(mv[j][2 * e]), fabsf(mv[j][2 * e + 1]))); } }
    am = fmaxf(wave_max(am), 1e-20f); const float qs = 127.0f / am;
    unsigned char* qrow = MQ + (size_t)tok * DM;
#pragma unroll
    for (int j = 0; j < 6; ++j) { int q[8];
#pragma unroll
        for (int e = 0; e < 8; ++e) q[e] = (int)rintf(mv[j][e] * qs);
        v2u o; o.x = ((unsigned)q[0] & 255u) | (((unsigned)q[1] & 255u) << 8) | (((unsigned)q[2] & 255u) << 16) | ((unsigned)q[3] << 24);
        o.y = ((unsigned)q[4] & 255u) | (((unsigned)q[5] & 255u) << 8) | (((unsigned)q[6] & 255u) << 16) | ((unsigned)q[7] << 24);
        st_wt8(qrow + (lane + 64 * j) * 8, o); }
#pragma unroll
    for (int h = 0; h < 4; ++h) { const int q0 = (int)rintf(yd[h].x * qs), q1 = (int)rintf(yd[h].y * qs), q2 = (int)rintf(yd[h].z * qs), q3 = (int)rintf(yd[h].w * qs);
        st_wt4(qrow + 3072 + h * 256 + lane * 4, ((unsigned)q0 & 255u) | (((unsigned)q1 & 255u) << 8) | (((unsigned)q2 & 255u) << 16) | ((unsigned)q3 << 24)); }
    if (lane == 0) MAS[tok] = am * (1.0f / 127.0f);
}
__device__ __forceinline__ int t5_bucket(int rel) {
    const int n = rel < 0 ? -rel : rel; int b;
    if (n < 8) b = n; else { const int l2 = 31 - __builtin_clz((unsigned)(n * n)); b = 8 + (l2 - 6); if (b > 15) b = 15; }
    return b + (rel > 0 ? 16 : 0);
}

constexpr int I_IN = (DM / 128) * (DIN / 32), I_OUT = (DM / 128) * (DM / 32), I_MI = (DM / 128) * (DFF / 32), I_MO = (DFF / 128) * (DM / 32);
struct ItemD { const float* W; const float* gain; unsigned char* WT; float scale; int K, N, r, kind; };
__device__ __forceinline__ void conv_load(const ItemD& d, int lane, f32x4 (&v)[16]) {
    const int nblk = d.N / 32, kb = d.r / nblk, nb = d.r - kb * nblk, k0 = 128 * kb + 16 * (lane >> 3), n0 = 32 * nb + 4 * (lane & 7);
#pragma unroll
    for (int i = 0; i < 16; ++i) v[i] = *(const f32x4*)(d.W + (size_t)(k0 + i) * d.N + n0);
}
template <int KIND>
__device__ __forceinline__ void conv_finish(const ItemD& d, int lane, const f32x4 (&v)[16]) {
    const int nblk = d.N / 32, kb = d.r / nblk, nb = d.r - kb * nblk, k0 = 128 * kb + 16 * (lane >> 3), n0 = 32 * nb + 4 * (lane & 7);
    float gs[16];
    if (d.gain) {
#pragma unroll
        for (int i = 0; i < 4; ++i) { const f32x4 g4 = *(const f32x4*)(d.gain + k0 + 4 * i); gs[4 * i] = g4.x * d.scale; gs[4 * i + 1] = g4.y * d.scale; gs[4 * i + 2] = g4.z * d.scale; gs[4 * i + 3] = g4.w * d.scale; }
    } else {
#pragma unroll
        for (int i = 0; i < 16; ++i) gs[i] = d.scale; }
#pragma unroll
    for (int j = 0; j < 4; ++j) {
        if (KIND == 0) { v4u o0, o1;
            o0.x = pk2(v[0][j] * gs[0], v[1][j] * gs[1]); o0.y = pk2(v[2][j] * gs[2], v[3][j] * gs[3]); o0.z = pk2(v[4][j] * gs[4], v[5][j] * gs[5]); o0.w = pk2(v[6][j] * gs[6], v[7][j] * gs[7]);
            o1.x = pk2(v[8][j] * gs[8], v[9][j] * gs[9]); o1.y = pk2(v[10][j] * gs[10], v[11][j] * gs[11]); o1.z = pk2(v[12][j] * gs[12], v[13][j] * gs[13]); o1.w = pk2(v[14][j] * gs[14], v[15][j] * gs[15]);
            bf16* dst = (bf16*)d.WT + (size_t)(n0 + j) * d.K + k0; *(v4u*)dst = o0; *(v4u*)(dst + 8) = o1;
        } else { unsigned w[4];
#pragma unroll
            for (int t = 0; t < 4; ++t) {
                if (KIND == 1) { int b[4];
#pragma unroll
                    for (int e = 0; e < 4; ++e) { const int bits = __float_as_int(fmaf(v[4 * t + e][j], gs[4 * t + e], 12582912.0f)); b[e] = min(max(bits, 0x4B400000 - 127), 0x4B400000 + 127); }
                    w[t] = __builtin_amdgcn_perm((unsigned)b[1], (unsigned)b[0], 0x0c0c0400u) | __builtin_amdgcn_perm((unsigned)b[3], (unsigned)b[2], 0x04000c0cu);
                } else { float f[4];
#pragma unroll
                    for (int e = 0; e < 4; ++e) f[e] = __builtin_amdgcn_fmed3f(v[4 * t + e][j] * gs[4 * t + e], -448.f, 448.f);
                    w[t] = pg8::pk4_fp8(f[0], f[1], f[2], f[3]); } }
            v4u o; o.x = w[0]; o.y = w[1]; o.z = w[2]; o.w = w[3];
            st_wt16(d.WT + (size_t)(n0 + j) * d.K + k0, o); } }
}
constexpr int CONV_TAIL_ITEMS = 8192;
struct ConvSrc { const float *w_in, *w_out, *w_mlp_in, *w_mlp_out, *ln_attn_pre, *ln_mlp_pre; };
__device__ __forceinline__ int conv_cnt(int t0, int t1, int t) { return (t0 <= t && t < t1) ? (t == 0 ? I_IN : t == 1 ? I_OUT : t == 2 ? I_MI : I_MO) : 0; }
__device__ __forceinline__ void conv_decode(const ConvSrc& cs, unsigned char* ws, float sa_in, float sa_mi, float sa_out, float sb_in, int la, int a0, int a1, int lb, int b0, int b1, int na, int it, ItemD& d) {
    const bool inA = it < na; const int l = inA ? la : lb, t0 = inA ? a0 : b0, t1 = inA ? a1 : b1; int r = inA ? it : it - na; unsigned char* wl = ws + WS_W + (size_t)l * W_LAYER_B;
    const int n0 = conv_cnt(t0, t1, 0), n1 = conv_cnt(t0, t1, 1), n2 = conv_cnt(t0, t1, 2);
    if (r < n0) { d = ItemD{cs.w_in + (size_t)l * DM * DIN, cs.ln_attn_pre + l * DM, wl, inA ? sa_in : sb_in, DM, DIN, r, 1}; return; } r -= n0;
    if (r < n1) { d = ItemD{cs.w_out + (size_t)l * DM * DM, nullptr, wl + W_IN_B, sa_out, DM, DM, r, 1}; return; } r -= n1;
    if (r < n2) { d = ItemD{cs.w_mlp_in + (size_t)l * DM * DFF, cs.ln_mlp_pre + l * DM, wl + W_IN_B + W_OUT_B, sa_mi, DM, DFF, r, 1}; return; } r -= n2;
    d = ItemD{cs.w_mlp_out + (size_t)l * DFF * DM, nullptr, wl + W_IN_B + W_OUT_B + W_MI_B, WMO_SCALE, DFF, DM, r, 2};
}
__device__ __forceinline__ void conv_stream(const ConvSrc& cs, unsigned char* ws, float sa_in, float sa_mi, float sa_out, float sb_in, int la, int a0, int a1, int lb, int b0, int b1, int it0, int it1, int gw, int NGW, int lane) {
    const int na = conv_cnt(a0, a1, 0) + conv_cnt(a0, a1, 1) + conv_cnt(a0, a1, 2) + conv_cnt(a0, a1, 3), nb = conv_cnt(b0, b1, 0) + conv_cnt(b0, b1, 1) + conv_cnt(b0, b1, 2) + conv_cnt(b0, b1, 3), ntot = na + nb;
    const int iend = it1 < ntot ? it1 : ntot;
    for (int it = it0 + gw; it < iend; it += 2 * NGW) { ItemD c0, c1; f32x4 v0[16], v1[16]; const bool two = it + NGW < iend;
        conv_decode(cs, ws, sa_in, sa_mi, sa_out, sb_in, la, a0, a1, lb, b0, b1, na, it, c0); conv_load(c0, lane, v0);
        if (two) { conv_decode(cs, ws, sa_in, sa_mi, sa_out, sb_in, la, a0, a1, lb, b0, b1, na, it + NGW, c1); conv_load(c1, lane, v1); }
        if (c0.kind == 1) conv_finish<1>(c0, lane, v0); else if (c0.kind == 2) conv_finish<2>(c0, lane, v0); else conv_finish<0>(c0, lane, v0);
        if (two) { if (c1.kind == 1) conv_finish<1>(c1, lane, v1); else if (c1.kind == 2) conv_finish<2>(c1, lane, v1); else conv_finish<0>(c1, lane, v1); } }
}

struct Args { const float* in[16]; float* out; unsigned char* ws; int ph_lo, ph_hi, li, pad; };
constexpr int NPHASES = 1 + 9 * DEPTH;

typedef __attribute__((address_space(4))) const Args* CArgs;
#define PH_ENTER() CArgs A_ = (CArgs)__builtin_amdgcn_kernarg_segment_ptr(); asm volatile("" : "+s"(A_)); unsigned char* ws = A_->ws; \
    int wave = wave0; asm volatile("" : "+s"(wave)); int lane = lane_id(); asm volatile("" : "+v"(lane)); const int tid = wave * 64 + lane; (void)tid; \
    const int G = gridDim.x, bx = blockIdx.x, vcu = (G % 8 == 0) ? (bx % 8) * (G / 8) + bx / 8 : bx; const int gw = vcu * NWAVES + wave, NGW = G * NWAVES; (void)lane; (void)gw; (void)NGW; (void)ws; (void)bx;
#define IN_(k) (A_->in[k])

__global__ void __launch_bounds__(NWAVES * 64, 2) mk_fwd(Args args) {
    extern __shared__ __attribute__((aligned(16))) unsigned char lds_raw[];
    LAS unsigned char* lds = (LAS unsigned char*)lds_raw;
    XcdBarrier bar; const int wave0 = __builtin_amdgcn_readfirstlane((int)threadIdx.x >> 6);
    { volatile LAS unsigned* MISC = (volatile LAS unsigned*)(lds + MISC_OFF);
      for (int u = threadIdx.x; u < (LDS_BYTES - LDSCTL_OFF) / 4; u += NWAVES * 64) ((LAS unsigned*)(lds + LDSCTL_OFF))[u] = 0u;
      __syncthreads();
      bar = xcd_barrier_post((unsigned*)(args.ws + WS_CTL) + CW_BAR + args.li * XCD_BAR_WORDS, MISC + 8); }
    const int lo = args.ph_lo, hi = args.ph_hi;
#define IN(k) (lo <= (k) && (k) < hi)
#ifndef PROBE_DUP
#define PROBE_DUP 0
#endif
#define DUPN(bit) (((PROBE_DUP >> (bit)) & 1) ? 2 : 1)
#define SEAM(k) do { if (IN(k) && IN((k) + 1)) xcd_barrier(bar); } while (0)

    if (IN(0)) for (int dup_ = 0; dup_ < DUPN(0); ++dup_) {
        PH_ENTER();
        const float* x_in = IN_(0); const float* ln_attn_pre = IN_(1); const float* ln_mlp_pre = IN_(3); const float* w_in = IN_(5); const float* w_out = IN_(6); const float* w_mlp_in = IN_(14); const float* w_mlp_out = IN_(15);
        float* RS = (float*)(ws + WS_RS); float* ROPE = (float*)(ws + WS_ROPE); bf16* XB = (bf16*)(ws + WS_XB);
        LAS float* scr = (LAS float*)(lds + wave * 16384);
        float wqi0 = 0.f;
        { float am[3 * DEPTH], gm[3 * DEPTH];
#pragma unroll
          for (int t = 0; t < 3 * DEPTH; ++t) { const int l = t / 3, kd = t - 3 * l;
            am[t] = 0.f; gm[t] = 0.f; if (t != 0 && (t % G) != bx) continue;
            const float* wsrc = kd == 0 ? w_in + (size_t)l * DM * DIN : kd == 1 ? w_mlp_in + (size_t)l * DM * DFF : w_out + (size_t)l * DM * DM; const float* gs = (kd == 0 ? ln_attn_pre : ln_mlp_pre) + l * DM; float a = 0.f, g = 0.f;
#pragma unroll 8
            for (int i = 0; i < 32; ++i) { const f32x4 v = *(const f32x4*)(wsrc + (size_t)(tid + 512 * i) * 4); a = fmaxf(fmaxf(a, fmaxf(fabsf(v.x), fabsf(v.y))), fmaxf(fabsf(v.z), fabsf(v.w))); }
            if (kd == 2) g = 1.f; else {
#pragma unroll
                for (int i = 0; i < 8; ++i) g = fmaxf(g, fabsf(gs[tid + 512 * i])); }
            am[t] = wave_max(a); gm[t] = wave_max(g); }
          LAS float* red = (LAS float*)(lds + 131072 - 1024);
          __syncthreads();
          if (lane == 0) {
#pragma unroll
            for (int t = 0; t < 3 * DEPTH; ++t) { red[t * 16 + wave] = am[t]; red[t * 16 + 8 + wave] = gm[t]; } }
          __syncthreads();
#pragma unroll
          for (int t = 0; t < 3 * DEPTH; ++t) { float a2 = 0.f, g2 = 0.f;
#pragma unroll
            for (int w = 0; w < 8; ++w) { a2 = fmaxf(a2, red[t * 16 + w]); g2 = fmaxf(g2, red[t * 16 + 8 + w]); }
            const float amax = fmaxf(a2 * g2 * 1.0f, 1e-20f); if (t == 0) wqi0 = 127.0f / amax;
            if ((t % G) == bx && tid == 0) { ((float*)(ws + WS_WQS))[t] = amax * (1.0f / 127.0f); ((float*)(ws + WS_WQS))[8 + t] = 127.0f / amax; } } }
        { const ConvSrc cs{w_in, w_out, w_mlp_in, w_mlp_out, ln_attn_pre, ln_mlp_pre};
          conv_stream(cs, ws, wqi0, 0.f, 0.f, 0.f, 0, 0, 1, 0, 0, 0, 0, 1 << 30, gw, NGW, lane); }
        if (gw < MTOK) {
            const int n = (MTOK - gw + NGW - 1) / NGW, lastm = gw + (n - 1) * NGW; f32x4 rA[16], rB[16];
#define ROW_OUT(m_, r_) row_to_bf16(r_, XB + (size_t)(m_) * DM, RS + (m_), (unsigned*)(ws + WS_XQ) + (size_t)(m_) * (DM / 4), (float*)(ws + WS_AS) + (m_), lane)
            row_load(x_in + (size_t)gw * DM, lane, rA);
            for (int k = 0; k < n; k += 2) { const int m1 = min(gw + (k + 1) * NGW, lastm), m2 = min(gw + (k + 2) * NGW, lastm);
                row_load(x_in + (size_t)m1 * DM, lane, rB); ROW_OUT(gw + k * NGW, rA);
                row_load(x_in + (size_t)m2 * DM, lane, rA); ROW_OUT(m1, rB); }
#undef ROW_OUT
        }
        for (int i = gw * 64 + lane; i < SEQ * 64; i += NGW * 64) { const int pos = i >> 6, pi = i & 63, j = pi & 31; const float p = (float)((pi < 32) ? (pos >> 6) : (pos & 63));
            const float inv = exp2f(-(float)j * (13.287712379549449f / 32.0f)); float t = (p * inv) * 0.15915494309189535f; t -= floorf(t);
            ROPE[2 * i] = __builtin_amdgcn_cosf(t); ROPE[2 * i + 1] = __builtin_amdgcn_sinf(t); }
    }
    SEAM(0);

    for (int l = 0; l < DEPTH; ++l) {
        const int pb = 1 + 9 * l;

        if (IN(pb + 0)) for (int dup_ = 0; dup_ < DUPN(1); ++dup_) {
            PH_ENTER();
            const bf16* Win_t = (const bf16*)(ws + WS_W + (size_t)l * W_LAYER_B);
            pg8::Gemm g{(const bf16*)(ws + WS_XQ), Win_t, MTOK, DIN, DM / 2}; pg8::StaticOrder S; S.init(MTOK, DIN, G, bx);
            pg8::EpiProjI8 E{(bf16*)(ws + WS_PROJ), DIN, (const float*)(ws + WS_RS), (const float*)(ws + WS_AS), (const float*)(ws + WS_WQS) + 3 * l, (LAS float*)(lds + RING_BYTES + 1024), IN_(8) + l * 128, IN_(9) + l * 128, (const float*)(ws + WS_ROPE), SEQ};
            pg8::gemm_phase<pg8::EpiProjI8, pg8::StaticOrder, true, true, 2>(lds, g, S, E, tid);
            { const int nwg = (MTOK / 256) * (DIN / 256), rem = nwg % G;
              if (dup_ == 0 && rem > 0 && bx >= rem) { const float* qsc = (const float*)(ws + WS_WQS) + 8; const ConvSrc cs{IN_(5), IN_(6), IN_(14), IN_(15), IN_(1), IN_(3)};
                  conv_stream(cs, ws, 0.f, qsc[3 * l + 1], qsc[3 * l + 2], (l + 1 < DEPTH) ? qsc[3 * l + 3] : 0.f, l, 1, 4, l + 1, 0, (l + 1 < DEPTH) ? 1 : 0, 0, CONV_TAIL_ITEMS, (bx - rem) * NWAVES + wave, (G - rem) * NWAVES, lane); }
            }
        }
        SEAM(pb + 0);


        if (IN(pb + 2)) for (int dup_ = 0; dup_ < DUPN(3); ++dup_) {
            PH_ENTER();
            const bf16* PROJ = (const bf16*)(ws + WS_PROJ); bf16* MIX = (bf16*)(ws + WS_MIX); bf16* DT = (bf16*)(ws + WS_DT);
            const float* na_rpb = IN_(7); const float* sw_sink = IN_(10); const float* t5_table = IN_(13);
            LAS float* tab = (LAS float*)(lds + att::OFF_TAB);
            const int cslot = vcu % 5; int ui = 0;
            for (int s = vcu; s < 1280; s += G, ++ui) {
                if (ui == cslot) {
                    CArgs A2 = (CArgs)__builtin_amdgcn_kernarg_segment_ptr(); asm volatile("" : "+s"(A2)); unsigned char* ws2 = A2->ws;
                    int wv2 = wave0; asm volatile("" : "+s"(wv2)); int ln2 = lane_id(); asm volatile("" : "+v"(ln2)); const int gw2 = vcu * NWAVES + wv2;
                    const float* qsc = (const float*)(ws2 + WS_WQS) + 8;
                    const ConvSrc cs{A2->in[5], A2->in[6], A2->in[14], A2->in[15], A2->in[1], A2->in[3]};
                    conv_stream(cs, ws2, 0.f, qsc[3 * l + 1], qsc[3 * l + 2], (l + 1 < DEPTH) ? qsc[3 * l + 3] : 0.f, l, 1, 4, l + 1, 0, (l + 1 < DEPTH) ? 1 : 0, (((MTOK / 256) * (DIN / 256)) % G) ? CONV_TAIL_ITEMS : 0, 1 << 30, gw2, NGW, ln2); }
                const int kind = s >> 8, v = s & 255; int t2 = wave * 64 + lane_id(); asm volatile("" : "+v"(t2));
                const bf16 *Qp, *Kp; int vdelta, mode, kbeg = 0, nkeys = SEQ, qt = v & 7; float sink = 0.f; void* Op;
                if (kind == 0) {
                    const int b = v >> 6, hq = (v >> 3) & 7; mode = att::MODE_B;
                    const bf16* base = PROJ + (size_t)(b * SEQ) * DIN;
                    Qp = base + (size_t)(qt * 256) * DIN + C_BQ + hq * 128; Kp = base + C_BK + (hq >> 2) * 128; vdelta = C_BV - C_BK;
                    Op = MIX + (size_t)(b * SEQ + qt * 256) * DM + 1024 + hq * 128;
                } else if (kind <= 2) {
                    const int u = v + 256 * (kind - 1), b = u >> 7, h = (u >> 5) & 3, sm = (u >> 4) & 1, vh = (u >> 3) & 1; mode = att::MODE_D;
                    const bf16* base = PROJ + (size_t)(b * SEQ) * DIN;
                    Qp = base + (size_t)(qt * 256) * DIN + C_DQ + sm * 512 + h * 128; Kp = base + C_DK + sm * 512 + h * 128; vdelta = (C_DV + h * 256 + vh * 128) - (C_DK + sm * 512 + h * 128);
                    Op = DT + (size_t)sm * MTOK * 1024 + (size_t)(b * SEQ + qt * 256) * 1024 + h * 256 + vh * 128;
                } else if (kind == 3) {
                    const int b = v >> 6, h = (v >> 3) & 7; mode = att::MODE_A;
                    int rlo = min(max(4 * qt - 4, 0), 24), rhi = min(max(4 * qt + 3 - 4, 0), 24) + 8;
                    if ((rhi - rlo) & 1) { if (rlo > 0) --rlo; else ++rhi; }
                    kbeg = rlo * 64; nkeys = (rhi - rlo) * 64;
                    const bf16* base = PROJ + (size_t)(b * SEQ) * DIN;
                    Qp = base + (size_t)(qt * 256) * DIN + C_AQ + h * 128; Kp = base + (size_t)kbeg * DIN + C_AK + h * 128; vdelta = C_AV - C_AK;
                    Op = MIX + (size_t)(b * SEQ + qt * 256) * DM + h * 128;
                } else {
                    const int b = v >> 6, hq = (v >> 3) & 7; qt = (v + 4) & 7; mode = att::MODE_C;
                    kbeg = max(0, qt * 256 - 128); const int kend = min(SEQ, qt * 256 + 256 + 128); nkeys = kend - kbeg;
                    const bf16* base = PROJ + (size_t)(b * SEQ) * DIN;
                    Qp = base + (size_t)(qt * 256) * DIN + C_CQ + hq * 128; Kp = base + (size_t)kbeg * DIN + C_CK + (hq >> 2) * 128; vdelta = C_CV - C_CK;
                    Op = MIX + (size_t)(b * SEQ + qt * 256) * DM + 2048 + hq * 128;
                    sink = __int_as_float(__builtin_amdgcn_readfirstlane(__float_as_int(sw_sink[l * 8 + hq])));
                }
                auto fill = [&]() {
                    if (kind == 1 || kind == 2) { const int h = ((v + 256 * (kind - 1)) >> 5) & 3;
                        for (int i = t2; i < 768; i += NWAVES * 64) tab[i] = t5_table[t5_bucket(i - att::TREL) * 12 + 8 + h] * att::INV_SCALE; }
                    else if (kind == 3) { const int h = (v >> 3) & 7; const float* rp = na_rpb + ((size_t)l * 8 + h) * 15 * 31;
                        for (int i = t2; i < 15 * 128; i += NWAVES * 64) { const int dr = i >> 7, dc = (i & 127) - 48; tab[i] = (dc >= 0 && dc < 31) ? rp[dr * 31 + dc] * att::INV_SCALE : 0.f; } }
                    else if (kind == 4) { const int hq = (v >> 3) & 7;
                        for (int i = t2; i < 768; i += NWAVES * 64) { const int rel = i - att::TREL; tab[i] = (rel >= -128 && rel <= 128) ? t5_table[t5_bucket(rel) * 12 + hq] * att::INV_SCALE : att::MASKV; } } };
                att::attn_unit<DIN>(Qp, Kp, vdelta, nkeys, mode, kbeg, qt * 256, (const LAS float*)tab, sink, Op, (att::lptr)lds, t2, fill);
            }
            if (ui <= cslot) {
                int ln3 = lane_id(); asm volatile("" : "+v"(ln3)); const float* qsc = (const float*)(ws + WS_WQS) + 8;
                const ConvSrc cs{IN_(5), IN_(6), IN_(14), IN_(15), IN_(1), IN_(3)};
                conv_stream(cs, ws, 0.f, qsc[3 * l + 1], qsc[3 * l + 2], (l + 1 < DEPTH) ? qsc[3 * l + 3] : 0.f, l, 1, 4, l + 1, 0, (l + 1 < DEPTH) ? 1 : 0, (((MTOK / 256) * (DIN / 256)) % G) ? CONV_TAIL_ITEMS : 0, 1 << 30, gw, NGW, ln3); }
        }
        SEAM(pb + 2);

        if (IN(pb + 3)) for (int dup_ = 0; dup_ < DUPN(4); ++dup_) {
            PH_ENTER();
            const bf16* DT = (const bf16*)(ws + WS_DT); const bf16* MIX = (const bf16*)(ws + WS_MIX); unsigned char* MQ = ws + WS_XQ; float* MAS = (float*)(ws + WS_MAS);
            v4u mxA[6], mxB[6]; v2u abA[4], cbA[4], abB[4], cbB[4];
            mixpost_load(MIX, DT, min(gw, MTOK - 1), lane, mxA, abA, cbA);
            const float lam_init = 0.8f - 0.6f * expf(-0.3f * (float)l);
            const float* lp = IN_(11) + l * 512;
            const float s1 = wave_sum(lp[lane] * lp[128 + lane] + lp[64 + lane] * lp[192 + lane]), s2 = wave_sum(lp[256 + lane] * lp[384 + lane] + lp[320 + lane] * lp[448 + lane]);
            const float lam = expf(s1) - expf(s2) + lam_init, oscale = 1.0f - lam_init;
            const f32x4 sg = *(const f32x4*)(IN_(12) + l * 256 + lane * 4);
            { const int n = (MTOK - gw + NGW - 1) / NGW, lastt = gw + (n - 1) * NGW;
              for (int k = 0; k < n; k += 2) {
                  mixpost_load(MIX, DT, min(gw + (k + 1) * NGW, lastt), lane, mxB, abB, cbB);
                  mixpost_row(gw + k * NGW, lane, mxA, abA, cbA, lam, oscale, sg, MQ, MAS);
                  mixpost_load(MIX, DT, min(gw + (k + 2) * NGW, lastt), lane, mxA, abA, cbA);
                  mixpost_row(min(gw + (k + 1) * NGW, lastt), lane, mxB, abB, cbB, lam, oscale, sg, MQ, MAS);
              } }
        }
        SEAM(pb + 3);

        if (IN(pb + 4)) for (int dup_ = 0; dup_ < DUPN(5); ++dup_) {
            PH_ENTER();
            const bf16* Wout_t = (const bf16*)(ws + WS_W + (size_t)l * W_LAYER_B + W_IN_B);
            pg8::Gemm g{(const bf16*)(ws + WS_XQ), Wout_t, MTOK, DM, DM / 2}; pg8::StaticOrder S; S.init(MTOK, DM, G, bx);
            pg8::EpiYStats<true> E{(bf16*)(ws + WS_Y), DM, (float*)(ws + WS_PART), 1.0f, (const float*)(ws + WS_MAS), (const float*)(ws + WS_WQS) + 3 * l + 2};
            pg8::gemm_phase<pg8::EpiYStats<true>, pg8::StaticOrder, true, true, 2>(lds, g, S, E, tid);
        }
        SEAM(pb + 4);

        if (IN(pb + 5)) {
            PH_ENTER();
            resid_rows((bf16*)(ws + WS_XB), (const bf16*)(ws + WS_Y), (const float*)(ws + WS_PART), IN_(2) + l * DM, (float*)(ws + WS_RS), nullptr, (unsigned*)(ws + WS_XQ), (float*)(ws + WS_AS), gw, NGW, lane);
        }
        SEAM(pb + 5);

        if (IN(pb + 6)) for (int dup_ = 0; dup_ < DUPN(7); ++dup_) {
            PH_ENTER();
            const bf16* Wmi_t = (const bf16*)(ws + WS_W + (size_t)l * W_LAYER_B + W_IN_B + W_OUT_B);
            pg8::Gemm g{(const bf16*)(ws + WS_XQ), Wmi_t, MTOK, DFF, DM / 2}; pg8::StaticOrder S; S.init(MTOK, DFF, G, bx);
            pg8::EpiRelu2Fp8<true> E{(unsigned char*)(ws + WS_U), DFF, (const float*)(ws + WS_RS), (const float*)(ws + WS_AS), (const float*)(ws + WS_WQS) + 3 * l + 1, U_SCALE};
            pg8::gemm_phase<pg8::EpiRelu2Fp8<true>, pg8::StaticOrder, true, true, 2>(lds, g, S, E, tid);
        }
        SEAM(pb + 6);

        if (IN(pb + 7)) for (int dup_ = 0; dup_ < DUPN(8); ++dup_) {
            PH_ENTER();
            const bf16* Wmo_t = (const bf16*)(ws + WS_W + (size_t)l * W_LAYER_B + W_IN_B + W_OUT_B + W_MI_B);
            pg8::Gemm g{(const bf16*)(ws + WS_U), Wmo_t, MTOK, DM, DFF / 2}; pg8::StaticOrder S; S.init(MTOK, DM, G, bx);
            pg8::EpiYStats<false> E{(bf16*)(ws + WS_Y), DM, (float*)(ws + WS_PART), 1.0f / (U_SCALE * WMO_SCALE), nullptr, nullptr};
            pg8::gemm_phase<pg8::EpiYStats<false>, pg8::StaticOrder, true, true, 1>(lds, g, S, E, tid);
        }
        SEAM(pb + 7);

        if (IN(pb + 8)) {
            PH_ENTER();
            resid_rows((bf16*)(ws + WS_XB), (const bf16*)(ws + WS_Y), (const float*)(ws + WS_PART), IN_(4) + l * DM, (float*)(ws + WS_RS), (l == DEPTH - 1) ? A_->out : nullptr, (l == DEPTH - 1) ? nullptr : (unsigned*)(ws + WS_XQ), (float*)(ws + WS_AS), gw, NGW, lane);
        }
        SEAM(pb + 8);
    }
#undef IN
#undef SEAM
}

#ifndef MK_PER_PHASE
#define MK_PER_PHASE 0
#endif
extern "C" void kernel_launch(void* const* d_in, const int* in_sizes, int n_in, void* d_out, int out_size, void* d_ws, size_t ws_size, hipStream_t stream) {
    static int grid = 0;
    if (grid == 0) {
        if (n_in != 16 || in_sizes[0] != MTOK * DM || out_size != MTOK * DM || ws_size < WS_END) {
            fprintf(stderr, "kernel_launch: shape mismatch: n_in %d in0 %d out %d ws %zu (need %zu); nothing launched\n", n_in, n_in > 0 ? in_sizes[0] : -1, out_size, ws_size, (size_t)WS_END); grid = -1; return; }
        int dev = 0, cus = 0, per_cu = 0;
        if (hipGetDevice(&dev) != hipSuccess || hipDeviceGetAttribute(&cus, hipDeviceAttributeMultiprocessorCount, dev) != hipSuccess) { fprintf(stderr, "kernel_launch: device query failed\n"); grid = -1; return; }
        if (hipFuncSetAttribute((const void*)mk_fwd, hipFuncAttributeMaxDynamicSharedMemorySize, LDS_BYTES) != hipSuccess) { fprintf(stderr, "kernel_launch: hipFuncSetAttribute failed\n"); grid = -1; return; }
        if (hipOccupancyMaxActiveBlocksPerMultiprocessor(&per_cu, (const void*)mk_fwd, NWAVES * 64, LDS_BYTES) != hipSuccess || per_cu < 1)
            fprintf(stderr, "kernel_launch: note: occupancy query reports %d workgroups per CU\n", per_cu);
        (void)hipGetLastError();
        grid = cus;
    }
    if (grid < 0) return;
    if (hipMemsetAsync((char*)d_ws + WS_CTL, 0, CTL_ZERO_BYTES, stream) != hipSuccess) { fprintf(stderr, "kernel_launch: memset failed\n"); return; }
    Args a{};
    for (int i = 0; i < 16; ++i) a.in[i] = (const float*)d_in[i];
    a.out = (float*)d_out; a.ws = (unsigned char*)d_ws; a.pad = 0;
#if MK_PER_PHASE
    for (int p = 0; p < NPHASES; ++p) { a.ph_lo = p; a.ph_hi = p + 1; a.li = p; hipLaunchKernelGGL(mk_fwd, dim3(grid), dim3(NWAVES * 64), LDS_BYTES, stream, a); }
#else
    a.ph_lo = 0; a.ph_hi = NPHASES; a.li = 0;
    hipLaunchKernelGGL(mk_fwd, dim3(grid), dim3(NWAVES * 64), LDS_BYTES, stream, a);
#endif
    const hipError_t le = hipPeekAtLastError();
    if (le != hipSuccess) fprintf(stderr, "kernel_launch: launch failed: %s\n", hipGetErrorName(le));
}
```
